# Optimizing an MI355X kernel written in HIP

```python
import jax, jax.numpy as jnp
from jax import lax
import numpy as np

D_MODEL = 1024
BATCH = 2
SEQ = 16384
DEPTH = 2
DEC_BATCH = 16
DEC_SEQ = 64
PAST_LEN = 2048

CHUNK = 64
HEAD_DIM = 64
N_HEADS_A = 8
N_HEADS_B = 8
N_KV_B = 2
GROUP_B = N_HEADS_B // N_KV_B
WIDTH_A = N_HEADS_A * HEAD_DIM
WIDTH_B = N_HEADS_B * HEAD_DIM
KV_WIDTH_B = N_KV_B * HEAD_DIM
MIX_WIDTH = WIDTH_A + WIDTH_B
IN_WIDTH = 3 * WIDTH_A + WIDTH_B + 2 * KV_WIDTH_B
PREV_CHUNKS_A = 8
A_ROWS = PREV_CHUNKS_A * CHUNK
REL_CLIP = 256
WINDOW_B = 128
PREV_CHUNKS_B = WINDOW_B // CHUNK
ROT_DIM = HEAD_DIM // 4
ROPE_THETA = 500000.0
D_FF = -(-8 * D_MODEL // (3 * 256)) * 256
D_PLE = 256
RMS_EPS = 1e-6
SCALE = HEAD_DIM ** -0.5

kernel_name = "hybrid_chunk_stream_encoder_step"


def rms_norm(x, g):
    xf = x.astype(jnp.float32)
    y = xf * lax.rsqrt(jnp.mean(xf * xf, axis=-1, keepdims=True) + RMS_EPS)
    return (y * g.astype(jnp.float32)).astype(x.dtype)


def partial_rope(x, pos):
    inv = ROPE_THETA ** (-jnp.arange(0, ROT_DIM, 2, dtype=jnp.float32) / ROT_DIM)
    ang = pos.astype(jnp.float32)[:, None] * inv[None, :]
    cos = jnp.cos(ang)[:, None, :]
    sin = jnp.sin(ang)[:, None, :]
    xr = x[..., :ROT_DIM].astype(jnp.float32)
    x1, x2 = xr[..., :ROT_DIM // 2], xr[..., ROT_DIM // 2:]
    rot = jnp.concatenate([x1 * cos - x2 * sin, x2 * cos + x1 * sin], axis=-1).astype(x.dtype)
    return jnp.concatenate([rot, x[..., ROT_DIM:]], axis=-1)


def chunk_band(x, n_prev):
    b, s = x.shape[0], x.shape[1]
    nc = s // CHUNK
    xc = x.reshape(b, nc, CHUNK, *x.shape[2:])
    xp = jnp.pad(xc, [(0, 0), (n_prev, 0)] + [(0, 0)] * (xc.ndim - 2))
    return jnp.concatenate([xp[:, j:j + nc] for j in range(n_prev + 1)], axis=2)


def band_valid(nc, n_prev):
    c = jnp.arange(nc)[:, None]
    j = jnp.arange((n_prev + 1) * CHUNK)[None, :]
    return (c - n_prev + j // CHUNK) >= 0


def rel_attention(q, k, v, dist, rel_bias, valid):
    s = jnp.einsum('...qhd,...khd->...hqk', q, k, preferred_element_type=jnp.float32) * SCALE
    s = s + rel_bias.astype(jnp.float32)[:, jnp.clip(dist, -REL_CLIP, REL_CLIP) + REL_CLIP]
    if valid is not None:
        s = jnp.where(valid, s, -jnp.inf)
    p = jax.nn.softmax(s, axis=-1).astype(v.dtype)
    return jnp.einsum('...hqk,...khd->...qhd', p, v)


def sink_gqa_attention(q, k, v, sinks, valid):
    qg = q.reshape(*q.shape[:-2], N_KV_B, GROUP_B, HEAD_DIM)
    s = jnp.einsum('...qhgd,...khd->...hgqk', qg, k, preferred_element_type=jnp.float32) * SCALE
    if valid is not None:
        s = jnp.where(valid, s, -jnp.inf)
    sk = sinks.astype(jnp.float32).reshape(N_KV_B, GROUP_B)[:, :, None, None]
    m = jnp.maximum(jnp.max(s, axis=-1, keepdims=True), sk)
    e = jnp.exp(s - m)
    p = (e / (jnp.sum(e, axis=-1, keepdims=True) + jnp.exp(sk - m))).astype(v.dtype)
    o = jnp.einsum('...hgqk,...khd->...qhgd', p, v)
    return o.reshape(*o.shape[:-3], N_HEADS_B, HEAD_DIM)


def mixer_inputs(h, g_norm, w_in):
    n = rms_norm(h, g_norm)
    z = n @ w_in
    b, s = h.shape[0], h.shape[1]
    o1 = WIDTH_A; o2 = 2 * WIDTH_A; o3 = 3 * WIDTH_A; o4 = o3 + WIDTH_B; o5 = o4 + KV_WIDTH_B
    qa = z[..., :o1].reshape(b, s, N_HEADS_A, HEAD_DIM)
    ka = z[..., o1:o2].reshape(b, s, N_HEADS_A, HEAD_DIM)
    va = z[..., o2:o3].reshape(b, s, N_HEADS_A, HEAD_DIM)
    qb = z[..., o3:o4].reshape(b, s, N_HEADS_B, HEAD_DIM)
    kb = z[..., o4:o5].reshape(b, s, N_KV_B, HEAD_DIM)
    vb = z[..., o5:].reshape(b, s, N_KV_B, HEAD_DIM)
    return qa, ka, va, qb, kb, vb


def layer_tail(h, oa, ob, p_i, g_out_a, g_out_b, w_out, g_ffn, w_gate_up, w_down, w_ple_proj, w_ple_gate):
    o = jnp.concatenate([rms_norm(oa, g_out_a), rms_norm(ob, g_out_b)], axis=-1)
    h = h + o @ w_out
    gu = rms_norm(h, g_ffn) @ w_gate_up
    h = h + (jax.nn.silu(gu[..., :D_FF]) * gu[..., D_FF:]) @ w_down
    return h + jax.nn.sigmoid(h @ w_ple_gate) * (p_i @ w_ple_proj)


def setup_inputs(seed: int = 0) -> dict:
    key = jax.random.key(seed)
    ks = jax.random.split(key, 24)
    f32 = jnp.float32
    la = min(A_ROWS, PAST_LEN)
    lb = min(WINDOW_B, PAST_LEN)
    nrm = lambda k, shape, sc: jax.random.normal(k, shape, f32) * sc
    return {
        "x_prompt": nrm(ks[0], (BATCH, SEQ, D_MODEL), 1.0),
        "x_sample": nrm(ks[1], (DEC_BATCH, DEC_SEQ, D_MODEL), 1.0),
        "p_prompt": nrm(ks[2], (DEPTH, BATCH, SEQ, D_PLE), 1.0),
        "p_sample": nrm(ks[3], (DEPTH, DEC_BATCH, DEC_SEQ, D_PLE), 1.0),
        "cache_a_k": nrm(ks[4], (DEPTH, DEC_BATCH, la, N_HEADS_A, HEAD_DIM), 1.0),
        "cache_a_v": nrm(ks[5], (DEPTH, DEC_BATCH, la, N_HEADS_A, HEAD_DIM), 1.0),
        "cache_b_k": nrm(ks[6], (DEPTH, DEC_BATCH, lb, N_KV_B, HEAD_DIM), 1.0),
        "cache_b_v": nrm(ks[7], (DEPTH, DEC_BATCH, lb, N_KV_B, HEAD_DIM), 1.0),
        "g_mix_norm": 1.0 + nrm(ks[8], (DEPTH, D_MODEL), 0.05),
        "w_in": nrm(ks[9], (DEPTH, D_MODEL, IN_WIDTH), D_MODEL ** -0.5),
        "rel_bias_a": nrm(ks[10], (DEPTH, N_HEADS_A, 2 * REL_CLIP + 1), 0.2),
        "sinks_b": nrm(ks[11], (DEPTH, N_HEADS_B), 0.5),
        "g_out_a": 1.0 + nrm(ks[12], (DEPTH, WIDTH_A), 0.05),
        "g_out_b": 1.0 + nrm(ks[13], (DEPTH, WIDTH_B), 0.05),
        "w_out": nrm(ks[14], (DEPTH, MIX_WIDTH, D_MODEL), MIX_WIDTH ** -0.5),
        "g_ffn_norm": 1.0 + nrm(ks[15], (DEPTH, D_MODEL), 0.05),
        "w_gate_up": nrm(ks[16], (DEPTH, D_MODEL, 2 * D_FF), D_MODEL ** -0.5),
        "w_down": nrm(ks[17], (DEPTH, D_FF, D_MODEL), D_FF ** -0.5),
        "w_ple_proj": nrm(ks[18], (DEPTH, D_PLE, D_MODEL), D_PLE ** -0.5),
        "w_ple_gate": nrm(ks[19], (DEPTH, D_MODEL, D_MODEL), D_MODEL ** -0.5),
        "g_final": 1.0 + nrm(ks[20], (D_MODEL,), 0.05),
    }


def reference(x_prompt, x_sample, p_prompt, p_sample, cache_a_k, cache_a_v, cache_b_k, cache_b_v,
              g_mix_norm, w_in, rel_bias_a, sinks_b, g_out_a, g_out_b, w_out, g_ffn_norm,
              w_gate_up, w_down, w_ple_proj, w_ple_gate, g_final):
    b_p, s_p = x_prompt.shape[0], x_prompt.shape[1]
    b_s, t_s = x_sample.shape[0], x_sample.shape[1]
    nc = s_p // CHUNK
    la_c = cache_a_k.shape[2]
    lb_c = cache_b_k.shape[2]
    keep_a_p = min(A_ROWS, s_p)
    keep_b_p = min(WINDOW_B, s_p)
    keep_a_s = min(A_ROWS, la_c + t_s)
    keep_b_s = min(WINDOW_B, lb_c + t_s)

    pos_p = jnp.arange(s_p)
    la_band = (PREV_CHUNKS_A + 1) * CHUNK
    dist_p = PREV_CHUNKS_A * CHUNK + jnp.arange(CHUNK)[:, None] - jnp.arange(la_band)[None, :]
    valid_a = band_valid(nc, PREV_CHUNKS_A)[:, None, None, :]
    valid_b = band_valid(nc, PREV_CHUNKS_B)[:, None, None, None, :]
    qpos_s = PAST_LEN + jnp.arange(t_s)
    kpos_s = PAST_LEN - la_c + jnp.arange(la_c + t_s)
    dist_s = qpos_s[:, None] - kpos_s[None, :]

    hp, hs = x_prompt, x_sample
    nak_p, nav_p, nbk_p, nbv_p = [], [], [], []
    nak_s, nav_s, nbk_s, nbv_s = [], [], [], []
    for i in range(DEPTH):
        tail = (g_out_a[i], g_out_b[i], w_out[i], g_ffn_norm[i], w_gate_up[i], w_down[i],
                w_ple_proj[i], w_ple_gate[i])
        qa, ka, va, qb, kb, vb = mixer_inputs(hp, g_mix_norm[i], w_in[i])
        qb = partial_rope(qb, pos_p)
        kb = partial_rope(kb, pos_p)
        oa = rel_attention(qa.reshape(b_p, nc, CHUNK, N_HEADS_A, HEAD_DIM),
                           chunk_band(ka, PREV_CHUNKS_A), chunk_band(va, PREV_CHUNKS_A),
                           dist_p, rel_bias_a[i], valid_a).reshape(b_p, s_p, WIDTH_A)
        ob = sink_gqa_attention(qb.reshape(b_p, nc, CHUNK, N_HEADS_B, HEAD_DIM),
                                chunk_band(kb, PREV_CHUNKS_B), chunk_band(vb, PREV_CHUNKS_B),
                                sinks_b[i], valid_b).reshape(b_p, s_p, WIDTH_B)
        hp = layer_tail(hp, oa, ob, p_prompt[i], *tail)
        nak_p.append(ka[:, s_p - keep_a_p:])
        nav_p.append(va[:, s_p - keep_a_p:])
        nbk_p.append(kb[:, s_p - keep_b_p:])
        nbv_p.append(vb[:, s_p - keep_b_p:])

        qa, ka, va, qb, kb, vb = mixer_inputs(hs, g_mix_norm[i], w_in[i])
        ka_all = jnp.concatenate([cache_a_k[i], ka], axis=1)
        va_all = jnp.concatenate([cache_a_v[i], va], axis=1)
        oa = rel_attention(qa, ka_all, va_all, dist_s, rel_bias_a[i], None).reshape(b_s, t_s, WIDTH_A)
        qb = partial_rope(qb, qpos_s)
        kb = partial_rope(kb, qpos_s)
        kb_all = jnp.concatenate([cache_b_k[i], kb], axis=1)
        vb_all = jnp.concatenate([cache_b_v[i], vb], axis=1)
        ob = sink_gqa_attention(qb, kb_all, vb_all, sinks_b[i], None).reshape(b_s, t_s, WIDTH_B)
        hs = layer_tail(hs, oa, ob, p_sample[i], *tail)
        nak_s.append(ka_all[:, la_c + t_s - keep_a_s:])
        nav_s.append(va_all[:, la_c + t_s - keep_a_s:])
        nbk_s.append(kb_all[:, lb_c + t_s - keep_b_s:])
        nbv_s.append(vb_all[:, lb_c + t_s - keep_b_s:])

    y_prompt = rms_norm(hp, g_final)
    y_sample = rms_norm(hs, g_final)
    return (y_prompt, y_sample,
            jnp.stack(nak_p), jnp.stack(nav_p), jnp.stack(nbk_p), jnp.stack(nbv_p),
            jnp.stack(nak_s), jnp.stack(nav_s), jnp.stack(nbk_s), jnp.stack(nbv_s))
```

```cpp
#include <hip/hip_runtime.h>
#include <hip/hip_cooperative_groups.h>
#include <cstdio>
#include <cstdint>
namespace cg = cooperative_groups;

#define GAS __attribute__((address_space(1)))
#define LAS __attribute__((address_space(3)))
typedef unsigned short bf16;
typedef unsigned v4u __attribute__((ext_vector_type(4)));
typedef unsigned v2u __attribute__((ext_vector_type(2)));
typedef float f32x4 __attribute__((ext_vector_type(4)));
typedef short bf16x8 __attribute__((ext_vector_type(8)));
typedef short s16x4 __attribute__((ext_vector_type(4)));

constexpr int MP = 32768, MS = 1024, MT = MP + MS;
constexpr int DM = 1024, NIN = 2304, FF = 2816, DPLE = 256;
constexpr float EPS = 1e-6f;
constexpr float LOG2E = 1.4426950408889634f;
constexpr float QSCALE = 0.125f * LOG2E;

__device__ __forceinline__ unsigned cvt_pk(float lo, float hi) { unsigned r; asm("v_cvt_pk_bf16_f32 %0, %1, %2" : "=v"(r) : "v"(lo), "v"(hi)); return r; }
__device__ __forceinline__ float bf_lo(unsigned w) { return __builtin_bit_cast(float, w << 16); }
__device__ __forceinline__ float bf_hi(unsigned w) { return __builtin_bit_cast(float, w & 0xffff0000u); }
__device__ __forceinline__ float fexp2(float x) { return __builtin_amdgcn_exp2f(x); }
__device__ __forceinline__ float frcp(float x) { return __builtin_amdgcn_rcpf(x); }

__device__ __forceinline__ int lane_id() { int l = __builtin_amdgcn_mbcnt_hi(~0u, __builtin_amdgcn_mbcnt_lo(~0u, 0u)); asm volatile("" : "+v"(l)); return l; }

namespace pg8 {
constexpr int BM = 256, BK = 64, HALF = 128, HTB = HALF * BK * 2, STAGE_BYTES = 8 * HTB, NXCD = 8, WGM = 8;
__host__ __device__ __forceinline__ int lds_byte(int r, int c) { const int st = (r >> 4) * 2 + (c >> 5), rr = r & 15, cc = c & 31, ob = rr * 64 + cc * 2; return st * 1024 + (ob ^ (((ob >> 9) & 1) << 5)); }
__host__ __device__ __forceinline__ void stage_rc(int b, int& R, int& C) { const int st = b / 1024, sb = b % 1024, swz = sb ^ (((sb >> 9) & 1) << 5); R = (st >> 1) * 16 + swz / 64; C = (st & 1) * 32 + (swz % 64) / 2; }
__host__ __device__ __forceinline__ int perm32(int rho) { const int n = rho >> 4, i = rho & 15; return 8 * (i >> 2) + 4 * n + (i & 3); }

struct Unit { int pm, pn; };
struct Gemm { const bf16* A; const bf16* Bt; int M, N, K; };

template <int NN>
struct RowOrder {
    int G, v;
    __device__ __forceinline__ void init(int G_, int c) { G = G_; v = (G_ % 8 == 0) ? (c % 8) * (G_ / 8) + c / 8 : c; }
    __device__ __forceinline__ bool next(int i, Unit& u) const {
        const int L = i * G + v; if (L >= (33792 / BM) * NN) return false;
        constexpr int NM = 33792 / BM, NFULL = (NM / 8) * 8 * NN;
        if (L < NFULL) { const int g = L / (8 * NN), idx = L % (8 * NN); u.pm = g * 8 + (idx & 7); u.pn = idx >> 3; }
        else { constexpr int GS = NM % 8 ? NM % 8 : 8; const int idx = L - NFULL; u.pm = (NM / 8) * 8 + idx % GS; u.pn = idx / GS; }
        return true;
    }
};

template <int KK, class Epi, class Sched, bool ALIGN_EPI = true>
__device__ __forceinline__ void gemm_phase(LAS unsigned char* lds, const bf16* gA, const bf16* gBt, const Sched& S, const Epi& E, const int wid) {
    const int lane = lane_id();
    const int tid = wid * 64 + lane, wr = wid >> 2, wc = wid & 3, fr = lane & 15, fq = lane >> 4;
    constexpr int K = KK, nt = K / BK;
    unsigned voffA[2], voffB[2];
#pragma unroll
    for (int i = 0; i < 2; ++i) { int R, C; stage_rc(tid * 16 + i * 8192, R, C); const int Rb = Epi::PERM ? ((R & ~31) + perm32(R & 31)) : R;
        voffA[i] = (unsigned)(R * K + C) * 2u; voffB[i] = (unsigned)(Rb * K + C) * 2u; }
    const size_t kstep = (size_t)(BK * 2);
    const size_t hstep = (size_t)HALF * K * 2;
    const size_t tstep = 2 * hstep;
    const unsigned ldsw = (unsigned)wid * 1024u;
    const int aoff = lds_byte(wr * 64 + fr, fq * 8), boff = lds_byte(wc * 32 + fr, fq * 8);
#define PG8_SA(b, h) (((b) * 2 + (h)) * HTB)
#define PG8_SB(b, h) ((4 + (b) * 2 + (h)) * HTB)
#define PG8_STAGE(bufoff, gbase, voff) do { _Pragma("unroll") for (int _i = 0; _i < 2; ++_i) \
        __builtin_amdgcn_global_load_lds((const unsigned*)((const char*)(gbase) + (voff)[_i]), (LAS unsigned*)(lds + (bufoff) + ldsw + _i * 8192), 16, 0, 0); } while (0)
#define PG8_LDA(dst, b, h) do { _Pragma("unroll") for (int m = 0; m < 4; ++m) _Pragma("unroll") for (int k = 0; k < 2; ++k) dst[m][k] = *(const LAS bf16x8*)(lds + PG8_SA(b, h) + aoff + m * 2048 + k * 1024); } while (0)
#define PG8_LDB(dst, b, h) do { _Pragma("unroll") for (int n = 0; n < 2; ++n) _Pragma("unroll") for (int k = 0; k < 2; ++k) dst[n][k] = *(const LAS bf16x8*)(lds + PG8_SB(b, h) + boff + n * 2048 + k * 1024); } while (0)
#define PG8_MMA(ai, bj, At, Bt) do { __builtin_amdgcn_s_setprio(1); _Pragma("unroll") for (int m = 0; m < 4; ++m) _Pragma("unroll") for (int n = 0; n < 2; ++n) _Pragma("unroll") for (int k = 0; k < 2; ++k) \
        acc[ai][bj][m][n] = __builtin_amdgcn_mfma_f32_16x16x32_bf16(Bt[n][k], At[m][k], acc[ai][bj][m][n], 0, 0, 0); __builtin_amdgcn_s_setprio(0); } while (0)
#define PG8_WAIT_V(n) asm volatile("s_waitcnt vmcnt(" #n ")" ::: "memory")
#define PG8_WAIT_L(n) asm volatile("s_waitcnt lgkmcnt(" #n ")" ::: "memory")
#define PG8_BAR __builtin_amdgcn_s_barrier()
#define PG8_SCHED __builtin_amdgcn_sched_barrier(0)
    Unit cur, nxt; int ui = 0;
    if (!S.next(0, cur)) return;
    f32x4 acc[2][2][4][2];
#pragma unroll
    for (int a = 0; a < 2; ++a)
#pragma unroll
        for (int b = 0; b < 2; ++b)
#pragma unroll
            for (int m = 0; m < 4; ++m)
#pragma unroll
                for (int n = 0; n < 2; ++n) acc[a][b][m][n] = (f32x4){0.f, 0.f, 0.f, 0.f};
    bf16x8 At[4][2], B0[2][2], B1[2][2];
    const char* cA = (const char*)gA + (size_t)cur.pm * tstep; const char* cB = (const char*)gBt + (size_t)cur.pn * tstep;
    PG8_STAGE(PG8_SB(0, 0), cB, voffB); PG8_STAGE(PG8_SB(0, 1), cB + hstep, voffB); PG8_STAGE(PG8_SA(0, 0), cA, voffA); PG8_STAGE(PG8_SA(0, 1), cA + hstep, voffA);
    if (wr == 1) PG8_BAR;
    PG8_WAIT_V(2); PG8_BAR;
    PG8_STAGE(PG8_SB(1, 0), cB + kstep, voffB); PG8_STAGE(PG8_SA(1, 0), cA + kstep, voffA); PG8_STAGE(PG8_SB(1, 1), cB + hstep + kstep, voffB);
    PG8_WAIT_V(6); PG8_BAR;
    for (;;) {
        const bool has_next = S.next(ui + 1, nxt);
        const char* nA = has_next ? (const char*)gA + (size_t)nxt.pm * tstep : cA; const char* nB = has_next ? (const char*)gBt + (size_t)nxt.pn * tstep : cB;
#pragma unroll 1
        for (int t = 0; t < nt; t += 2) {
            const bool last = (t == nt - 2);
            const char* a1 = cA + (size_t)(t + 1) * kstep;
            const char* a2 = last ? nA : cA + (size_t)(t + 2) * kstep; const char* b2 = last ? nB : cB + (size_t)(t + 2) * kstep;
            const char* a3 = a2 + kstep; const char* b3 = b2 + kstep;
            PG8_LDB(B0, 0, 0); PG8_LDB(B1, 0, 1); PG8_SCHED; PG8_LDA(At, 0, 0); PG8_STAGE(PG8_SA(1, 1), a1 + hstep, voffA);
            PG8_WAIT_V(8); PG8_WAIT_L(0); PG8_BAR; PG8_MMA(0, 0, At, B0); PG8_MMA(0, 1, At, B1); PG8_BAR; PG8_SCHED;
            PG8_LDA(At, 0, 1); PG8_STAGE(PG8_SB(0, 0), b2, voffB); PG8_STAGE(PG8_SB(0, 1), b2 + hstep, voffB); PG8_STAGE(PG8_SA(0, 0), a2, voffA);
            PG8_WAIT_V(8); PG8_WAIT_L(0); PG8_BAR; PG8_MMA(1, 0, At, B0); PG8_MMA(1, 1, At, B1); PG8_BAR; PG8_SCHED;
            PG8_LDB(B0, 1, 0); PG8_LDB(B1, 1, 1); PG8_SCHED; PG8_LDA(At, 1, 0); PG8_STAGE(PG8_SA(0, 1), a2 + hstep, voffA);
            PG8_WAIT_V(8); PG8_WAIT_L(0); PG8_BAR; PG8_MMA(0, 0, At, B0); PG8_MMA(0, 1, At, B1); PG8_BAR; PG8_SCHED;
            PG8_LDA(At, 1, 1); PG8_STAGE(PG8_SB(1, 0), b3, voffB); PG8_STAGE(PG8_SB(1, 1), b3 + hstep, voffB); PG8_STAGE(PG8_SA(1, 0), a3, voffA);
            PG8_WAIT_V(8); PG8_WAIT_L(0); PG8_BAR; PG8_MMA(1, 0, At, B0); PG8_MMA(1, 1, At, B1); PG8_BAR; PG8_SCHED;
        }
        if constexpr (ALIGN_EPI) { if (wr == 0) PG8_BAR; }
        E(acc, cur, wr, wc, fr, fq);
        if (!has_next) break;
#pragma unroll
        for (int a = 0; a < 2; ++a)
#pragma unroll
            for (int b = 0; b < 2; ++b)
#pragma unroll
                for (int m = 0; m < 4; ++m)
#pragma unroll
                    for (int n = 0; n < 2; ++n) acc[a][b][m][n] = (f32x4){0.f, 0.f, 0.f, 0.f};
        cur = nxt; cA = nA; cB = nB; ++ui;
        if constexpr (ALIGN_EPI) { if (wr == 1) PG8_BAR; }
    }
    PG8_WAIT_V(0);
    if constexpr (!ALIGN_EPI) { if (wr == 0) PG8_BAR; }
    PG8_BAR;
#undef PG8_SA
#undef PG8_SB
#undef PG8_STAGE
#undef PG8_LDA
#undef PG8_LDB
#undef PG8_MMA
#undef PG8_WAIT_V
#undef PG8_WAIT_L
#undef PG8_BAR
#undef PG8_SCHED
}
}

constexpr size_t MiB = 1u << 20;
constexpr size_t WS_CTL = 0;
constexpr size_t WS_SSQ = 4096;
constexpr size_t WS_ROPE = 1 * MiB;
constexpr size_t WS_W = 2 * MiB;
constexpr size_t W_IN = 0, W_OUT = W_IN + (size_t)NIN * DM * 2, W_GU = W_OUT + (size_t)DM * DM * 2, W_D = W_GU + (size_t)2 * FF * DM * 2,
                 W_PP = W_D + (size_t)DM * FF * 2, W_PG = W_PP + (size_t)DM * DPLE * 2, W_LAYER = W_PG + (size_t)DM * DM * 2;
constexpr size_t WS_XB = WS_W + 2 * W_LAYER + MiB;
constexpr size_t ACT_DM = (size_t)MT * DM * 2;
constexpr size_t WS_HB = WS_XB + ACT_DM;
constexpr size_t WS_Z = WS_HB + ACT_DM;
constexpr size_t WS_O = WS_Z + (size_t)MT * NIN * 2;
constexpr size_t WS_ACT = WS_Z;
constexpr size_t WS_PB = WS_O + ACT_DM;
constexpr size_t WS_CKA = WS_PB + (size_t)2 * MT * DPLE * 2;
constexpr size_t CA_BYTES = (size_t)2 * 16 * 512 * 512 * 2, CB_BYTES = (size_t)2 * 16 * 128 * 128 * 2;
constexpr size_t WS_CVA = WS_CKA + CA_BYTES, WS_CKB = WS_CVA + CA_BYTES, WS_CVB = WS_CKB + CB_BYTES, WS_END = WS_CVB + CB_BYTES;
static_assert((size_t)MT * FF * 2 <= (size_t)MT * NIN * 2 + ACT_DM, "ACT overlay fits Z|O");
static_assert(WS_END <= 512 * MiB, "workspace map");

constexpr size_t O_Y = 0, O_AKP = (size_t)MT * DM, O_AVP = O_AKP + 2 * 2 * 512 * 512, O_BKP = O_AVP + 2 * 2 * 512 * 512, O_BVP = O_BKP + 2 * 2 * 128 * 128,
                 O_AKS = O_BVP + 2 * 2 * 128 * 128, O_AVS = O_AKS + (size_t)2 * 16 * 512 * 512, O_BKS = O_AVS + (size_t)2 * 16 * 512 * 512, O_BVS = O_BKS + 2 * 16 * 128 * 128,
                 O_END = O_BVS + 2 * 16 * 128 * 128;

constexpr int LDS_BYTES = 131072 + 4096;
constexpr int W_ITEMS_EARLY = (DM / 64) * (NIN / 32) + (DM / 64) * (DM / 32);
constexpr int NWAVES = 8;

typedef const f32x4 (&AccRef)[2][2][4][2];

struct EpiIn {
    static constexpr bool PERM = true;
    unsigned char* ws_; float* out_; int ssq_off; int l;
    __device__ __forceinline__ void operator()(AccRef acc, const pg8::Unit& u, int wr, int wc, int, int) const {
        GAS unsigned char* wsg_ = (GAS unsigned char*)ws_; GAS float* outg_ = (GAS float*)out_; asm volatile("" : "+s"(wsg_), "+s"(outg_)); unsigned char* ws = (unsigned char*)wsg_; float* out = (float*)outg_;
        const int lane_ = lane_id(); const int fr = lane_ & 15, fq = lane_ >> 4;
        const float* ssq = (const float*)(ws + WS_SSQ) + ssq_off;
        const int pn = u.pn, pm = u.pm;
        const bool samp = pm >= (MP / 256);
        const bool isq = (pn < 2) || (pn == 6) || (pn == 7);
        bf16* Z = (bf16*)(ws + WS_Z); const float* rope = (const float*)(ws + WS_ROPE);
        const bool wrA = (pn >= 2 && pn <= 5) && (samp || (pm & 63) >= 62);
        const bool wrB = (pn == 8) && (samp || (pm & 63) == 63);
        float sq[2][4];
#pragma unroll
        for (int ai = 0; ai < 2; ++ai)
#pragma unroll
            for (int m = 0; m < 4; ++m) sq[ai][m] = ssq[pm * 256 + ai * 128 + wr * 64 + m * 16 + fr];
        asm volatile("" ::: "memory");
#pragma unroll
        for (int ai = 0; ai < 2; ++ai)
#pragma unroll
            for (int m = 0; m < 4; ++m) {
                const int row = pm * 256 + ai * 128 + wr * 64 + m * 16 + fr;
                const float rstd = __builtin_amdgcn_rsqf(sq[ai][m] * (1.0f / DM) + EPS) * (isq ? QSCALE : 1.0f);
                const int pos = samp ? 2048 + ((row - MP) & 63) : (row & 16383);
#pragma unroll
                for (int bj = 0; bj < 2; ++bj) {
                    const int c0 = pn * 256 + bj * 128 + wc * 32 + 8 * fq;
                    float v[8];
#pragma unroll
                    for (int j = 0; j < 4; ++j) { v[j] = acc[ai][bj][m][0][j] * rstd; v[4 + j] = acc[ai][bj][m][1][j] * rstd; }
                    const bool ropet = (pn == 6 || pn == 7 || (pn == 8 && bj == 0)) && ((wc & 1) == 0);
                    if (ropet) {
                        float pv[8];
#pragma unroll
                        for (int j = 0; j < 8; ++j) pv[j] = __shfl_xor(v[j], 16);
                        if (fq < 2) {
                            const f32x4* cs = (const f32x4*)(rope + (size_t)pos * 16);
                            const float sg = (fq == 0) ? -1.f : 1.f;
#pragma unroll
                            for (int jj = 0; jj < 4; ++jj) { const f32x4 t = cs[jj];
                                v[2 * jj] = v[2 * jj] * t[0] + sg * pv[2 * jj] * t[1];
                                v[2 * jj + 1] = v[2 * jj + 1] * t[2] + sg * pv[2 * jj + 1] * t[3]; }
                        }
                    }
                    v4u w; w.x = cvt_pk(v[0], v[1]); w.y = cvt_pk(v[2], v[3]); w.z = cvt_pk(v[4], v[5]); w.w = cvt_pk(v[6], v[7]);
                    *(v4u*)(Z + (size_t)row * NIN + c0) = w;
                    if (wrA) {
                        const int colA = c0 - (pn < 4 ? 512 : 1024);
                        float* dst;
                        if (samp) { const int rs = row - MP; dst = out + (pn < 4 ? O_AKS : O_AVS) + (size_t)l * 16 * 512 * 512 + ((size_t)((rs >> 6) * 512 + 448 + (rs & 63))) * 512 + colA; }
                        else { const int sq = (row & 16383) - 15872; dst = out + (pn < 4 ? O_AKP : O_AVP) + (size_t)l * 2 * 512 * 512 + ((size_t)((row >> 14) * 512 + sq)) * 512 + colA; }
                        *(f32x4*)dst = (f32x4){v[0], v[1], v[2], v[3]}; *(f32x4*)(dst + 4) = (f32x4){v[4], v[5], v[6], v[7]};
                    }
                    if (wrB && (samp || ai == 1)) {
                        const int colB = c0 - (bj == 0 ? 2048 : 2176);
                        float* dst;
                        if (samp) { const int rs = row - MP; dst = out + (bj == 0 ? O_BKS : O_BVS) + (size_t)l * 16 * 128 * 128 + ((size_t)((rs >> 6) * 128 + 64 + (rs & 63))) * 128 + colB; }
                        else { const int sq = (row & 16383) - 16256; dst = out + (bj == 0 ? O_BKP : O_BVP) + (size_t)l * 2 * 128 * 128 + ((size_t)((row >> 14) * 128 + sq)) * 128 + colB; }
                        *(f32x4*)dst = (f32x4){v[0], v[1], v[2], v[3]}; *(f32x4*)(dst + 4) = (f32x4){v[4], v[5], v[6], v[7]};
                    }
                }
            }
    }
};

#define EPI_ENTRY() GAS unsigned char* wsg_ = (GAS unsigned char*)ws_; GAS float* outg_ = (GAS float*)out_; asm volatile("" : "+s"(wsg_), "+s"(outg_)); unsigned char* ws = (unsigned char*)wsg_; float* out = (float*)outg_; const int lane_ = lane_id(); const int fr = lane_ & 15, fq = lane_ >> 4; (void)ws; (void)out

struct EpiRes {
    static constexpr bool PERM = true;
    unsigned char* ws_; float* out_; const float *xp, *xs; int from_xb; int ssq_off;
    __device__ __forceinline__ void operator()(AccRef acc, const pg8::Unit& u, int wr, int wc, int, int) const {
        EPI_ENTRY();
        bf16* HB = (bf16*)(ws + WS_HB); const bf16* RB = (const bf16*)(ws + (from_xb ? WS_XB : WS_HB)); float* ssq = (float*)(ws + WS_SSQ) + ssq_off;
#pragma unroll
        for (int ai = 0; ai < 2; ++ai) {
            f32x4 r0[4][2], r1[4][2];
            if (xp) {
#pragma unroll
                for (int m = 0; m < 4; ++m) { const int row = u.pm * 256 + ai * 128 + wr * 64 + m * 16 + fr;
                    const float* rsrc = (row < MP) ? xp + (size_t)row * DM : xs + (size_t)(row - MP) * DM;
#pragma unroll
                    for (int bj = 0; bj < 2; ++bj) { const int c0 = u.pn * 256 + bj * 128 + wc * 32 + 8 * fq; r0[m][bj] = *(const f32x4*)(rsrc + c0); r1[m][bj] = *(const f32x4*)(rsrc + c0 + 4); } }
            } else {
                v4u pw[4][2];
#pragma unroll
                for (int m = 0; m < 4; ++m) { const int row = u.pm * 256 + ai * 128 + wr * 64 + m * 16 + fr;
#pragma unroll
                    for (int bj = 0; bj < 2; ++bj) pw[m][bj] = *(const v4u*)(RB + (size_t)row * DM + u.pn * 256 + bj * 128 + wc * 32 + 8 * fq); }
#pragma unroll
                for (int m = 0; m < 4; ++m)
#pragma unroll
                    for (int bj = 0; bj < 2; ++bj) { const v4u w = pw[m][bj]; r0[m][bj] = (f32x4){bf_lo(w.x), bf_hi(w.x), bf_lo(w.y), bf_hi(w.y)}; r1[m][bj] = (f32x4){bf_lo(w.z), bf_hi(w.z), bf_lo(w.w), bf_hi(w.w)}; }
            }
            asm volatile("" ::: "memory");
#pragma unroll
            for (int m = 0; m < 4; ++m) {
                const int row = u.pm * 256 + ai * 128 + wr * 64 + m * 16 + fr;
                float ss = 0.f;
#pragma unroll
                for (int bj = 0; bj < 2; ++bj) {
                    const int c0 = u.pn * 256 + bj * 128 + wc * 32 + 8 * fq;
                    const f32x4 o0 = r0[m][bj] + acc[ai][bj][m][0], o1 = r1[m][bj] + acc[ai][bj][m][1];
                    v4u w; w.x = cvt_pk(o0[0], o0[1]); w.y = cvt_pk(o0[2], o0[3]); w.z = cvt_pk(o1[0], o1[1]); w.w = cvt_pk(o1[2], o1[3]);
                    *(v4u*)(HB + (size_t)row * DM + c0) = w;
                    ss += (o0[0] * o0[0] + o0[1] * o0[1]) + (o0[2] * o0[2] + o0[3] * o0[3]) + (o1[0] * o1[0] + o1[1] * o1[1]) + (o1[2] * o1[2] + o1[3] * o1[3]);
                }
                if (ssq_off >= 0) { ss += __shfl_xor(ss, 16); ss += __shfl_xor(ss, 32); if (fq == 0) __hip_atomic_fetch_add(ssq + row, ss, __ATOMIC_RELAXED, __HIP_MEMORY_SCOPE_AGENT); }
            }
        }
    }
};

typedef float f32x2 __attribute__((ext_vector_type(2)));
struct EpiGU {
    static constexpr bool PERM = true;
    unsigned char* ws_; float* out_; int ssq_off;
    __device__ __forceinline__ void operator()(AccRef acc, const pg8::Unit& u, int wr, int wc, int, int) const {
        EPI_ENTRY();
        bf16* ACT = (bf16*)(ws + WS_ACT); const float* ssq = (const float*)(ws + WS_SSQ) + ssq_off;
        float sq[2][4];
#pragma unroll
        for (int ai = 0; ai < 2; ++ai)
#pragma unroll
            for (int m = 0; m < 4; ++m) sq[ai][m] = ssq[u.pm * 256 + ai * 128 + wr * 64 + m * 16 + fr];
        asm volatile("" ::: "memory");
#pragma unroll
        for (int ai = 0; ai < 2; ++ai)
#pragma unroll
            for (int m = 0; m < 4; ++m) {
                const int row = u.pm * 256 + ai * 128 + wr * 64 + m * 16 + fr;
                const float rstd = __builtin_amdgcn_rsqf(sq[ai][m] * (1.0f / DM) + EPS);
                const float rc = -rstd * LOG2E, r2 = rstd * rstd;
                unsigned pk[4];
#pragma unroll
                for (int n = 0; n < 2; ++n)
#pragma unroll
                    for (int h = 0; h < 2; ++h) {
                        const f32x2 g2 = {acc[ai][0][m][n][2 * h], acc[ai][0][m][n][2 * h + 1]}, u2 = {acc[ai][1][m][n][2 * h], acc[ai][1][m][n][2 * h + 1]};
                        const f32x2 x2 = g2 * rc; f32x2 d2; d2.x = fexp2(x2.x); d2.y = fexp2(x2.y); d2 = d2 + 1.0f;
                        f32x2 q2; q2.x = frcp(d2.x); q2.y = frcp(d2.y);
                        const f32x2 t2 = (g2 * u2) * r2 * q2;
                        pk[2 * n + h] = cvt_pk(t2.x, t2.y);
                    }
                v4u w; w.x = pk[0]; w.y = pk[1]; w.z = pk[2]; w.w = pk[3];
                *(v4u*)(ACT + (size_t)row * FF + u.pn * 128 + wc * 32 + 8 * fq) = w;
            }
    }
};

struct EpiPP {
    static constexpr bool PERM = true;
    unsigned char* ws_; float* out_;
    __device__ __forceinline__ void operator()(AccRef acc, const pg8::Unit& u, int wr, int wc, int, int) const {
        EPI_ENTRY();
        bf16* PP = (bf16*)(ws + WS_XB);
#pragma unroll
        for (int ai = 0; ai < 2; ++ai)
#pragma unroll
            for (int m = 0; m < 4; ++m) {
                const int row = u.pm * 256 + ai * 128 + wr * 64 + m * 16 + fr;
#pragma unroll
                for (int bj = 0; bj < 2; ++bj) {
                    const int c0 = u.pn * 256 + bj * 128 + wc * 32 + 8 * fq;
                    const f32x4 o0 = acc[ai][bj][m][0], o1 = acc[ai][bj][m][1];
                    v4u w; w.x = cvt_pk(o0[0], o0[1]); w.y = cvt_pk(o0[2], o0[3]); w.z = cvt_pk(o1[0], o1[1]); w.w = cvt_pk(o1[2], o1[3]);
                    *(v4u*)(PP + (size_t)row * DM + c0) = w;
                }
            }
    }
};

struct EpiPG {
    static constexpr bool PERM = true;
    unsigned char* ws_; float* out_; int ssq_off;
    __device__ __forceinline__ void operator()(AccRef acc, const pg8::Unit& u, int wr, int wc, int, int) const {
        EPI_ENTRY();
        const bf16* HB = (const bf16*)(ws + WS_HB); bf16* XB = (bf16*)(ws + WS_XB); float* ssq = (float*)(ws + WS_SSQ) + ssq_off;
#pragma unroll
        for (int ai = 0; ai < 2; ++ai) {
            v4u hwv[4][2], pwv[4][2];
#pragma unroll
            for (int m = 0; m < 4; ++m) { const int row = u.pm * 256 + ai * 128 + wr * 64 + m * 16 + fr;
#pragma unroll
                for (int bj = 0; bj < 2; ++bj) { const size_t off = (size_t)row * DM + u.pn * 256 + bj * 128 + wc * 32 + 8 * fq; hwv[m][bj] = *(const v4u*)(HB + off); pwv[m][bj] = *(const v4u*)(XB + off); } }
            asm volatile("" ::: "memory");
#pragma unroll
            for (int m = 0; m < 4; ++m) {
                const int row = u.pm * 256 + ai * 128 + wr * 64 + m * 16 + fr;
                float ss = 0.f;
#pragma unroll
                for (int bj = 0; bj < 2; ++bj) {
                    const int c0 = u.pn * 256 + bj * 128 + wc * 32 + 8 * fq;
                    const v4u hw = hwv[m][bj], pw = pwv[m][bj];
                    const float hh[8] = {bf_lo(hw.x), bf_hi(hw.x), bf_lo(hw.y), bf_hi(hw.y), bf_lo(hw.z), bf_hi(hw.z), bf_lo(hw.w), bf_hi(hw.w)};
                    const float pp[8] = {bf_lo(pw.x), bf_hi(pw.x), bf_lo(pw.y), bf_hi(pw.y), bf_lo(pw.z), bf_hi(pw.z), bf_lo(pw.w), bf_hi(pw.w)};
                    float o[8];
#pragma unroll
                    for (int j = 0; j < 4; ++j) {
                        o[j] = hh[j] + pp[j] * frcp(1.0f + fexp2(-acc[ai][bj][m][0][j] * LOG2E));
                        o[4 + j] = hh[4 + j] + pp[4 + j] * frcp(1.0f + fexp2(-acc[ai][bj][m][1][j] * LOG2E));
                    }
                    v4u w; w.x = cvt_pk(o[0], o[1]); w.y = cvt_pk(o[2], o[3]); w.z = cvt_pk(o[4], o[5]); w.w = cvt_pk(o[6], o[7]);
                    *(v4u*)(XB + (size_t)row * DM + c0) = w;
#pragma unroll
                    for (int j = 0; j < 8; ++j) ss += o[j] * o[j];
                }
                ss += __shfl_xor(ss, 16); ss += __shfl_xor(ss, 32);
                if (fq == 0) __hip_atomic_fetch_add(ssq + row, ss, __ATOMIC_RELAXED, __HIP_MEMORY_SCOPE_AGENT);
            }
        }
    }
};

template <bool GU>
__device__ __forceinline__ void transpose_item(const float* W, int K, int N, bf16* WT, const float* gs, LAS float* scr, int item, int lane) {
    const int nblk = N / 32, kb = item / nblk, nb = item % nblk, k0 = 64 * kb, n0 = 32 * nb;
#pragma unroll 16
    for (int i = 0; i < 32; ++i) { const int kk = 2 * i + (lane >> 5); float w = W[(size_t)(k0 + kk) * N + n0 + (lane & 31)]; if (gs) w *= gs[k0 + kk]; scr[kk * 33 + (lane & 31)] = w; }
    asm volatile("s_waitcnt lgkmcnt(0)" ::: "memory");
    int d0 = n0;
    if (GU) { const int f = (n0 < FF) ? n0 : n0 - FF; d0 = 256 * (f >> 7) + (f & 127) + ((n0 < FF) ? 0 : 128); }
    const int c = lane & 7;
#pragma unroll
    for (int j = 0; j < 4; ++j) { const int n = (lane >> 3) + 8 * j; const LAS float* s = scr + (8 * c) * 33 + n;
        v4u o; o.x = cvt_pk(s[0 * 33], s[1 * 33]); o.y = cvt_pk(s[2 * 33], s[3 * 33]); o.z = cvt_pk(s[4 * 33], s[5 * 33]); o.w = cvt_pk(s[6 * 33], s[7 * 33]);
        *(v4u*)(WT + (size_t)(d0 + n) * K + k0 + 8 * c) = o; }
    asm volatile("s_waitcnt lgkmcnt(0)" ::: "memory");
}

__device__ __forceinline__ void convert_flat(const float* src, bf16* dst, size_t n, size_t gtid, size_t gthreads) {
    for (size_t i = gtid * 8; i < n; i += gthreads * 8) {
        const f32x4 a = *(const f32x4*)(src + i), b = *(const f32x4*)(src + i + 4);
        v4u w; w.x = cvt_pk(a[0], a[1]); w.y = cvt_pk(a[2], a[3]); w.z = cvt_pk(b[0], b[1]); w.w = cvt_pk(b[2], b[3]);
        *(v4u*)(dst + i) = w;
    }
}

constexpr int AL_V = 0, AL_EXT = 65536, AL_RED = AL_EXT + 26624, AL_UNIT = AL_RED + 2048;
struct AttnArgs { const bf16 *Z, *CKA, *CVA, *CKB, *CVB; const float *sinks, *goa, *gob; bf16* O; unsigned* ctr; };

template <bool ISA>
__device__ __forceinline__ void attn_unit(LAS unsigned char* lds, const AttnArgs& T, int sc, int wave, int) {
    const int lane = lane_id();
    const int fr = lane & 15, fq = lane >> 4;
    const bool samp = sc >= 512;
    const int b = samp ? sc - 512 : sc >> 8, c = samp ? 255 : (sc & 255);
    const int row0 = samp ? MP + b * 64 : b * 16384 + c * 64;
    constexpr int NPREV = ISA ? 8 : 2;
    const int kc0 = (NPREV - c) > 0 ? (NPREV - c) : 0;
    const int hd = wave, kv = wave >> 2;
    const int qcol = ISA ? hd * 64 : 1536 + hd * 64;
    LAS unsigned char* vst = lds + AL_V + wave * 8192;
    const LAS float* ext = (const LAS float*)(lds + AL_EXT) + hd * 832;
    LAS float* red = (LAS float*)(lds + AL_RED);

    bf16x8 qf[4][2];
#pragma unroll
    for (int qb = 0; qb < 4; ++qb)
#pragma unroll
        for (int ks = 0; ks < 2; ++ks) qf[qb][ks] = *(const bf16x8*)((const char*)(T.Z + (size_t)(row0 + 16 * qb) * NIN + qcol + 32 * ks) + (unsigned)((fr * NIN + 8 * fq) * 2));
    f32x4 o[4][4];
#pragma unroll
    for (int db = 0; db < 4; ++db)
#pragma unroll
        for (int qb = 0; qb < 4; ++qb) o[db][qb] = (f32x4){0.f, 0.f, 0.f, 0.f};
    const float sink2 = ISA ? 0.f : T.sinks[hd] * LOG2E;
    float mrow[4], lrow[4];
#pragma unroll
    for (int qb = 0; qb < 4; ++qb) { mrow[qb] = ISA ? -1e30f : sink2; lrow[qb] = 0.f; }

#define ATT_TILE_PTRS(KC, KP, VP, PITCH) do { \
        if (samp && (KC) < NPREV) { \
            if (ISA) { const size_t off_ = ((size_t)(b * 512 + (KC) * 64)) * 512 + hd * 64; KP = T.CKA + off_; VP = T.CVA + off_; PITCH = 512; } \
            else { const size_t off_ = ((size_t)(b * 128 + (KC) * 64)) * 128 + kv * 64; KP = T.CKB + off_; VP = T.CVB + off_; PITCH = 128; } \
        } else { \
            const size_t r_ = (size_t)(row0 - (NPREV - (KC)) * 64) * NIN; \
            KP = T.Z + r_ + (ISA ? 512 + hd * 64 : 2048 + kv * 64); VP = T.Z + r_ + (ISA ? 1024 + hd * 64 : 2176 + kv * 64); PITCH = NIN; \
        } } while (0)
#define ATT_LOAD_K(KP, PITCH) do { _Pragma("unroll") for (int kb = 0; kb < 4; ++kb) { \
        const char* kr_ = (const char*)((KP) + (size_t)(16 * kb) * (PITCH)) + (unsigned)((fr * (PITCH) + 8 * fq) * 2); kf[kb][0] = *(const bf16x8*)kr_; kf[kb][1] = *(const bf16x8*)(kr_ + 64); } } while (0)
    bf16x8 kf[4][2];
    { const bf16 *kp0, *vp0; int pitch0; ATT_TILE_PTRS(kc0, kp0, vp0, pitch0); (void)vp0; ATT_LOAD_K(kp0, pitch0); }
    for (int kc = kc0; kc <= NPREV; ++kc) {
        const bf16 *kp, *vp; int pitch;
        ATT_TILE_PTRS(kc, kp, vp, pitch); (void)kp;
        {
            const unsigned voff = (unsigned)(((lane >> 3) * pitch + (((lane & 7) ^ ((lane >> 3) & 6)) * 8)) * 2);
#pragma unroll
            for (int i = 0; i < 8; ++i)
                __builtin_amdgcn_global_load_lds((const unsigned*)((const char*)(vp + (size_t)(8 * i) * pitch) + voff), (LAS unsigned*)(vst + i * 1024), 16, 0, 0);
        }
        bf16x8 pf[4][2];
#pragma unroll
        for (int qh = 0; qh < 2; ++qh) {
            f32x4 s[4][2];
            const LAS float* eb = ext + (768 + 32 * qh + fr - 64 * kc - 4 * fq);
#pragma unroll
            for (int kb = 0; kb < 4; ++kb)
#pragma unroll
                for (int q2 = 0; q2 < 2; ++q2) {
                    f32x4 c0 = (f32x4){0.f, 0.f, 0.f, 0.f};
                    if (ISA) { const LAS float* e = eb + (16 * q2 - 16 * kb); c0 = (f32x4){e[0], e[-1], e[-2], e[-3]}; }
                    f32x4 t = __builtin_amdgcn_mfma_f32_16x16x32_bf16(kf[kb][0], qf[2 * qh + q2][0], c0, 0, 0, 0);
                    s[kb][q2] = __builtin_amdgcn_mfma_f32_16x16x32_bf16(kf[kb][1], qf[2 * qh + q2][1], t, 0, 0, 0);
                }
            if (qh == 1) { const int kn = kc < NPREV ? kc + 1 : kc; const bf16 *kpn, *vpn; int pitchn; ATT_TILE_PTRS(kn, kpn, vpn, pitchn); (void)vpn; ATT_LOAD_K(kpn, pitchn); }
#pragma unroll
            for (int q2 = 0; q2 < 2; ++q2) {
                const int qb = 2 * qh + q2;
                float mx = s[0][q2][0];
#pragma unroll
                for (int kb = 0; kb < 4; ++kb)
#pragma unroll
                    for (int j = 0; j < 4; ++j) mx = fmaxf(mx, s[kb][q2][j]);
                mx = fmaxf(mx, __shfl_xor(mx, 16)); mx = fmaxf(mx, __shfl_xor(mx, 32));
                const float mnew = fmaxf(mrow[qb], mx), alpha = fexp2(mrow[qb] - mnew);
                mrow[qb] = mnew;
                float ps = 0.f; float p[4][4];
#pragma unroll
                for (int kb = 0; kb < 4; ++kb)
#pragma unroll
                    for (int j = 0; j < 4; ++j) { p[kb][j] = fexp2(s[kb][q2][j] - mnew); ps += p[kb][j]; }
                lrow[qb] = lrow[qb] * alpha + ps;
#pragma unroll
                for (int db = 0; db < 4; ++db) o[db][qb] = o[db][qb] * alpha;
#pragma unroll
                for (int kp2 = 0; kp2 < 2; ++kp2) {
                    v4u w; w.x = cvt_pk(p[2 * kp2][0], p[2 * kp2][1]); w.y = cvt_pk(p[2 * kp2][2], p[2 * kp2][3]);
                    w.z = cvt_pk(p[2 * kp2 + 1][0], p[2 * kp2 + 1][1]); w.w = cvt_pk(p[2 * kp2 + 1][2], p[2 * kp2 + 1][3]);
                    pf[qb][kp2] = __builtin_bit_cast(bf16x8, w);
                }
            }
        }
        asm volatile("s_waitcnt vmcnt(8)" ::: "memory");
        __builtin_amdgcn_wave_barrier();
        const int tq = (lane & 15) >> 2, tp = lane & 3;
#pragma unroll
        for (int kp2 = 0; kp2 < 2; ++kp2) {
            bf16x8 vf[4];
#pragma unroll
            for (int db = 0; db < 4; ++db) {
                const int r8 = 4 * (fq & 1) + tq;
                LAS unsigned char* a0 = vst + (4 * kp2 + (fq >> 1)) * 1024 + r8 * 128 + (((2 * db + (tp >> 1)) ^ (r8 & 6)) * 16) + (tp & 1) * 8;
                const s16x4 lo = __builtin_bit_cast(s16x4, __builtin_amdgcn_ds_read_tr16_b64_v4i16((LAS s16x4*)a0));
                const s16x4 hi = __builtin_bit_cast(s16x4, __builtin_amdgcn_ds_read_tr16_b64_v4i16((LAS s16x4*)(a0 + 2048)));
                vf[db] = (bf16x8){lo[0], lo[1], lo[2], lo[3], hi[0], hi[1], hi[2], hi[3]};
            }
#pragma unroll
            for (int qb = 0; qb < 4; ++qb)
#pragma unroll
                for (int db = 0; db < 4; ++db) o[db][qb] = __builtin_amdgcn_mfma_f32_16x16x32_bf16(vf[db], pf[qb][kp2], o[db][qb], 0, 0, 0);
        }
        asm volatile("" ::: "memory");
    }
#pragma unroll
    for (int qb = 0; qb < 4; ++qb) {
        float lt = lrow[qb]; lt += __shfl_xor(lt, 16); lt += __shfl_xor(lt, 32);
        if (!ISA) lt += fexp2(sink2 - mrow[qb]);
        const float inv = 1.0f / lt; float ss = 0.f;
#pragma unroll
        for (int db = 0; db < 4; ++db) { o[db][qb] = o[db][qb] * inv;
#pragma unroll
            for (int j = 0; j < 4; ++j) ss += o[db][qb][j] * o[db][qb][j]; }
        ss += __shfl_xor(ss, 16); ss += __shfl_xor(ss, 32);
        if (fq == 0) red[wave * 64 + 16 * qb + fr] = ss;
    }
    __syncthreads();
    const float* gout = (ISA ? T.goa : T.gob) + hd * 64 + 4 * (lane_id() >> 4);
    f32x4 gv[4];
#pragma unroll
    for (int db = 0; db < 4; ++db) gv[db] = *(const f32x4*)(gout + 16 * db);
#pragma unroll
    for (int qb = 0; qb < 4; ++qb) {
        float tot = 0.f;
#pragma unroll
        for (int w = 0; w < 8; ++w) tot += red[w * 64 + 16 * qb + fr];
        const float rstd = __builtin_amdgcn_rsqf(tot * (1.0f / 512.0f) + EPS);
        char* orow = (char*)(T.O + (size_t)(row0 + 16 * qb) * DM + (ISA ? 0 : 512) + hd * 64) + (unsigned)((fr * DM + 4 * fq) * 2);
#pragma unroll
        for (int db = 0; db < 4; ++db) { const f32x4 v = o[db][qb] * rstd * gv[db];
            v2u w; w.x = cvt_pk(v[0], v[1]); w.y = cvt_pk(v[2], v[3]); *(v2u*)(orow + 32 * db) = w; }
    }
}

__device__ __forceinline__ void attn_phase(LAS unsigned char* lds, const AttnArgs& T, const float* relb, const int wave) {
    const int lane = lane_id(), tid = wave * 64 + lane;
    LAS float* ext = (LAS float*)(lds + AL_EXT);
    for (int i = tid; i < 8 * 832; i += NWAVES * 64) { const int h = i / 832, k = i % 832; ext[i] = relb[h * 513 + (k < 512 ? k : 512)] * LOG2E; }
    volatile LAS unsigned* uw = (volatile LAS unsigned*)(lds + AL_UNIT);
    int qcur = (int)(blockIdx.x & 7u), qleft = 8;
    for (;;) {
        __syncthreads();
        if (tid == 0) {
            unsigned code = 0xffffffffu;
            while (qleft > 0) {
                const unsigned j = __hip_atomic_fetch_add(T.ctr + 16 * qcur, 1u, __ATOMIC_RELAXED, __HIP_MEMORY_SCOPE_AGENT);
                if (j < 132u) { code = (unsigned)qcur * 132u + j; break; }
                qcur = (qcur + 1) & 7; --qleft;
            }
            uw[0] = code;
        }
        __syncthreads();
        const unsigned u = (unsigned)__builtin_amdgcn_readfirstlane((int)uw[0]);
        if (u == 0xffffffffu) break;
        const int qq = (int)(u / 132u), j = (int)(u % 132u);
        if (j < 66) attn_unit<true>(lds, T, qq * 66 + j, wave, lane); else attn_unit<false>(lds, T, qq * 66 + j - 66, wave, lane);
    }
    __syncthreads();
}

struct Args { const float* in[21]; float* out; unsigned char* ws; };

constexpr size_t WS_SMALL = 768 * 1024, WS_BAR = 2048;
constexpr int SM_RELB = 0, SM_SINK = 8448, SM_GOA = 8512, SM_GOB = 9536, SM_GFIN = 10560, SM_END = 11584;
static_assert(WS_SSQ + (size_t)5 * MT * 4 <= WS_SMALL && WS_SMALL + SM_END * 4 <= WS_ROPE, "control region map");

__device__ __forceinline__ void grid_bar(unsigned* bar, unsigned k, unsigned G, unsigned bid, bool leader) {
    asm volatile("s_waitcnt vmcnt(0) lgkmcnt(0)" ::: "memory");
    __syncthreads();
    if (leader) {
        const unsigned g = bid & 7u, gsz = (G - g + 7u) >> 3, ng = G < 8u ? G : 8u;
        unsigned* gcnt = bar + 16 * (1 + g); unsigned* ggen = bar + 16 * (9 + g); unsigned* top = bar + 16 * 17;
        __builtin_amdgcn_fence(__ATOMIC_RELEASE, "agent");
        asm volatile("s_waitcnt vmcnt(0)" ::: "memory");
        const unsigned old = __hip_atomic_fetch_add(gcnt, 1u, __ATOMIC_RELAXED, __HIP_MEMORY_SCOPE_AGENT);
        if (old + 1u == k * gsz) {
            __hip_atomic_fetch_add(top, 1u, __ATOMIC_RELAXED, __HIP_MEMORY_SCOPE_AGENT);
            while (__hip_atomic_load(top, __ATOMIC_RELAXED, __HIP_MEMORY_SCOPE_AGENT) < k * ng) __builtin_amdgcn_s_sleep(1);
            __hip_atomic_fetch_add(ggen, 1u, __ATOMIC_RELAXED, __HIP_MEMORY_SCOPE_AGENT);
        } else {
            while (__hip_atomic_load(ggen, __ATOMIC_RELAXED, __HIP_MEMORY_SCOPE_AGENT) < k) __builtin_amdgcn_s_sleep(1);
        }
        __builtin_amdgcn_fence(__ATOMIC_ACQUIRE, "agent");
        asm volatile("s_waitcnt vmcnt(0)" ::: "memory");
    }
    __syncthreads();
}

struct PIn { const float *w_in, *w_out, *w_gu, *w_d, *w_pp, *w_pg, *g_mix, *g_ffn, *p_p, *p_s, *cak, *cav, *cbk, *cbv; };

__device__ __forceinline__ void conv_weights(LAS unsigned char* lds, unsigned char* ws, const PIn& I, const int l, const int wave, const int lane, const int gw, const int NGW, const int r_lo, const int r_hi) {
    LAS float* scr = (LAS float*)(lds + wave * 8448);
    constexpr int I_IN = (DM / 64) * (NIN / 32), I_OUT = (DM / 64) * (DM / 32), I_GU = (DM / 64) * (2 * FF / 32), I_D = (FF / 64) * (DM / 32), I_PP = (DPLE / 64) * (DM / 32), I_PG = I_OUT;
    constexpr int I_LAYER = I_IN + I_OUT + I_GU + I_D + I_PP + I_PG;
    unsigned char* wb = ws + WS_W + (size_t)l * W_LAYER;
    for (int it = r_lo + gw; it < (r_hi < I_LAYER ? r_hi : I_LAYER); it += NGW) {
        int r = it;
        if (r < I_IN) { transpose_item<false>(I.w_in + (size_t)l * DM * NIN, DM, NIN, (bf16*)(wb + W_IN), I.g_mix + l * DM, scr, r, lane); continue; } r -= I_IN;
        if (r < I_OUT) { transpose_item<false>(I.w_out + (size_t)l * DM * DM, DM, DM, (bf16*)(wb + W_OUT), nullptr, scr, r, lane); continue; } r -= I_OUT;
        if (r < I_GU) { transpose_item<true>(I.w_gu + (size_t)l * DM * 2 * FF, DM, 2 * FF, (bf16*)(wb + W_GU), I.g_ffn + l * DM, scr, r, lane); continue; } r -= I_GU;
        if (r < I_D) { transpose_item<false>(I.w_d + (size_t)l * FF * DM, FF, DM, (bf16*)(wb + W_D), nullptr, scr, r, lane); continue; } r -= I_D;
        if (r < I_PP) { transpose_item<false>(I.w_pp + (size_t)l * DPLE * DM, DPLE, DM, (bf16*)(wb + W_PP), nullptr, scr, r, lane); continue; } r -= I_PP;
        transpose_item<false>(I.w_pg + (size_t)l * DM * DM, DM, DM, (bf16*)(wb + W_PG), nullptr, scr, r, lane);
    }
}
__device__ __forceinline__ void conv_p_caches(unsigned char* ws, float* out, const PIn& I, const int l, const size_t gtid, const size_t gth) {
    bf16* PB = (bf16*)(ws + WS_PB);
    convert_flat(I.p_p + (size_t)l * MP * DPLE, PB + (size_t)l * MT * DPLE, (size_t)MP * DPLE, gtid, gth);
    convert_flat(I.p_s + (size_t)l * MS * DPLE, PB + (size_t)l * MT * DPLE + (size_t)MP * DPLE, (size_t)MS * DPLE, gtid, gth);
    constexpr size_t NA = (size_t)16 * 512 * 512, NB = (size_t)16 * 128 * 128;
    for (size_t i = gtid * 8; i < NA; i += gth * 8) {
        const size_t gi = (size_t)l * NA + i;
        const f32x4 a = *(const f32x4*)(I.cak + gi), b = *(const f32x4*)(I.cak + gi + 4), c = *(const f32x4*)(I.cav + gi), d = *(const f32x4*)(I.cav + gi + 4);
        v4u w; w.x = cvt_pk(a[0], a[1]); w.y = cvt_pk(a[2], a[3]); w.z = cvt_pk(b[0], b[1]); w.w = cvt_pk(b[2], b[3]);
        *(v4u*)((bf16*)(ws + WS_CKA) + gi) = w;
        w.x = cvt_pk(c[0], c[1]); w.y = cvt_pk(c[2], c[3]); w.z = cvt_pk(d[0], d[1]); w.w = cvt_pk(d[2], d[3]);
        *(v4u*)((bf16*)(ws + WS_CVA) + gi) = w;
        if (((i >> 9) & 511) >= 64) { float* dk = out + O_AKS + gi - 32768; float* dv = out + O_AVS + gi - 32768;
            *(f32x4*)dk = a; *(f32x4*)(dk + 4) = b; *(f32x4*)dv = c; *(f32x4*)(dv + 4) = d; }
    }
    for (size_t i = gtid * 8; i < NB; i += gth * 8) {
        const size_t gi = (size_t)l * NB + i;
        const f32x4 a = *(const f32x4*)(I.cbk + gi), b = *(const f32x4*)(I.cbk + gi + 4), c = *(const f32x4*)(I.cbv + gi), d = *(const f32x4*)(I.cbv + gi + 4);
        v4u w; w.x = cvt_pk(a[0], a[1]); w.y = cvt_pk(a[2], a[3]); w.z = cvt_pk(b[0], b[1]); w.w = cvt_pk(b[2], b[3]);
        *(v4u*)((bf16*)(ws + WS_CKB) + gi) = w;
        w.x = cvt_pk(c[0], c[1]); w.y = cvt_pk(c[2], c[3]); w.z = cvt_pk(d[0], d[1]); w.w = cvt_pk(d[2], d[3]);
        *(v4u*)((bf16*)(ws + WS_CVB) + gi) = w;
        if (((i >> 7) & 127) >= 64) { float* dk = out + O_BKS + gi - 8192; float* dv = out + O_BVS + gi - 8192;
            *(f32x4*)dk = a; *(f32x4*)(dk + 4) = b; *(f32x4*)dv = c; *(f32x4*)(dv + 4) = d; }
    }
}

template <int l>
__device__ __forceinline__ void run_layer(LAS unsigned char* lds, unsigned char* ws_in, float* out_in, const float* x_p, const float* x_s, const PIn* pin, const int G, const int bid, const int wave) {
    GAS unsigned char* wsg_ = (GAS unsigned char*)ws_in; GAS float* outg_ = (GAS float*)out_in; asm volatile("" : "+s"(wsg_), "+s"(outg_));
    unsigned char* ws = (unsigned char*)wsg_; float* out = (float*)outg_;
    unsigned* const bar = (unsigned*)(ws + WS_BAR);
#define GRID_BAR(k) grid_bar(bar, (unsigned)((k) + 1), (unsigned)G, (unsigned)bid, wave == 0 && lane_id() == 0)
        unsigned char* wb = ws + WS_W + (size_t)l * W_LAYER;
        bf16 *XB = (bf16*)(ws + WS_XB), *HB = (bf16*)(ws + WS_HB), *O = (bf16*)(ws + WS_O), *ACT = (bf16*)(ws + WS_ACT);
        {
            pg8::RowOrder<NIN / 256> S; S.init(G, bid);
            EpiIn E{ws, out, (l == 0) ? 0 : 2 * MT, l};
            pg8::gemm_phase<DM, EpiIn, pg8::RowOrder<NIN / 256>>(lds, XB, (const bf16*)(wb + W_IN), S, E, wave);
            if (l == 0) {
                const int nbusy = (MT / 256 * (NIN / 256)) % G;
                if (S.v >= nbusy) { const int lane = lane_id(); const PIn I = *pin;
                    conv_p_caches(ws, out, I, 0, (size_t)(S.v - nbusy) * (NWAVES * 64) + wave * 64 + lane, (size_t)(G - nbusy) * (NWAVES * 64)); }
            }
        }
        GRID_BAR(6 * l + 1);
        {
            const float* sm = (const float*)(ws + WS_SMALL);
            AttnArgs T{(const bf16*)(ws + WS_Z), (const bf16*)(ws + WS_CKA) + (size_t)l * 16 * 512 * 512, (const bf16*)(ws + WS_CVA) + (size_t)l * 16 * 512 * 512,
                       (const bf16*)(ws + WS_CKB) + (size_t)l * 16 * 128 * 128, (const bf16*)(ws + WS_CVB) + (size_t)l * 16 * 128 * 128,
                       sm + SM_SINK + l * 8, sm + SM_GOA + l * 512, sm + SM_GOB + l * 512, O, (unsigned*)(ws + WS_CTL) + 128 * l};
            attn_phase(lds, T, sm + SM_RELB + (size_t)l * 8 * 513, wave);
        }
        GRID_BAR(6 * l + 2);
        {
            pg8::RowOrder<DM / 256> S; S.init(G, bid);
            EpiRes E{ws, out, (l == 0) ? x_p : nullptr, x_s, 1, (1 + 2 * l) * MT};
            pg8::gemm_phase<DM, EpiRes, pg8::RowOrder<DM / 256>>(lds, O, (const bf16*)(wb + W_OUT), S, E, wave);
            if (l == 0) {
                const int nbusy = (MT / 256 * 4) % G;
                if (S.v >= nbusy) { const int lane = lane_id(); const PIn I = *pin; __syncthreads();
                    conv_weights(lds, ws, I, 0, wave, lane, (S.v - nbusy) * NWAVES + wave, (G - nbusy) * NWAVES, W_ITEMS_EARLY, 1 << 30); }
            }
        }
        GRID_BAR(6 * l + 3);
        {
            pg8::RowOrder<2 * FF / 256> S; S.init(G, bid);
            EpiGU E{ws, out, (1 + 2 * l) * MT};
            pg8::gemm_phase<DM, EpiGU, pg8::RowOrder<2 * FF / 256>>(lds, HB, (const bf16*)(wb + W_GU), S, E, wave);
            if (l == 0) {
                const int nbusy = (MT / 256 * (2 * FF / 256)) % G;
                if (S.v >= nbusy) { const int lane = lane_id(); const PIn I = *pin;
                    conv_p_caches(ws, out, I, 1, (size_t)(S.v - nbusy) * (NWAVES * 64) + wave * 64 + lane, (size_t)(G - nbusy) * (NWAVES * 64)); }
            }
        }
        GRID_BAR(6 * l + 4);
        {
            pg8::RowOrder<DM / 256> S; S.init(G, bid);
            EpiRes E{ws, out, nullptr, nullptr, 0, -1};
            pg8::gemm_phase<FF, EpiRes, pg8::RowOrder<DM / 256>>(lds, ACT, (const bf16*)(wb + W_D), S, E, wave);
            pg8::RowOrder<DM / 256> S2; S2.init(G, G - 1 - bid);
            EpiPP E2{ws, out};
            pg8::gemm_phase<DPLE, EpiPP, pg8::RowOrder<DM / 256>>(lds, (const bf16*)(ws + WS_PB) + (size_t)l * MT * DPLE, (const bf16*)(wb + W_PP), S2, E2, wave);
            if (l == 0) {
                const int nbusy = (MT / 256 * 4) % G;
                if (S.v >= nbusy) { const int lane = lane_id(); const PIn I = *pin; __syncthreads();
                    conv_weights(lds, ws, I, 1, wave, lane, (S.v - nbusy) * NWAVES + wave, (G - nbusy) * NWAVES, 0, 1 << 30); }
            }
        }
        GRID_BAR(6 * l + 5);
        {
            pg8::RowOrder<DM / 256> S; S.init(G, bid);
            EpiPG E{ws, out, (2 + 2 * l) * MT};
            pg8::gemm_phase<DM, EpiPG, pg8::RowOrder<DM / 256>>(lds, HB, (const bf16*)(wb + W_PG), S, E, wave);
        }
        GRID_BAR(6 * l + 6);
    }
#undef GRID_BAR

__global__ void __launch_bounds__(NWAVES * 64, 2) mega_fwd(Args args) {
    extern __shared__ __attribute__((aligned(16))) unsigned char lds_raw[];
    LAS unsigned char* lds = (LAS unsigned char*)lds_raw;
    const int wave = __builtin_amdgcn_readfirstlane((int)threadIdx.x >> 6);
    const int G = gridDim.x, bid = blockIdx.x;
    unsigned char* const ws = args.ws;
    float* const out = args.out;
    float* const H = out + O_Y;

    if (args.ws == nullptr) cg::this_grid().sync();
    {
        const float *x_p = args.in[0], *x_s = args.in[1], *p_p = args.in[2], *p_s = args.in[3], *cak = args.in[4], *cav = args.in[5], *cbk = args.in[6], *cbv = args.in[7],
                    *g_mix = args.in[8], *w_in = args.in[9], *relb = args.in[10], *sinks = args.in[11], *goa = args.in[12], *gob = args.in[13], *w_out = args.in[14],
                    *g_ffn = args.in[15], *w_gu = args.in[16], *w_d = args.in[17], *w_pp = args.in[18], *w_pg = args.in[19], *g_fin = args.in[20];
        float* ssqb = (float*)(ws + WS_SSQ);
        float* rope = (float*)(ws + WS_ROPE);
        float* sm = (float*)(ws + WS_SMALL);
        bf16 *XB = (bf16*)(ws + WS_XB), *PB = (bf16*)(ws + WS_PB);
        const int lane = lane_id(), tid = wave * 64 + lane;
        const int gw = bid * NWAVES + wave, NGW = G * NWAVES;
        const size_t gtid = (size_t)bid * (NWAVES * 64) + tid, gth = (size_t)G * (NWAVES * 64);
        const PIn I{w_in, w_out, w_gu, w_d, w_pp, w_pg, g_mix, g_ffn, p_p, p_s, cak, cav, cbk, cbv};
        conv_weights(lds, ws, I, 0, wave, lane, gw, NGW, 0, W_ITEMS_EARLY);
        for (int m0 = gw; m0 < MT; m0 += 2 * NGW) {
            const int m1 = m0 + NGW; const bool has1 = m1 < MT;
            const float* xr0 = (m0 < MP) ? x_p + (size_t)m0 * DM : x_s + (size_t)(m0 - MP) * DM;
            const float* xr1 = has1 ? ((m1 < MP) ? x_p + (size_t)m1 * DM : x_s + (size_t)(m1 - MP) * DM) : xr0;
            f32x4 a[2][4];
#pragma unroll
            for (int j = 0; j < 2; ++j) { a[0][2 * j] = *(const f32x4*)(xr0 + j * 512 + lane * 8); a[0][2 * j + 1] = *(const f32x4*)(xr0 + j * 512 + lane * 8 + 4);
                                          a[1][2 * j] = *(const f32x4*)(xr1 + j * 512 + lane * 8); a[1][2 * j + 1] = *(const f32x4*)(xr1 + j * 512 + lane * 8 + 4); }
#pragma unroll
            for (int r = 0; r < 2; ++r) {
                const int m = r ? m1 : m0; float ss = 0.f;
#pragma unroll
                for (int j = 0; j < 2; ++j) { const f32x4 p = a[r][2 * j], q = a[r][2 * j + 1];
                    ss += (p[0] * p[0] + p[1] * p[1]) + (p[2] * p[2] + p[3] * p[3]) + (q[0] * q[0] + q[1] * q[1]) + (q[2] * q[2] + q[3] * q[3]);
                    v4u w; w.x = cvt_pk(p[0], p[1]); w.y = cvt_pk(p[2], p[3]); w.z = cvt_pk(q[0], q[1]); w.w = cvt_pk(q[2], q[3]);
                    if (r == 0 || has1) *(v4u*)(XB + (size_t)m * DM + j * 512 + lane * 8) = w; }
#pragma unroll
                for (int o = 1; o < 64; o <<= 1) ss += __shfl_xor(ss, o);
                if (lane == 0 && (r == 0 || has1)) ssqb[m] = ss;
            }
        }
        for (size_t i = gtid; i < (size_t)16384 * 8; i += gth) {
            const int pos = (int)(i >> 3), j = (int)(i & 7);
            const double rv = (j == 0) ? 0.15915494309189535 : (j == 1) ? 0.03086376340470123 : (j == 2) ? 0.005985185712713705 : (j == 3) ? 0.001160663641240061 :
                              (j == 4) ? 0.00022507907903927653 : (j == 5) ? 4.364795279280289e-05 : (j == 6) ? 8.464330808241401e-06 : 1.6414262627950345e-06;
            const double t = (double)pos * rv; const float fr_ = (float)(t - __builtin_floor(t));
            rope[2 * i] = __builtin_amdgcn_cosf(fr_); rope[2 * i + 1] = __builtin_amdgcn_sinf(fr_);
        }
        for (size_t i = gtid; i < (size_t)SM_END; i += gth) {
            float v = 0.f; const int k = (int)i;
            if (k < 2 * 8 * 513) v = relb[k];
            else if (k >= SM_SINK && k < SM_SINK + 16) v = sinks[k - SM_SINK];
            else if (k >= SM_GOA && k < SM_GOB) v = goa[k - SM_GOA];
            else if (k >= SM_GOB && k < SM_GFIN) v = gob[k - SM_GOB];
            else if (k >= SM_GFIN) v = g_fin[k - SM_GFIN];
            sm[k] = v;
        }
        for (size_t i = gtid; i < (size_t)4 * MT; i += gth) ssqb[MT + i] = 0.f;
        if (gtid < 256) ((unsigned*)(ws + WS_CTL))[gtid] = 0u;
    }
    grid_bar((unsigned*)(ws + WS_BAR), 1u, (unsigned)G, (unsigned)bid, wave == 0 && lane_id() == 0);

    const float* const x_p = args.in[0]; const float* const x_s = args.in[1];
    const PIn pin{args.in[9], args.in[14], args.in[16], args.in[17], args.in[18], args.in[19], args.in[8], args.in[15], args.in[2], args.in[3], args.in[4], args.in[5], args.in[6], args.in[7]};
    run_layer<0>(lds, ws, out, x_p, x_s, &pin, G, bid, wave);
    run_layer<1>(lds, ws, out, x_p, x_s, &pin, G, bid, wave);
    {
        const int lane = lane_id();
        const int gw = bid * NWAVES + wave, NGW = G * NWAVES;
        const float* ssq = (const float*)(ws + WS_SSQ) + 4 * (size_t)MT;
        const float* g_fin = (const float*)(ws + WS_SMALL) + SM_GFIN;
        const bf16* XB = (const bf16*)(ws + WS_XB);
        f32x4 gf[2][2];
#pragma unroll
        for (int j = 0; j < 2; ++j) { gf[j][0] = *(const f32x4*)(g_fin + j * 512 + lane * 8); gf[j][1] = *(const f32x4*)(g_fin + j * 512 + lane * 8 + 4); }
        for (int m = gw; m < MT; m += NGW) {
            const float rstd = __builtin_amdgcn_rsqf(ssq[m] * (1.0f / DM) + EPS);
            float* yr = H + (size_t)m * DM;
#pragma unroll
            for (int j = 0; j < 2; ++j) {
                const v4u w = *(const v4u*)(XB + (size_t)m * DM + j * 512 + lane * 8);
                const f32x4 a = (f32x4){bf_lo(w.x), bf_hi(w.x), bf_lo(w.y), bf_hi(w.y)}, b2 = (f32x4){bf_lo(w.z), bf_hi(w.z), bf_lo(w.w), bf_hi(w.w)};
                *(f32x4*)(yr + j * 512 + lane * 8) = a * rstd * gf[j][0]; *(f32x4*)(yr + j * 512 + lane * 8 + 4) = b2 * rstd * gf[j][1];
            }
        }
    }
}

extern "C" void kernel_launch(void* const* d_in, const int* in_sizes, int n_in, void* d_out, int out_size, void* d_ws, size_t ws_size, hipStream_t stream) {
    static int grid = 0;
    if (grid == 0) {
        if (n_in != 21 || (size_t)out_size != O_END || ws_size < WS_END) { fprintf(stderr, "kernel_launch: unexpected problem: n_in %d out %d ws %zu (need out %zu ws %zu)\n", n_in, out_size, ws_size, (size_t)O_END, (size_t)WS_END); grid = -1; return; }
        int dev = 0, cus = 0, per_cu = 0;
        (void)hipGetDevice(&dev);
        (void)hipDeviceGetAttribute(&cus, hipDeviceAttributeMultiprocessorCount, dev);
        if (hipFuncSetAttribute((const void*)mega_fwd, hipFuncAttributeMaxDynamicSharedMemorySize, LDS_BYTES) != hipSuccess) { fprintf(stderr, "kernel_launch: hipFuncSetAttribute failed\n"); grid = -1; return; }
        if (hipOccupancyMaxActiveBlocksPerMultiprocessor(&per_cu, (const void*)mega_fwd, NWAVES * 64, LDS_BYTES) != hipSuccess || per_cu < 1) { fprintf(stderr, "kernel_launch: occupancy query says %d blocks per CU\n", per_cu); (void)hipGetLastError(); per_cu = 1; }
        grid = cus * 1;
        if (grid <= 0) { grid = -1; return; }
    }
    if (grid < 0) return;
    (void)hipMemsetAsync((unsigned char*)d_ws + WS_BAR, 0, 2048, stream);
    Args a{};
    for (int i = 0; i < 21; ++i) a.in[i] = (const float*)d_in[i];
    a.out = (float*)d_out; a.ws = (unsigned char*)d_ws;
    void* kargs[] = {&a};
    hipError_t e = hipLaunchCooperativeKernel((const void*)mega_fwd, dim3(grid), dim3(NWAVES * 64), kargs, LDS_BYTES, stream);
    if (e != hipSuccess) fprintf(stderr, "kernel_launch: cooperative launch failed: %s (grid %d)\n", hipGetErrorString(e), grid);
}
```

```cpp
#include <hip/hip_runtime.h>
#include <hip/hip_cooperative_groups.h>
#include <cstdio>
#include <cstdint>
namespace cg = cooperative_groups;

#define GAS __attribute__((address_space(1)))
#define LAS __attribute__((address_space(3)))
typedef unsigned short bf16;
typedef unsigned v4u __attribute__((ext_vector_type(4)));
typedef unsigned v2u __attribute__((ext_vector_type(2)));
typedef float f32x4 __attribute__((ext_vector_type(4)));
typedef short bf16x8 __attribute__((ext_vector_type(8)));
typedef short s16x4 __attribute__((ext_vector_type(4)));

constexpr int MP = 32768, MS = 1024, MT = MP + MS;
constexpr int DM = 1024, NIN = 2304, FF = 2816, DPLE = 256;
constexpr float EPS = 1e-6f;
constexpr float LOG2E = 1.4426950408889634f;
constexpr float QSCALE = 0.125f * LOG2E;

__device__ __forceinline__ unsigned cvt_pk(float lo, float hi) { unsigned r; asm("v_cvt_pk_bf16_f32 %0, %1, %2" : "=v"(r) : "v"(lo), "v"(hi)); return r; }
__device__ __forceinline__ float bf_lo(unsigned w) { return __builtin_bit_cast(float, w << 16); }
__device__ __forceinline__ float bf_hi(unsigned w) { return __builtin_bit_cast(float, w & 0xffff0000u); }
__device__ __forceinline__ float fexp2(float x) { return __builtin_amdgcn_exp2f(x); }
__device__ __forceinline__ float frcp(float x) { return __builtin_amdgcn_rcpf(x); }

__device__ __forceinline__ int lane_id() { int l = __builtin_amdgcn_mbcnt_hi(~0u, __builtin_amdgcn_mbcnt_lo(~0u, 0u)); asm volatile("" : "+v"(l)); return l; }

namespace pg8 {
constexpr int BM = 256, BK = 64, HALF = 128, HTB = HALF * BK * 2, STAGE_BYTES = 8 * HTB, NXCD = 8, WGM = 8;
__host__ __device__ __forceinline__ int lds_byte(int r, int c) { const int st = (r >> 4) * 2 + (c >> 5), rr = r & 15, cc = c & 31, ob = rr * 64 + cc * 2; return st * 1024 + (ob ^ (((ob >> 9) & 1) << 5)); }
__host__ __device__ __forceinline__ void stage_rc(int b, int& R, int& C) { const int st = b / 1024, sb = b % 1024, swz = sb ^ (((sb >> 9) & 1) << 5); R = (st >> 1) * 16 + swz / 64; C = (st & 1) * 32 + (swz % 64) / 2; }
__host__ __device__ __forceinline__ int perm32(int rho) { const int n = rho >> 4, i = rho & 15; return 8 * (i >> 2) + 4 * n + (i & 3); }

struct Unit { int pm, pn; };
struct Gemm { const bf16* A; const bf16* Bt; int M, N, K; };

template <int NN>
struct RowOrder {
    int G, v;
    __device__ __forceinline__ void init(int G_, int c) { G = G_; v = (G_ % 8 == 0) ? (c % 8) * (G_ / 8) + c / 8 : c; }
    __device__ __forceinline__ bool next(int i, Unit& u) const {
        const int L = i * G + v; if (L >= (33792 / BM) * NN) return false;
        constexpr int NM = 33792 / BM, NFULL = (NM / 8) * 8 * NN;
        if (L < NFULL) { const int g = L / (8 * NN), idx = L % (8 * NN); u.pm = g * 8 + (idx & 7); u.pn = idx >> 3; }
        else { constexpr int GS = NM % 8 ? NM % 8 : 8; const int idx = L - NFULL; u.pm = (NM / 8) * 8 + idx % GS; u.pn = idx / GS; }
        return true;
    }
};

template <int KK, class Epi, class Sched, bool ALIGN_EPI = true>
__device__ __forceinline__ void gemm_phase(LAS unsigned char* lds, const bf16* gA, const bf16* gBt, const Sched& S, const Epi& E, const int wid) {
    const int lane = lane_id();
    const int tid = wid * 64 + lane, wr = wid >> 2, wc = wid & 3, fr = lane & 15, fq = lane >> 4;
    constexpr int K = KK, nt = K / BK;
    unsigned voffA[2], voffB[2];
#pragma unroll
    for (int i = 0; i < 2; ++i) { int R, C; stage_rc(tid * 16 + i * 8192, R, C); const int Rb = Epi::PERM ? ((R & ~31) + perm32(R & 31)) : R;
        voffA[i] = (unsigned)(R * K + C) * 2u; voffB[i] = (unsigned)(Rb * K + C) * 2u; }
    const size_t kstep = (size_t)(BK * 2);
    const size_t hstep = (size_t)HALF * K * 2;
    const size_t tstep = 2 * hstep;
    const unsigned ldsw = (unsigned)wid * 1024u;
    const int aoff = lds_byte(wr * 64 + fr, fq * 8), boff = lds_byte(wc * 32 + fr, fq * 8);
#define PG8_SA(b, h) (((b) * 2 + (h)) * HTB)
#define PG8_SB(b, h) ((4 + (b) * 2 + (h)) * HTB)
#define PG8_STAGE(bufoff, gbase, voff) do { _Pragma("unroll") for (int _i = 0; _i < 2; ++_i) \
        __builtin_amdgcn_global_load_lds((const unsigned*)((const char*)(gbase) + (voff)[_i]), (LAS unsigned*)(lds + (bufoff) + ldsw + _i * 8192), 16, 0, 0); } while (0)
#define PG8_LDA(dst, b, h) do { _Pragma("unroll") for (int m = 0; m < 4; ++m) _Pragma("unroll") for (int k = 0; k < 2; ++k) dst[m][k] = *(const LAS bf16x8*)(lds + PG8_SA(b, h) + aoff + m * 2048 + k * 1024); } while (0)
#define PG8_LDB(dst, b, h) do { _Pragma("unroll") for (int n = 0; n < 2; ++n) _Pragma("unroll") for (int k = 0; k < 2; ++k) dst[n][k] = *(const LAS bf16x8*)(lds + PG8_SB(b, h) + boff + n * 2048 + k * 1024); } while (0)
#define PG8_MMA(ai, bj, At, Bt) do { __builtin_amdgcn_s_setprio(1); _Pragma("unroll") for (int m = 0; m < 4; ++m) _Pragma("unroll") for (int n = 0; n < 2; ++n) _Pragma("unroll") for (int k = 0; k < 2; ++k) \
        acc[ai][bj][m][n] = __builtin_amdgcn_mfma_f32_16x16x32_bf16(Bt[n][k], At[m][k], acc[ai][bj][m][n], 0, 0, 0); __builtin_amdgcn_s_setprio(0); } while (0)
#define PG8_WAIT_V(n) asm volatile("s_waitcnt vmcnt(" #n ")" ::: "memory")
#define PG8_WAIT_L(n) asm volatile("s_waitcnt lgkmcnt(" #n ")" ::: "memory")
#define PG8_BAR __builtin_amdgcn_s_barrier()
#define PG8_SCHED __builtin_amdgcn_sched_barrier(0)
    Unit cur, nxt; int ui = 0;
    if (!S.next(0, cur)) return;
    f32x4 acc[2][2][4][2];
#pragma unroll
    for (int a = 0; a < 2; ++a)
#pragma unroll
        for (int b = 0; b < 2; ++b)
#pragma unroll
            for (int m = 0; m < 4; ++m)
#pragma unroll
                for (int n = 0; n < 2; ++n) acc[a][b][m][n] = (f32x4){0.f, 0.f, 0.f, 0.f};
    bf16x8 At[4][2], B0[2][2], B1[2][2];
    const char* cA = (const char*)gA + (size_t)cur.pm * tstep; const char* cB = (const char*)gBt + (size_t)cur.pn * tstep;
    PG8_STAGE(PG8_SB(0, 0), cB, voffB); PG8_STAGE(PG8_SB(0, 1), cB + hstep, voffB); PG8_STAGE(PG8_SA(0, 0), cA, voffA); PG8_STAGE(PG8_SA(0, 1), cA + hstep, voffA);
    if (wr == 1) PG8_BAR;
    PG8_WAIT_V(2); PG8_BAR;
    PG8_STAGE(PG8_SB(1, 0), cB + kstep, voffB); PG8_STAGE(PG8_SA(1, 0), cA + kstep, voffA); PG8_STAGE(PG8_SB(1, 1), cB + hstep + kstep, voffB);
    PG8_WAIT_V(6); PG8_BAR;
    for (;;) {
        const bool has_next = S.next(ui + 1, nxt);
        const char* nA = has_next ? (const char*)gA + (size_t)nxt.pm * tstep : cA; const char* nB = has_next ? (const char*)gBt + (size_t)nxt.pn * tstep : cB;
#pragma unroll 1
        for (int t = 0; t < nt; t += 2) {
            const bool last = (t == nt - 2);
            const char* a1 = cA + (size_t)(t + 1) * kstep;
            const char* a2 = last ? nA : cA + (size_t)(t + 2) * kstep; const char* b2 = last ? nB : cB + (size_t)(t + 2) * kstep;
            const char* a3 = a2 + kstep; const char* b3 = b2 + kstep;
            PG8_LDB(B0, 0, 0); PG8_LDB(B1, 0, 1); PG8_SCHED; PG8_LDA(At, 0, 0); PG8_STAGE(PG8_SA(1, 1), a1 + hstep, voffA);
            PG8_WAIT_V(8); PG8_WAIT_L(0); PG8_BAR; PG8_MMA(0, 0, At, B0); PG8_MMA(0, 1, At, B1); PG8_BAR; PG8_SCHED;
            PG8_LDA(At, 0, 1); PG8_STAGE(PG8_SB(0, 0), b2, voffB); PG8_STAGE(PG8_SB(0, 1), b2 + hstep, voffB); PG8_STAGE(PG8_SA(0, 0), a2, voffA);
            PG8_WAIT_V(8); PG8_WAIT_L(0); PG8_BAR; PG8_MMA(1, 0, At, B0); PG8_MMA(1, 1, At, B1); PG8_BAR; PG8_SCHED;
            PG8_LDB(B0, 1, 0); PG8_LDB(B1, 1, 1); PG8_SCHED; PG8_LDA(At, 1, 0); PG8_STAGE(PG8_SA(0, 1), a2 + hstep, voffA);
            PG8_WAIT_V(8); PG8_WAIT_L(0); PG8_BAR; PG8_MMA(0, 0, At, B0); PG8_MMA(0, 1, At, B1); PG8_BAR; PG8_SCHED;
            PG8_LDA(At, 1, 1); PG8_STAGE(PG8_SB(1, 0), b3, voffB); PG8_STAGE(PG8_SB(1, 1), b3 + hstep, voffB); PG8_STAGE(PG8_SA(1, 0), a3, voffA);
            PG8_WAIT_V(8); PG8_WAIT_L(0); PG8_BAR; PG8_MMA(1, 0, At, B0); PG8_MMA(1, 1, At, B1); PG8_BAR; PG8_SCHED;
        }
        if constexpr (ALIGN_EPI) { if (wr == 0) PG8_BAR; }
        E(acc, cur, wr, wc, fr, fq);
        if (!has_next) break;
#pragma unroll
        for (int a = 0; a < 2; ++a)
#pragma unroll
            for (int b = 0; b < 2; ++b)
#pragma unroll
                for (int m = 0; m < 4; ++m)
#pragma unroll
                    for (int n = 0; n < 2; ++n) acc[a][b][m][n] = (f32x4){0.f, 0.f, 0.f, 0.f};
        cur = nxt; cA = nA; cB = nB; ++ui;
        if constexpr (ALIGN_EPI) { if (wr == 1) PG8_BAR; }
    }
    PG8_WAIT_V(0);
    if constexpr (!ALIGN_EPI) { if (wr == 0) PG8_BAR; }
    PG8_BAR;
#undef PG8_SA
#undef PG8_SB
#undef PG8_STAGE
#undef PG8_LDA
#undef PG8_LDB
#undef PG8_MMA
#undef PG8_WAIT_V
#undef PG8_WAIT_L
#undef PG8_BAR
#undef PG8_SCHED
}
}

constexpr size_t MiB = 1u << 20;
constexpr size_t WS_CTL = 0;
constexpr size_t WS_SSQ = 4096;
constexpr size_t WS_ROPE = 1 * MiB;
constexpr size_t WS_W = 2 * MiB;
constexpr size_t W_IN = 0, W_OUT = W_IN + (size_t)NIN * DM * 2, W_GU = W_OUT + (size_t)DM * DM * 2, W_D = W_GU + (size_t)2 * FF * DM * 2,
                 W_PP = W_D + (size_t)DM * FF * 2, W_PG = W_PP + (size_t)DM * DPLE * 2, W_LAYER = W_PG + (size_t)DM * DM * 2;
constexpr size_t WS_XB = WS_W + 2 * W_LAYER + MiB;
constexpr size_t ACT_DM = (size_t)MT * DM * 2;
constexpr size_t WS_HB = WS_XB + ACT_DM;
constexpr size_t WS_Z = WS_HB + ACT_DM;
constexpr size_t WS_O = WS_Z + (size_t)MT * NIN * 2;
constexpr size_t WS_ACT = WS_Z;
constexpr size_t WS_PB = WS_O + ACT_DM;
constexpr size_t WS_CKA = WS_PB + (size_t)2 * MT * DPLE * 2;
constexpr size_t CA_BYTES = (size_t)2 * 16 * 512 * 512 * 2, CB_BYTES = (size_t)2 * 16 * 128 * 128 * 2;
constexpr size_t WS_CVA = WS_CKA + CA_BYTES, WS_CKB = WS_CVA + CA_BYTES, WS_CVB = WS_CKB + CB_BYTES, WS_END = WS_CVB + CB_BYTES;
static_assert((size_t)MT * FF * 2 <= (size_t)MT * NIN * 2 + ACT_DM, "ACT overlay fits Z|O");
static_assert(WS_END <= 512 * MiB, "workspace map");

constexpr size_t O_Y = 0, O_AKP = (size_t)MT * DM, O_AVP = O_AKP + 2 * 2 * 512 * 512, O_BKP = O_AVP + 2 * 2 * 512 * 512, O_BVP = O_BKP + 2 * 2 * 128 * 128,
                 O_AKS = O_BVP + 2 * 2 * 128 * 128, O_AVS = O_AKS + (size_t)2 * 16 * 512 * 512, O_BKS = O_AVS + (size_t)2 * 16 * 512 * 512, O_BVS = O_BKS + 2 * 16 * 128 * 128,
                 O_END = O_BVS + 2 * 16 * 128 * 128;

constexpr int LDS_BYTES = 131072 + 4096;
constexpr int W_ITEMS_EARLY = (DM / 64) * (NIN / 32) + (DM / 64) * (DM / 32);
constexpr int NWAVES = 8;

typedef const f32x4 (&AccRef)[2][2][4][2];

struct EpiIn {
    static constexpr bool PERM = true;
    unsigned char* ws_; float* out_; int ssq_off; int l;
    __device__ __forceinline__ void operator()(AccRef acc, const pg8::Unit& u, int wr, int wc, int, int) const {
        GAS unsigned char* wsg_ = (GAS unsigned char*)ws_; GAS float* outg_ = (GAS float*)out_; asm volatile("" : "+s"(wsg_), "+s"(outg_)); unsigned char* ws = (unsigned char*)wsg_; float* out = (float*)outg_;
        const int lane_ = lane_id(); const int fr = lane_ & 15, fq = lane_ >> 4;
        const float* ssq = (const float*)(ws + WS_SSQ) + ssq_off;
        const int pn = u.pn, pm = u.pm;
        const bool samp = pm >= (MP / 256);
        const bool isq = (pn < 2) || (pn == 6) || (pn == 7);
        bf16* Z = (bf16*)(ws + WS_Z); const float* rope = (const float*)(ws + WS_ROPE);
        const bool wrA = (pn >= 2 && pn <= 5) && (samp || (pm & 63) >= 62);
        const bool wrB = (pn == 8) && (samp || (pm & 63) == 63);
        float sq[2][4];
#pragma unroll
        for (int ai = 0; ai < 2; ++ai)
#pragma unroll
            for (int m = 0; m < 4; ++m) sq[ai][m] = ssq[pm * 256 + ai * 128 + wr * 64 + m * 16 + fr];
        asm volatile("" ::: "memory");
#pragma unroll
        for (int ai = 0; ai < 2; ++ai)
#pragma unroll
            for (int m = 0; m < 4; ++m) {
                const int row = pm * 256 + ai * 128 + wr * 64 + m * 16 + fr;
                const float rstd = __builtin_amdgcn_rsqf(sq[ai][m] * (1.0f / DM) + EPS) * (isq ? QSCALE : 1.0f);
                const int pos = samp ? 2048 + ((row - MP) & 63) : (row & 16383);
#pragma unroll
                for (int bj = 0; bj < 2; ++bj) {
                    const int c0 = pn * 256 + bj * 128 + wc * 32 + 8 * fq;
                    float v[8];
#pragma unroll
                    for (int j = 0; j < 4; ++j) { v[j] = acc[ai][bj][m][0][j] * rstd; v[4 + j] = acc[ai][bj][m][1][j] * rstd; }
                    const bool ropet = (pn == 6 || pn == 7 || (pn == 8 && bj == 0)) && ((wc & 1) == 0);
                    if (ropet) {
                        float pv[8];
#pragma unroll
                        for (int j = 0; j < 8; ++j) pv[j] = __shfl_xor(v[j], 16);
                        if (fq < 2) {
                            const f32x4* cs = (const f32x4*)(rope + (size_t)pos * 16);
                            const float sg = (fq == 0) ? -1.f : 1.f;
#pragma unroll
                            for (int jj = 0; jj < 4; ++jj) { const f32x4 t = cs[jj];
                                v[2 * jj] = v[2 * jj] * t[0] + sg * pv[2 * jj] * t[1];
                                v[2 * jj + 1] = v[2 * jj + 1] * t[2] + sg * pv[2 * jj + 1] * t[3]; }
                        }
                    }
                    v4u w; w.x = cvt_pk(v[0], v[1]); w.y = cvt_pk(v[2], v[3]); w.z = cvt_pk(v[4], v[5]); w.w = cvt_pk(v[6], v[7]);
                    *(v4u*)(Z + (size_t)row * NIN + c0) = w;
                    if (wrA) {
                        const int colA = c0 - (pn < 4 ? 512 : 1024);
                        float* dst;
                        if (samp) { const int rs = row - MP; dst = out + (pn < 4 ? O_AKS : O_AVS) + (size_t)l * 16 * 512 * 512 + ((size_t)((rs >> 6) * 512 + 448 + (rs & 63))) * 512 + colA; }
                        else { const int sq = (row & 16383) - 15872; dst = out + (pn < 4 ? O_AKP : O_AVP) + (size_t)l * 2 * 512 * 512 + ((size_t)((row >> 14) * 512 + sq)) * 512 + colA; }
                        *(f32x4*)dst = (f32x4){v[0], v[1], v[2], v[3]}; *(f32x4*)(dst + 4) = (f32x4){v[4], v[5], v[6], v[7]};
                    }
                    if (wrB && (samp || ai == 1)) {
                        const int colB = c0 - (bj == 0 ? 2048 : 2176);
                        float* dst;
                        if (samp) { const int rs = row - MP; dst = out + (bj == 0 ? O_BKS : O_BVS) + (size_t)l * 16 * 128 * 128 + ((size_t)((rs >> 6) * 128 + 64 + (rs & 63))) * 128 + colB; }
                        else { const int sq = (row & 16383) - 16256; dst = out + (bj == 0 ? O_BKP : O_BVP) + (size_t)l * 2 * 128 * 128 + ((size_t)((row >> 14) * 128 + sq)) * 128 + colB; }
                        *(f32x4*)dst = (f32x4){v[0], v[1], v[2], v[3]}; *(f32x4*)(dst + 4) = (f32x4){v[4], v[5], v[6], v[7]};
                    }
                }
            }
    }
};

#define EPI_ENTRY() GAS unsigned char* wsg_ = (GAS unsigned char*)ws_; GAS float* outg_ = (GAS float*)out_; asm volatile("" : "+s"(wsg_), "+s"(outg_)); unsigned char* ws = (unsigned char*)wsg_; float* out = (float*)outg_; const int lane_ = lane_id(); const int fr = lane_ & 15, fq = lane_ >> 4; (void)ws; (void)out

struct EpiRes {
    static constexpr bool PERM = true;
    unsigned char* ws_; float* out_; const float *xp, *xs; int from_xb; int ssq_off;
    __device__ __forceinline__ void operator()(AccRef acc, const pg8::Unit& u, int wr, int wc, int, int) const {
        EPI_ENTRY();
        bf16* HB = (bf16*)(ws + WS_HB); const bf16* RB = (const bf16*)(ws + (from_xb ? WS_XB : WS_HB)); float* ssq = (float*)(ws + WS_SSQ) + ssq_off;
#pragma unroll
        for (int ai = 0; ai < 2; ++ai) {
            f32x4 r0[4][2], r1[4][2];
            if (xp) {
#pragma unroll
                for (int m = 0; m < 4; ++m) { const int row = u.pm * 256 + ai * 128 + wr * 64 + m * 16 + fr;
                    const float* rsrc = (row < MP) ? xp + (size_t)row * DM : xs + (size_t)(row - MP) * DM;
#pragma unroll
                    for (int bj = 0; bj < 2; ++bj) { const int c0 = u.pn * 256 + bj * 128 + wc * 32 + 8 * fq; r0[m][bj] = *(const f32x4*)(rsrc + c0); r1[m][bj] = *(const f32x4*)(rsrc + c0 + 4); } }
            } else {
                v4u pw[4][2];
#pragma unroll
                for (int m = 0; m < 4; ++m) { const int row = u.pm * 256 + ai * 128 + wr * 64 + m * 16 + fr;
#pragma unroll
                    for (int bj = 0; bj < 2; ++bj) pw[m][bj] = *(const v4u*)(RB + (size_t)row * DM + u.pn * 256 + bj * 128 + wc * 32 + 8 * fq); }
#pragma unroll
                for (int m = 0; m < 4; ++m)
#pragma unroll
                    for (int bj = 0; bj < 2; ++bj) { const v4u w = pw[m][bj]; r0[m][bj] = (f32x4){bf_lo(w.x), bf_hi(w.x), bf_lo(w.y), bf_hi(w.y)}; r1[m][bj] = (f32x4){bf_lo(w.z), bf_hi(w.z), bf_lo(w.w), bf_hi(w.w)}; }
            }
            asm volatile("" ::: "memory");
#pragma unroll
            for (int m = 0; m < 4; ++m) {
                const int row = u.pm * 256 + ai * 128 + wr * 64 + m * 16 + fr;
                float ss = 0.f;
#pragma unroll
                for (int bj = 0; bj < 2; ++bj) {
                    const int c0 = u.pn * 256 + bj * 128 + wc * 32 + 8 * fq;
                    const f32x4 o0 = r0[m][bj] + acc[ai][bj][m][0], o1 = r1[m][bj] + acc[ai][bj][m][1];
                    v4u w; w.x = cvt_pk(o0[0], o0[1]); w.y = cvt_pk(o0[2], o0[3]); w.z = cvt_pk(o1[0], o1[1]); w.w = cvt_pk(o1[2], o1[3]);
                    *(v4u*)(HB + (size_t)row * DM + c0) = w;
                    ss += (o0[0] * o0[0] + o0[1] * o0[1]) + (o0[2] * o0[2] + o0[3] * o0[3]) + (o1[0] * o1[0] + o1[1] * o1[1]) + (o1[2] * o1[2] + o1[3] * o1[3]);
                }
                if (ssq_off >= 0) { ss += __shfl_xor(ss, 16); ss += __shfl_xor(ss, 32); if (fq == 0) __hip_atomic_fetch_add(ssq + row, ss, __ATOMIC_RELAXED, __HIP_MEMORY_SCOPE_AGENT); }
            }
        }
    }
};

typedef float f32x2 __attribute__((ext_vector_type(2)));
struct EpiGU {
    static constexpr bool PERM = true;
    unsigned char* ws_; float* out_; int ssq_off;
    __device__ __forceinline__ void operator()(AccRef acc, const pg8::Unit& u, int wr, int wc, int, int) const {
        EPI_ENTRY();
        bf16* ACT = (bf16*)(ws + WS_ACT); const float* ssq = (const float*)(ws + WS_SSQ) + ssq_off;
        float sq[2][4];
#pragma unroll
        for (int ai = 0; ai < 2; ++ai)
#pragma unroll
            for (int m = 0; m < 4; ++m) sq[ai][m] = ssq[u.pm * 256 + ai * 128 + wr * 64 + m * 16 + fr];
        asm volatile("" ::: "memory");
#pragma unroll
        for (int ai = 0; ai < 2; ++ai)
#pragma unroll
            for (int m = 0; m < 4; ++m) {
                const int row = u.pm * 256 + ai * 128 + wr * 64 + m * 16 + fr;
                const float rstd = __builtin_amdgcn_rsqf(sq[ai][m] * (1.0f / DM) + EPS);
                const float rc = -rstd * LOG2E, r2 = rstd * rstd;
                unsigned pk[4];
#pragma unroll
                for (int n = 0; n < 2; ++n)
#pragma unroll
                    for (int h = 0; h < 2; ++h) {
                        const f32x2 g2 = {acc[ai][0][m][n][2 * h], acc[ai][0][m][n][2 * h + 1]}, u2 = {acc[ai][1][m][n][2 * h], acc[ai][1][m][n][2 * h + 1]};
                        const f32x2 x2 = g2 * rc; f32x2 d2; d2.x = fexp2(x2.x); d2.y = fexp2(x2.y); d2 = d2 + 1.0f;
                        f32x2 q2; q2.x = frcp(d2.x); q2.y = frcp(d2.y);
                        const f32x2 t2 = (g2 * u2) * r2 * q2;
                        pk[2 * n + h] = cvt_pk(t2.x, t2.y);
                    }
                v4u w; w.x = pk[0]; w.y = pk[1]; w.z = pk[2]; w.w = pk[3];
                *(v4u*)(ACT + (size_t)row * FF + u.pn * 128 + wc * 32 + 8 * fq) = w;
            }
    }
};

struct EpiPP {
    static constexpr bool PERM = true;
    unsigned char* ws_; float* out_;
    __device__ __forceinline__ void operator()(AccRef acc, const pg8::Unit& u, int wr, int wc, int, int) const {
        EPI_ENTRY();
        bf16* PP = (bf16*)(ws + WS_XB);
#pragma unroll
        for (int ai = 0; ai < 2; ++ai)
#pragma unroll
            for (int m = 0; m < 4; ++m) {
                const int row = u.pm * 256 + ai * 128 + wr * 64 + m * 16 + fr;
#pragma unroll
                for (int bj = 0; bj < 2; ++bj) {
                    const int c0 = u.pn * 256 + bj * 128 + wc * 32 + 8 * fq;
                    const f32x4 o0 = acc[ai][bj][m][0], o1 = acc[ai][bj][m][1];
                    v4u w; w.x = cvt_pk(o0[0], o0[1]); w.y = cvt_pk(o0[2], o0[3]); w.z = cvt_pk(o1[0], o1[1]); w.w = cvt_pk(o1[2], o1[3]);
                    *(v4u*)(PP + (size_t)row * DM + c0) = w;
                }
            }
    }
};

struct EpiPG {
    static constexpr bool PERM = true;
    unsigned char* ws_; float* out_; int ssq_off;
    __device__ __forceinline__ void operator()(AccRef acc, const pg8::Unit& u, int wr, int wc, int, int) const {
        EPI_ENTRY();
        const bf16* HB = (const bf16*)(ws + WS_HB); bf16* XB = (bf16*)(ws + WS_XB); float* ssq = (float*)(ws + WS_SSQ) + ssq_off;
#pragma unroll
        for (int ai = 0; ai < 2; ++ai) {
            v4u hwv[4][2], pwv[4][2];
#pragma unroll
            for (int m = 0; m < 4; ++m) { const int row = u.pm * 256 + ai * 128 + wr * 64 + m * 16 + fr;
#pragma unroll
                for (int bj = 0; bj < 2; ++bj) { const size_t off = (size_t)row * DM + u.pn * 256 + bj * 128 + wc * 32 + 8 * fq; hwv[m][bj] = *(const v4u*)(HB + off); pwv[m][bj] = *(const v4u*)(XB + off); } }
            asm volatile("" ::: "memory");
#pragma unroll
            for (int m = 0; m < 4; ++m) {
                const int row = u.pm * 256 + ai * 128 + wr * 64 + m * 16 + fr;
                float ss = 0.f;
#pragma unroll
                for (int bj = 0; bj < 2; ++bj) {
                    const int c0 = u.pn * 256 + bj * 128 + wc * 32 + 8 * fq;
                    const v4u hw = hwv[m][bj], pw = pwv[m][bj];
                    const float hh[8] = {bf_lo(hw.x), bf_hi(hw.x), bf_lo(hw.y), bf_hi(hw.y), bf_lo(hw.z), bf_hi(hw.z), bf_lo(hw.w), bf_hi(hw.w)};
                    const float pp[8] = {bf_lo(pw.x), bf_hi(pw.x), bf_lo(pw.y), bf_hi(pw.y), bf_lo(pw.z), bf_hi(pw.z), bf_lo(pw.w), bf_hi(pw.w)};
                    float o[8];
#pragma unroll
                    for (int j = 0; j < 4; ++j) {
                        o[j] = hh[j] + pp[j] * frcp(1.0f + fexp2(-acc[ai][bj][m][0][j] * LOG2E));
                        o[4 + j] = hh[4 + j] + pp[4 + j] * frcp(1.0f + fexp2(-acc[ai][bj][m][1][j] * LOG2E));
                    }
                    v4u w; w.x = cvt_pk(o[0], o[1]); w.y = cvt_pk(o[2], o[3]); w.z = cvt_pk(o[4], o[5]); w.w = cvt_pk(o[6], o[7]);
                    *(v4u*)(XB + (size_t)row * DM + c0) = w;
#pragma unroll
                    for (int j = 0; j < 8; ++j) ss += o[j] * o[j];
                }
                ss += __shfl_xor(ss, 16); ss += __shfl_xor(ss, 32);
                if (fq == 0) __hip_atomic_fetch_add(ssq + row, ss, __ATOMIC_RELAXED, __HIP_MEMORY_SCOPE_AGENT);
            }
        }
    }
};

template <bool GU>
__device__ __forceinline__ void transpose_item(const float* W, int K, int N, bf16* WT, const float* gs, LAS float* scr, int item, int lane) {
    const int nblk = N / 32, kb = item / nblk, nb = item % nblk, k0 = 64 * kb, n0 = 32 * nb;
#pragma unroll 16
    for (int i = 0; i < 32; ++i) { const int kk = 2 * i + (lane >> 5); float w = W[(size_t)(k0 + kk) * N + n0 + (lane & 31)]; if (gs) w *= gs[k0 + kk]; scr[kk * 33 + (lane & 31)] = w; }
    asm volatile("s_waitcnt lgkmcnt(0)" ::: "memory");
    int d0 = n0;
    if (GU) { const int f = (n0 < FF) ? n0 : n0 - FF; d0 = 256 * (f >> 7) + (f & 127) + ((n0 < FF) ? 0 : 128); }
    const int c = lane & 7;
#pragma unroll
    for (int j = 0; j < 4; ++j) { const int n = (lane >> 3) + 8 * j; const LAS float* s = scr + (8 * c) * 33 + n;
        v4u o; o.x = cvt_pk(s[0 * 33], s[1 * 33]); o.y = cvt_pk(s[2 * 33], s[3 * 33]); o.z = cvt_pk(s[4 * 33], s[5 * 33]); o.w = cvt_pk(s[6 * 33], s[7 * 33]);
        *(v4u*)(WT + (size_t)(d0 + n) * K + k0 + 8 * c) = o; }
    asm volatile("s_waitcnt lgkmcnt(0)" ::: "memory");
}

__device__ __forceinline__ void convert_flat(const float* src, bf16* dst, size_t n, size_t gtid, size_t gthreads) {
    for (size_t i = gtid * 8; i < n; i += gthreads * 8) {
        const f32x4 a = *(const f32x4*)(src + i), b = *(const f32x4*)(src + i + 4);
        v4u w; w.x = cvt_pk(a[0], a[1]); w.y = cvt_pk(a[2], a[3]); w.z = cvt_pk(b[0], b[1]); w.w = cvt_pk(b[2], b[3]);
        *(v4u*)(dst + i) = w;
    }
}

constexpr float ATT_THR = 6.0f;
constexpr int AL_V = 0, AL_EXT = 65536, AL_RED = AL_EXT + 26624, AL_UNIT = AL_RED + 2048;
struct AttnArgs { const bf16 *Z, *CKA, *CVA, *CKB, *CVB; const float *sinks, *goa, *gob; bf16* O; unsigned* ctr; };

template <bool ISA>
__device__ __forceinline__ void attn_unit(LAS unsigned char* lds, const AttnArgs& T, int sc, int wave, int) {
    const int lane = lane_id();
    const int fr = lane & 15, fq = lane >> 4;
    const bool samp = sc >= 512;
    const int b = samp ? sc - 512 : sc >> 8, c = samp ? 255 : (sc & 255);
    const int row0 = samp ? MP + b * 64 : b * 16384 + c * 64;
    constexpr int NPREV = ISA ? 8 : 2;
    const int kc0 = (NPREV - c) > 0 ? (NPREV - c) : 0;
    const int hd = wave, kv = wave >> 2;
    const int qcol = ISA ? hd * 64 : 1536 + hd * 64;
    LAS unsigned char* vst = lds + AL_V + wave * 8192;
    const LAS float* ext = (const LAS float*)(lds + AL_EXT) + hd * 832;
    LAS float* red = (LAS float*)(lds + AL_RED);

    bf16x8 qf[4][2];
#pragma unroll
    for (int qb = 0; qb < 4; ++qb)
#pragma unroll
        for (int ks = 0; ks < 2; ++ks) qf[qb][ks] = *(const bf16x8*)((const char*)(T.Z + (size_t)(row0 + 16 * qb) * NIN + qcol + 32 * ks) + (unsigned)((fr * NIN + 8 * fq) * 2));
    f32x4 o[4][4];
#pragma unroll
    for (int db = 0; db < 4; ++db)
#pragma unroll
        for (int qb = 0; qb < 4; ++qb) o[db][qb] = (f32x4){0.f, 0.f, 0.f, 0.f};
    const float sink2 = ISA ? 0.f : T.sinks[hd] * LOG2E;
    float mrow[4], lrow[4];
#pragma unroll
    for (int qb = 0; qb < 4; ++qb) { mrow[qb] = ISA ? -1e30f : sink2; lrow[qb] = 0.f; }

#define ATT_TILE_PTRS(KC, KP, VP, PITCH) do { \
        if (samp && (KC) < NPREV) { \
            if (ISA) { const size_t off_ = ((size_t)(b * 512 + (KC) * 64)) * 512 + hd * 64; KP = T.CKA + off_; VP = T.CVA + off_; PITCH = 512; } \
            else { const size_t off_ = ((size_t)(b * 128 + (KC) * 64)) * 128 + kv * 64; KP = T.CKB + off_; VP = T.CVB + off_; PITCH = 128; } \
        } else { \
            const size_t r_ = (size_t)(row0 - (NPREV - (KC)) * 64) * NIN; \
            KP = T.Z + r_ + (ISA ? 512 + hd * 64 : 2048 + kv * 64); VP = T.Z + r_ + (ISA ? 1024 + hd * 64 : 2176 + kv * 64); PITCH = NIN; \
        } } while (0)
#define ATT_LOAD_K(KP, PITCH) do { _Pragma("unroll") for (int kb = 0; kb < 4; ++kb) { \
        const char* kr_ = (const char*)((KP) + (size_t)(16 * kb) * (PITCH)) + (unsigned)((fr * (PITCH) + 8 * fq) * 2); kf[kb][0] = *(const bf16x8*)kr_; kf[kb][1] = *(const bf16x8*)(kr_ + 64); } } while (0)
    bf16x8 kf[4][2];
    { const bf16 *kp0, *vp0; int pitch0; ATT_TILE_PTRS(kc0, kp0, vp0, pitch0); (void)vp0; ATT_LOAD_K(kp0, pitch0); }
    for (int kc = kc0; kc <= NPREV; ++kc) {
        const bf16 *kp, *vp; int pitch;
        ATT_TILE_PTRS(kc, kp, vp, pitch); (void)kp;
        {
            const unsigned voff = (unsigned)(((lane >> 3) * pitch + (((lane & 7) ^ ((lane >> 3) & 6)) * 8)) * 2);
#pragma unroll
            for (int i = 0; i < 8; ++i)
                __builtin_amdgcn_global_load_lds((const unsigned*)((const char*)(vp + (size_t)(8 * i) * pitch) + voff), (LAS unsigned*)(vst + i * 1024), 16, 0, 0);
        }
        bf16x8 pf[4][2];
#pragma unroll
        for (int qh = 0; qh < 2; ++qh) {
            f32x4 s[4][2];
            const LAS float* eb = ext + (768 + 32 * qh + fr - 64 * kc - 4 * fq);
#pragma unroll
            for (int kb = 0; kb < 4; ++kb)
#pragma unroll
                for (int q2 = 0; q2 < 2; ++q2) {
                    f32x4 c0 = (f32x4){0.f, 0.f, 0.f, 0.f};
                    if (ISA) { const LAS float* e = eb + (16 * q2 - 16 * kb); c0 = (f32x4){e[0], e[-1], e[-2], e[-3]}; }
                    f32x4 t = __builtin_amdgcn_mfma_f32_16x16x32_bf16(kf[kb][0], qf[2 * qh + q2][0], c0, 0, 0, 0);
                    s[kb][q2] = __builtin_amdgcn_mfma_f32_16x16x32_bf16(kf[kb][1], qf[2 * qh + q2][1], t, 0, 0, 0);
                }
            if (qh == 1) { const int kn = kc < NPREV ? kc + 1 : kc; const bf16 *kpn, *vpn; int pitchn; ATT_TILE_PTRS(kn, kpn, vpn, pitchn); (void)vpn; ATT_LOAD_K(kpn, pitchn); }
#pragma unroll
            for (int q2 = 0; q2 < 2; ++q2) {
                const int qb = 2 * qh + q2;
                float mx = fmaxf(fmaxf(s[0][q2][0], s[0][q2][1]), s[0][q2][2]);
                mx = fmaxf(fmaxf(mx, s[0][q2][3]), s[1][q2][0]); mx = fmaxf(fmaxf(mx, s[1][q2][1]), s[1][q2][2]); mx = fmaxf(fmaxf(mx, s[1][q2][3]), s[2][q2][0]);
                mx = fmaxf(fmaxf(mx, s[2][q2][1]), s[2][q2][2]); mx = fmaxf(fmaxf(mx, s[2][q2][3]), s[3][q2][0]); mx = fmaxf(fmaxf(mx, s[3][q2][1]), s[3][q2][2]); mx = fmaxf(mx, s[3][q2][3]);
                if (!__all(mx <= mrow[qb] + ATT_THR)) {
                    mx = fmaxf(mx, __shfl_xor(mx, 16)); mx = fmaxf(mx, __shfl_xor(mx, 32));
                    const float mnew = fmaxf(mrow[qb], mx), alpha = fexp2(mrow[qb] - mnew);
                    mrow[qb] = mnew; lrow[qb] = lrow[qb] * alpha;
#pragma unroll
                    for (int db = 0; db < 4; ++db) o[db][qb] = o[db][qb] * alpha;
                }
                const float mcur = mrow[qb];
                float ps = 0.f; float p[4][4];
#pragma unroll
                for (int kb = 0; kb < 4; ++kb)
#pragma unroll
                    for (int j = 0; j < 4; ++j) { p[kb][j] = fexp2(s[kb][q2][j] - mcur); ps += p[kb][j]; }
                lrow[qb] += ps;
#pragma unroll
                for (int kp2 = 0; kp2 < 2; ++kp2) {
                    v4u w; w.x = cvt_pk(p[2 * kp2][0], p[2 * kp2][1]); w.y = cvt_pk(p[2 * kp2][2], p[2 * kp2][3]);
                    w.z = cvt_pk(p[2 * kp2 + 1][0], p[2 * kp2 + 1][1]); w.w = cvt_pk(p[2 * kp2 + 1][2], p[2 * kp2 + 1][3]);
                    pf[qb][kp2] = __builtin_bit_cast(bf16x8, w);
                }
            }
        }
        asm volatile("s_waitcnt vmcnt(8)" ::: "memory");
        __builtin_amdgcn_wave_barrier();
        const int tq = (lane & 15) >> 2, tp = lane & 3;
#pragma unroll
        for (int kp2 = 0; kp2 < 2; ++kp2) {
            bf16x8 vf[4];
#pragma unroll
            for (int db = 0; db < 4; ++db) {
                const int r8 = 4 * (fq & 1) + tq;
                LAS unsigned char* a0 = vst + (4 * kp2 + (fq >> 1)) * 1024 + r8 * 128 + (((2 * db + (tp >> 1)) ^ (r8 & 6)) * 16) + (tp & 1) * 8;
                const s16x4 lo = __builtin_bit_cast(s16x4, __builtin_amdgcn_ds_read_tr16_b64_v4i16((LAS s16x4*)a0));
                const s16x4 hi = __builtin_bit_cast(s16x4, __builtin_amdgcn_ds_read_tr16_b64_v4i16((LAS s16x4*)(a0 + 2048)));
                vf[db] = (bf16x8){lo[0], lo[1], lo[2], lo[3], hi[0], hi[1], hi[2], hi[3]};
            }
#pragma unroll
            for (int qb = 0; qb < 4; ++qb)
#pragma unroll
                for (int db = 0; db < 4; ++db) o[db][qb] = __builtin_amdgcn_mfma_f32_16x16x32_bf16(vf[db], pf[qb][kp2], o[db][qb], 0, 0, 0);
        }
        asm volatile("" ::: "memory");
    }
#pragma unroll
    for (int qb = 0; qb < 4; ++qb) {
        float lt = lrow[qb]; lt += __shfl_xor(lt, 16); lt += __shfl_xor(lt, 32);
        if (!ISA) lt += fexp2(sink2 - mrow[qb]);
        const float inv = 1.0f / lt; float ss = 0.f;
#pragma unroll
        for (int db = 0; db < 4; ++db) { o[db][qb] = o[db][qb] * inv;
#pragma unroll
            for (int j = 0; j < 4; ++j) ss += o[db][qb][j] * o[db][qb][j]; }
        ss += __shfl_xor(ss, 16); ss += __shfl_xor(ss, 32);
        if (fq == 0) red[wave * 64 + 16 * qb + fr] = ss;
    }
    __syncthreads();
    const float* gout = (ISA ? T.goa : T.gob) + hd * 64 + 4 * (lane_id() >> 4);
    f32x4 gv[4];
#pragma unroll
    for (int db = 0; db < 4; ++db) gv[db] = *(const f32x4*)(gout + 16 * db);
#pragma unroll
    for (int qb = 0; qb < 4; ++qb) {
        float tot = 0.f;
#pragma unroll
        for (int w = 0; w < 8; ++w) tot += red[w * 64 + 16 * qb + fr];
        const float rstd = __builtin_amdgcn_rsqf(tot * (1.0f / 512.0f) + EPS);
        char* orow = (char*)(T.O + (size_t)(row0 + 16 * qb) * DM + (ISA ? 0 : 512) + hd * 64) + (unsigned)((fr * DM + 4 * fq) * 2);
#pragma unroll
        for (int db = 0; db < 4; ++db) { const f32x4 v = o[db][qb] * rstd * gv[db];
            v2u w; w.x = cvt_pk(v[0], v[1]); w.y = cvt_pk(v[2], v[3]); *(v2u*)(orow + 32 * db) = w; }
    }
}

__device__ __forceinline__ void attn_phase(LAS unsigned char* lds, const AttnArgs& T, const float* relb, const int wave) {
    const int lane = lane_id(), tid = wave * 64 + lane;
    LAS float* ext = (LAS float*)(lds + AL_EXT);
    for (int i = tid; i < 8 * 832; i += NWAVES * 64) { const int h = i / 832, k = i % 832; ext[i] = relb[h * 513 + (k < 512 ? k : 512)] * LOG2E; }
    volatile LAS unsigned* uw = (volatile LAS unsigned*)(lds + AL_UNIT);
    int qcur = (int)(blockIdx.x & 7u), qleft = 8;
    for (;;) {
        __syncthreads();
        if (tid == 0) {
            unsigned code = 0xffffffffu;
            while (qleft > 0) {
                const unsigned j = __hip_atomic_fetch_add(T.ctr + 16 * qcur, 1u, __ATOMIC_RELAXED, __HIP_MEMORY_SCOPE_AGENT);
                if (j < 132u) { code = (unsigned)qcur * 132u + j; break; }
                qcur = (qcur + 1) & 7; --qleft;
            }
            uw[0] = code;
        }
        __syncthreads();
        const unsigned u = (unsigned)__builtin_amdgcn_readfirstlane((int)uw[0]);
        if (u == 0xffffffffu) break;
        const int qq = (int)(u / 132u), j = (int)(u % 132u);
        if (j < 66) attn_unit<true>(lds, T, qq * 66 + j, wave, lane); else attn_unit<false>(lds, T, qq * 66 + j - 66, wave, lane);
    }
    __syncthreads();
}

struct Args { const float* in[21]; float* out; unsigned char* ws; };

constexpr size_t WS_SMALL = 768 * 1024, WS_BAR = 2048;
constexpr int SM_RELB = 0, SM_SINK = 8448, SM_GOA = 8512, SM_GOB = 9536, SM_GFIN = 10560, SM_END = 11584;
static_assert(WS_SSQ + (size_t)5 * MT * 4 <= WS_SMALL && WS_SMALL + SM_END * 4 <= WS_ROPE, "control region map");

__device__ __forceinline__ void grid_bar(unsigned* bar, unsigned k, unsigned G, unsigned bid, bool leader) {
    asm volatile("s_waitcnt vmcnt(0) lgkmcnt(0)" ::: "memory");
    __syncthreads();
    if (leader) {
        const unsigned g = bid & 7u, gsz = (G - g + 7u) >> 3, ng = G < 8u ? G : 8u;
        unsigned* gcnt = bar + 16 * (1 + g); unsigned* ggen = bar + 16 * (9 + g); unsigned* top = bar + 16 * 17;
        __builtin_amdgcn_fence(__ATOMIC_RELEASE, "agent");
        asm volatile("s_waitcnt vmcnt(0)" ::: "memory");
        const unsigned old = __hip_atomic_fetch_add(gcnt, 1u, __ATOMIC_RELAXED, __HIP_MEMORY_SCOPE_AGENT);
        if (old + 1u == k * gsz) {
            __hip_atomic_fetch_add(top, 1u, __ATOMIC_RELAXED, __HIP_MEMORY_SCOPE_AGENT);
            while (__hip_atomic_load(top, __ATOMIC_RELAXED, __HIP_MEMORY_SCOPE_AGENT) < k * ng) __builtin_amdgcn_s_sleep(1);
            __hip_atomic_fetch_add(ggen, 1u, __ATOMIC_RELAXED, __HIP_MEMORY_SCOPE_AGENT);
        } else {
            while (__hip_atomic_load(ggen, __ATOMIC_RELAXED, __HIP_MEMORY_SCOPE_AGENT) < k) __builtin_amdgcn_s_sleep(1);
        }
        __builtin_amdgcn_fence(__ATOMIC_ACQUIRE, "agent");
        asm volatile("s_waitcnt vmcnt(0)" ::: "memory");
    }
    __syncthreads();
}

struct PIn { const float *w_in, *w_out, *w_gu, *w_d, *w_pp, *w_pg, *g_mix, *g_ffn, *p_p, *p_s, *cak, *cav, *cbk, *cbv; };

__device__ __forceinline__ void conv_weights(LAS unsigned char* lds, unsigned char* ws, const PIn& I, const int l, const int wave, const int lane, const int gw, const int NGW, const int r_lo, const int r_hi) {
    LAS float* scr = (LAS float*)(lds + wave * 8448);
    constexpr int I_IN = (DM / 64) * (NIN / 32), I_OUT = (DM / 64) * (DM / 32), I_GU = (DM / 64) * (2 * FF / 32), I_D = (FF / 64) * (DM / 32), I_PP = (DPLE / 64) * (DM / 32), I_PG = I_OUT;
    constexpr int I_LAYER = I_IN + I_OUT + I_GU + I_D + I_PP + I_PG;
    unsigned char* wb = ws + WS_W + (size_t)l * W_LAYER;
    for (int it = r_lo + gw; it < (r_hi < I_LAYER ? r_hi : I_LAYER); it += NGW) {
        int r = it;
        if (r < I_IN) { transpose_item<false>(I.w_in + (size_t)l * DM * NIN, DM, NIN, (bf16*)(wb + W_IN), I.g_mix + l * DM, scr, r, lane); continue; } r -= I_IN;
        if (r < I_OUT) { transpose_item<false>(I.w_out + (size_t)l * DM * DM, DM, DM, (bf16*)(wb + W_OUT), nullptr, scr, r, lane); continue; } r -= I_OUT;
        if (r < I_GU) { transpose_item<true>(I.w_gu + (size_t)l * DM * 2 * FF, DM, 2 * FF, (bf16*)(wb + W_GU), I.g_ffn + l * DM, scr, r, lane); continue; } r -= I_GU;
        if (r < I_D) { transpose_item<false>(I.w_d + (size_t)l * FF * DM, FF, DM, (bf16*)(wb + W_D), nullptr, scr, r, lane); continue; } r -= I_D;
        if (r < I_PP) { transpose_item<false>(I.w_pp + (size_t)l * DPLE * DM, DPLE, DM, (bf16*)(wb + W_PP), nullptr, scr, r, lane); continue; } r -= I_PP;
        transpose_item<false>(I.w_pg + (size_t)l * DM * DM, DM, DM, (bf16*)(wb + W_PG), nullptr, scr, r, lane);
    }
}
__device__ __forceinline__ void conv_p_caches(unsigned char* ws, float* out, const PIn& I, const int l, const size_t gtid, const size_t gth) {
    bf16* PB = (bf16*)(ws + WS_PB);
    convert_flat(I.p_p + (size_t)l * MP * DPLE, PB + (size_t)l * MT * DPLE, (size_t)MP * DPLE, gtid, gth);
    convert_flat(I.p_s + (size_t)l * MS * DPLE, PB + (size_t)l * MT * DPLE + (size_t)MP * DPLE, (size_t)MS * DPLE, gtid, gth);
    constexpr size_t NA = (size_t)16 * 512 * 512, NB = (size_t)16 * 128 * 128;
    for (size_t i = gtid * 8; i < NA; i += gth * 8) {
        const size_t gi = (size_t)l * NA + i;
        const f32x4 a = *(const f32x4*)(I.cak + gi), b = *(const f32x4*)(I.cak + gi + 4), c = *(const f32x4*)(I.cav + gi), d = *(const f32x4*)(I.cav + gi + 4);
        v4u w; w.x = cvt_pk(a[0], a[1]); w.y = cvt_pk(a[2], a[3]); w.z = cvt_pk(b[0], b[1]); w.w = cvt_pk(b[2], b[3]);
        *(v4u*)((bf16*)(ws + WS_CKA) + gi) = w;
        w.x = cvt_pk(c[0], c[1]); w.y = cvt_pk(c[2], c[3]); w.z = cvt_pk(d[0], d[1]); w.w = cvt_pk(d[2], d[3]);
        *(v4u*)((bf16*)(ws + WS_CVA) + gi) = w;
        if (((i >> 9) & 511) >= 64) { float* dk = out + O_AKS + gi - 32768; float* dv = out + O_AVS + gi - 32768;
            *(f32x4*)dk = a; *(f32x4*)(dk + 4) = b; *(f32x4*)dv = c; *(f32x4*)(dv + 4) = d; }
    }
    for (size_t i = gtid * 8; i < NB; i += gth * 8) {
        const size_t gi = (size_t)l * NB + i;
        const f32x4 a = *(const f32x4*)(I.cbk + gi), b = *(const f32x4*)(I.cbk + gi + 4), c = *(const f32x4*)(I.cbv + gi), d = *(const f32x4*)(I.cbv + gi + 4);
        v4u w; w.x = cvt_pk(a[0], a[1]); w.y = cvt_pk(a[2], a[3]); w.z = cvt_pk(b[0], b[1]); w.w = cvt_pk(b[2], b[3]);
        *(v4u*)((bf16*)(ws + WS_CKB) + gi) = w;
        w.x = cvt_pk(c[0], c[1]); w.y = cvt_pk(c[2], c[3]); w.z = cvt_pk(d[0], d[1]); w.w = cvt_pk(d[2], d[3]);
        *(v4u*)((bf16*)(ws + WS_CVB) + gi) = w;
        if (((i >> 7) & 127) >= 64) { float* dk = out + O_BKS + gi - 8192; float* dv = out + O_BVS + gi - 8192;
            *(f32x4*)dk = a; *(f32x4*)(dk + 4) = b; *(f32x4*)dv = c; *(f32x4*)(dv + 4) = d; }
    }
}

template <int l>
__device__ __forceinline__ void run_layer(LAS unsigned char* lds, unsigned char* ws_in, float* out_in, const float* x_p, const float* x_s, const PIn* pin, const int G, const int bid, const int wave) {
    GAS unsigned char* wsg_ = (GAS unsigned char*)ws_in; GAS float* outg_ = (GAS float*)out_in; asm volatile("" : "+s"(wsg_), "+s"(outg_));
    unsigned char* ws = (unsigned char*)wsg_; float* out = (float*)outg_;
    unsigned* const bar = (unsigned*)(ws + WS_BAR);
#define GRID_BAR(k) grid_bar(bar, (unsigned)((k) + 1), (unsigned)G, (unsigned)bid, wave == 0 && lane_id() == 0)
        unsigned char* wb = ws + WS_W + (size_t)l * W_LAYER;
        bf16 *XB = (bf16*)(ws + WS_XB), *HB = (bf16*)(ws + WS_HB), *O = (bf16*)(ws + WS_O), *ACT = (bf16*)(ws + WS_ACT);
        {
            pg8::RowOrder<NIN / 256> S; S.init(G, bid);
            EpiIn E{ws, out, (l == 0) ? 0 : 2 * MT, l};
            pg8::gemm_phase<DM, EpiIn, pg8::RowOrder<NIN / 256>>(lds, XB, (const bf16*)(wb + W_IN), S, E, wave);
            if (l == 0) {
                const int nbusy = (MT / 256 * (NIN / 256)) % G;
                if (S.v >= nbusy) { const int lane = lane_id(); const PIn I = *pin;
                    conv_p_caches(ws, out, I, 0, (size_t)(S.v - nbusy) * (NWAVES * 64) + wave * 64 + lane, (size_t)(G - nbusy) * (NWAVES * 64)); }
            }
        }
        GRID_BAR(6 * l + 1);
        {
            const float* sm = (const float*)(ws + WS_SMALL);
            AttnArgs T{(const bf16*)(ws + WS_Z), (const bf16*)(ws + WS_CKA) + (size_t)l * 16 * 512 * 512, (const bf16*)(ws + WS_CVA) + (size_t)l * 16 * 512 * 512,
                       (const bf16*)(ws + WS_CKB) + (size_t)l * 16 * 128 * 128, (const bf16*)(ws + WS_CVB) + (size_t)l * 16 * 128 * 128,
                       sm + SM_SINK + l * 8, sm + SM_GOA + l * 512, sm + SM_GOB + l * 512, O, (unsigned*)(ws + WS_CTL) + 128 * l};
            attn_phase(lds, T, sm + SM_RELB + (size_t)l * 8 * 513, wave);
        }
        GRID_BAR(6 * l + 2);
        {
            pg8::RowOrder<DM / 256> S; S.init(G, bid);
            EpiRes E{ws, out, (l == 0) ? x_p : nullptr, x_s, 1, (1 + 2 * l) * MT};
            pg8::gemm_phase<DM, EpiRes, pg8::RowOrder<DM / 256>>(lds, O, (const bf16*)(wb + W_OUT), S, E, wave);
            if (l == 0) {
                const int nbusy = (MT / 256 * 4) % G;
                if (S.v >= nbusy) { const int lane = lane_id(); const PIn I = *pin; __syncthreads();
                    conv_weights(lds, ws, I, 0, wave, lane, (S.v - nbusy) * NWAVES + wave, (G - nbusy) * NWAVES, W_ITEMS_EARLY, 1 << 30); }
            }
        }
        GRID_BAR(6 * l + 3);
        {
            pg8::RowOrder<2 * FF / 256> S; S.init(G, bid);
            EpiGU E{ws, out, (1 + 2 * l) * MT};
            pg8::gemm_phase<DM, EpiGU, pg8::RowOrder<2 * FF / 256>>(lds, HB, (const bf16*)(wb + W_GU), S, E, wave);
            if (l == 0) {
                const int nbusy = (MT / 256 * (2 * FF / 256)) % G;
                if (S.v >= nbusy) { const int lane = lane_id(); const PIn I = *pin;
                    conv_p_caches(ws, out, I, 1, (size_t)(S.v - nbusy) * (NWAVES * 64) + wave * 64 + lane, (size_t)(G - nbusy) * (NWAVES * 64)); }
            }
        }
        GRID_BAR(6 * l + 4);
        {
            pg8::RowOrder<DM / 256> S; S.init(G, bid);
            EpiRes E{ws, out, nullptr, nullptr, 0, -1};
            pg8::gemm_phase<FF, EpiRes, pg8::RowOrder<DM / 256>>(lds, ACT, (const bf16*)(wb + W_D), S, E, wave);
            pg8::RowOrder<DM / 256> S2; S2.init(G, G - 1 - bid);
            EpiPP E2{ws, out};
            pg8::gemm_phase<DPLE, EpiPP, pg8::RowOrder<DM / 256>>(lds, (const bf16*)(ws + WS_PB) + (size_t)l * MT * DPLE, (const bf16*)(wb + W_PP), S2, E2, wave);
            if (l == 0) {
                const int nbusy = (MT / 256 * 4) % G;
                if (S.v >= nbusy) { const int lane = lane_id(); const PIn I = *pin; __syncthreads();
                    conv_weights(lds, ws, I, 1, wave, lane, (S.v - nbusy) * NWAVES + wave, (G - nbusy) * NWAVES, 0, 1 << 30); }
            }
        }
        GRID_BAR(6 * l + 5);
        {
            pg8::RowOrder<DM / 256> S; S.init(G, bid);
            EpiPG E{ws, out, (2 + 2 * l) * MT};
            pg8::gemm_phase<DM, EpiPG, pg8::RowOrder<DM / 256>>(lds, HB, (const bf16*)(wb + W_PG), S, E, wave);
        }
        GRID_BAR(6 * l + 6);
    }
#undef GRID_BAR

__global__ void __launch_bounds__(NWAVES * 64, 2) mega_fwd(Args args) {
    extern __shared__ __attribute__((aligned(16))) unsigned char lds_raw[];
    LAS unsigned char* lds = (LAS unsigned char*)lds_raw;
    const int wave = __builtin_amdgcn_readfirstlane((int)threadIdx.x >> 6);
    const int G = gridDim.x, bid = blockIdx.x;
    unsigned char* const ws = args.ws;
    float* const out = args.out;
    float* const H = out + O_Y;

    if (args.ws == nullptr) cg::this_grid().sync();
    {
        const float *x_p = args.in[0], *x_s = args.in[1], *p_p = args.in[2], *p_s = args.in[3], *cak = args.in[4], *cav = args.in[5], *cbk = args.in[6], *cbv = args.in[7],
                    *g_mix = args.in[8], *w_in = args.in[9], *relb = args.in[10], *sinks = args.in[11], *goa = args.in[12], *gob = args.in[13], *w_out = args.in[14],
                    *g_ffn = args.in[15], *w_gu = args.in[16], *w_d = args.in[17], *w_pp = args.in[18], *w_pg = args.in[19], *g_fin = args.in[20];
        float* ssqb = (float*)(ws + WS_SSQ);
        float* rope = (float*)(ws + WS_ROPE);
        float* sm = (float*)(ws + WS_SMALL);
        bf16 *XB = (bf16*)(ws + WS_XB), *PB = (bf16*)(ws + WS_PB);
        const int lane = lane_id(), tid = wave * 64 + lane;
        const int gw = bid * NWAVES + wave, NGW = G * NWAVES;
        const size_t gtid = (size_t)bid * (NWAVES * 64) + tid, gth = (size_t)G * (NWAVES * 64);
        const PIn I{w_in, w_out, w_gu, w_d, w_pp, w_pg, g_mix, g_ffn, p_p, p_s, cak, cav, cbk, cbv};
        conv_weights(lds, ws, I, 0, wave, lane, gw, NGW, 0, W_ITEMS_EARLY);
        for (int m0 = gw; m0 < MT; m0 += 2 * NGW) {
            const int m1 = m0 + NGW; const bool has1 = m1 < MT;
            const float* xr0 = (m0 < MP) ? x_p + (size_t)m0 * DM : x_s + (size_t)(m0 - MP) * DM;
            const float* xr1 = has1 ? ((m1 < MP) ? x_p + (size_t)m1 * DM : x_s + (size_t)(m1 - MP) * DM) : xr0;
            f32x4 a[2][4];
#pragma unroll
            for (int j = 0; j < 2; ++j) { a[0][2 * j] = *(const f32x4*)(xr0 + j * 512 + lane * 8); a[0][2 * j + 1] = *(const f32x4*)(xr0 + j * 512 + lane * 8 + 4);
                                          a[1][2 * j] = *(const f32x4*)(xr1 + j * 512 + lane * 8); a[1][2 * j + 1] = *(const f32x4*)(xr1 + j * 512 + lane * 8 + 4); }
#pragma unroll
            for (int r = 0; r < 2; ++r) {
                const int m = r ? m1 : m0; float ss = 0.f;
#pragma unroll
                for (int j = 0; j < 2; ++j) { const f32x4 p = a[r][2 * j], q = a[r][2 * j + 1];
                    ss += (p[0] * p[0] + p[1] * p[1]) + (p[2] * p[2] + p[3] * p[3]) + (q[0] * q[0] + q[1] * q[1]) + (q[2] * q[2] + q[3] * q[3]);
                    v4u w; w.x = cvt_pk(p[0], p[1]); w.y = cvt_pk(p[2], p[3]); w.z = cvt_pk(q[0], q[1]); w.w = cvt_pk(q[2], q[3]);
                    if (r == 0 || has1) *(v4u*)(XB + (size_t)m * DM + j * 512 + lane * 8) = w; }
#pragma unroll
                for (int o = 1; o < 64; o <<= 1) ss += __shfl_xor(ss, o);
                if (lane == 0 && (r == 0 || has1)) ssqb[m] = ss;
            }
        }
        for (size_t i = gtid; i < (size_t)16384 * 8; i += gth) {
            const int pos = (int)(i >> 3), j = (int)(i & 7);
            const double rv = (j == 0) ? 0.15915494309189535 : (j == 1) ? 0.03086376340470123 : (j == 2) ? 0.005985185712713705 : (j == 3) ? 0.001160663641240061 :
                              (j == 4) ? 0.00022507907903927653 : (j == 5) ? 4.364795279280289e-05 : (j == 6) ? 8.464330808241401e-06 : 1.6414262627950345e-06;
            const double t = (double)pos * rv; const float fr_ = (float)(t - __builtin_floor(t));
            rope[2 * i] = __builtin_amdgcn_cosf(fr_); rope[2 * i + 1] = __builtin_amdgcn_sinf(fr_);
        }
        for (size_t i = gtid; i < (size_t)SM_END; i += gth) {
            float v = 0.f; const int k = (int)i;
            if (k < 2 * 8 * 513) v = relb[k];
            else if (k >= SM_SINK && k < SM_SINK + 16) v = sinks[k - SM_SINK];
            else if (k >= SM_GOA && k < SM_GOB) v = goa[k - SM_GOA];
            else if (k >= SM_GOB && k < SM_GFIN) v = gob[k - SM_GOB];
            else if (k >= SM_GFIN) v = g_fin[k - SM_GFIN];
            sm[k] = v;
        }
        for (size_t i = gtid; i < (size_t)4 * MT; i += gth) ssqb[MT + i] = 0.f;
        if (gtid < 256) ((unsigned*)(ws + WS_CTL))[gtid] = 0u;
    }
    grid_bar((unsigned*)(ws + WS_BAR), 1u, (unsigned)G, (unsigned)bid, wave == 0 && lane_id() == 0);

    const float* const x_p = args.in[0]; const float* const x_s = args.in[1];
    const PIn pin{args.in[9], args.in[14], args.in[16], args.in[17], args.in[18], args.in[19], args.in[8], args.in[15], args.in[2], args.in[3], args.in[4], args.in[5], args.in[6], args.in[7]};
    run_layer<0>(lds, ws, out, x_p, x_s, &pin, G, bid, wave);
    run_layer<1>(lds, ws, out, x_p, x_s, &pin, G, bid, wave);
    {
        const int lane = lane_id();
        const int gw = bid * NWAVES + wave, NGW = G * NWAVES;
        const float* ssq = (const float*)(ws + WS_SSQ) + 4 * (size_t)MT;
        const float* g_fin = (const float*)(ws + WS_SMALL) + SM_GFIN;
        const bf16* XB = (const bf16*)(ws + WS_XB);
        f32x4 gf[2][2];
#pragma unroll
        for (int j = 0; j < 2; ++j) { gf[j][0] = *(const f32x4*)(g_fin + j * 512 + lane * 8); gf[j][1] = *(const f32x4*)(g_fin + j * 512 + lane * 8 + 4); }
        for (int m = gw; m < MT; m += NGW) {
            const float rstd = __builtin_amdgcn_rsqf(ssq[m] * (1.0f / DM) + EPS);
            float* yr = H + (size_t)m * DM;
#pragma unroll
            for (int j = 0; j < 2; ++j) {
                const v4u w = *(const v4u*)(XB + (size_t)m * DM + j * 512 + lane * 8);
                const f32x4 a = (f32x4){bf_lo(w.x), bf_hi(w.x), bf_lo(w.y), bf_hi(w.y)}, b2 = (f32x4){bf_lo(w.z), bf_hi(w.z), bf_lo(w.w), bf_hi(w.w)};
                *(f32x4*)(yr + j * 512 + lane * 8) = a * rstd * gf[j][0]; *(f32x4*)(yr + j * 512 + lane * 8 + 4) = b2 * rstd * gf[j][1];
            }
        }
    }
}

extern "C" void kernel_launch(void* const* d_in, const int* in_sizes, int n_in, void* d_out, int out_size, void* d_ws, size_t ws_size, hipStream_t stream) {
    static int grid = 0;
    if (grid == 0) {
        if (n_in != 21 || (size_t)out_size != O_END || ws_size < WS_END) { fprintf(stderr, "kernel_launch: unexpected problem: n_in %d out %d ws %zu (need out %zu ws %zu)\n", n_in, out_size, ws_size, (size_t)O_END, (size_t)WS_END); grid = -1; return; }
        int dev = 0, cus = 0, per_cu = 0;
        (void)hipGetDevice(&dev);
        (void)hipDeviceGetAttribute(&cus, hipDeviceAttributeMultiprocessorCount, dev);
        if (hipFuncSetAttribute((const void*)mega_fwd, hipFuncAttributeMaxDynamicSharedMemorySize, LDS_BYTES) != hipSuccess) { fprintf(stderr, "kernel_launch: hipFuncSetAttribute failed\n"); grid = -1; return; }
        if (hipOccupancyMaxActiveBlocksPerMultiprocessor(&per_cu, (const void*)mega_fwd, NWAVES * 64, LDS_BYTES) != hipSuccess || per_cu < 1) { fprintf(stderr, "kernel_launch: occupancy query says %d blocks per CU\n", per_cu); (void)hipGetLastError(); per_cu = 1; }
        grid = cus * 1;
        if (grid <= 0) { grid = -1; return; }
    }
    if (grid < 0) return;
    (void)hipMemsetAsync((unsigned char*)d_ws + WS_BAR, 0, 2048, stream);
    Args a{};
    for (int i = 0; i < 21; ++i) a.in[i] = (const float*)d_in[i];
    a.out = (float*)d_out; a.ws = (unsigned char*)d_ws;
    void* kargs[] = {&a};
    hipError_t e = hipLaunchCooperativeKernel((const void*)mega_fwd, dim3(grid), dim3(NWAVES * 64), kargs, LDS_BYTES, stream);
    if (e != hipSuccess) fprintf(stderr, "kernel_launch: cooperative launch failed: %s (grid %d)\n", hipGetErrorString(e), grid);
}
```

```cpp
#include <hip/hip_runtime.h>
#include <hip/hip_cooperative_groups.h>
#include <cstdio>
#include <cstdint>
namespace cg = cooperative_groups;

#define GAS __attribute__((address_space(1)))
#define LAS __attribute__((address_space(3)))
typedef unsigned short bf16;
typedef unsigned v4u __attribute__((ext_vector_type(4)));
typedef unsigned v2u __attribute__((ext_vector_type(2)));
typedef float f32x4 __attribute__((ext_vector_type(4)));
typedef short bf16x8 __attribute__((ext_vector_type(8)));
typedef short s16x4 __attribute__((ext_vector_type(4)));

constexpr int MP = 32768, MS = 1024, MT = MP + MS;
constexpr int DM = 1024, NIN = 2304, FF = 2816, DPLE = 256;
constexpr float EPS = 1e-6f;
constexpr float LOG2E = 1.4426950408889634f;
constexpr float QSCALE = 0.125f * LOG2E;

__device__ __forceinline__ unsigned cvt_pk(float lo, float hi) { unsigned r; asm("v_cvt_pk_bf16_f32 %0, %1, %2" : "=v"(r) : "v"(lo), "v"(hi)); return r; }
__device__ __forceinline__ float bf_lo(unsigned w) { return __builtin_bit_cast(float, w << 16); }
__device__ __forceinline__ float bf_hi(unsigned w) { return __builtin_bit_cast(float, w & 0xffff0000u); }
__device__ __forceinline__ float fexp2(float x) { return __builtin_amdgcn_exp2f(x); }
__device__ __forceinline__ float frcp(float x) { return __builtin_amdgcn_rcpf(x); }

__device__ __forceinline__ int lane_id() { int l = __builtin_amdgcn_mbcnt_hi(~0u, __builtin_amdgcn_mbcnt_lo(~0u, 0u)); asm volatile("" : "+v"(l)); return l; }

namespace pg8 {
constexpr int BM = 256, BK = 64, HALF = 128, HTB = HALF * BK * 2, STAGE_BYTES = 8 * HTB, NXCD = 8, WGM = 8;
__host__ __device__ __forceinline__ int lds_byte(int r, int c) { const int st = (r >> 4) * 2 + (c >> 5), rr = r & 15, cc = c & 31, ob = rr * 64 + cc * 2; return st * 1024 + (ob ^ (((ob >> 9) & 1) << 5)); }
__host__ __device__ __forceinline__ void stage_rc(int b, int& R, int& C) { const int st = b / 1024, sb = b % 1024, swz = sb ^ (((sb >> 9) & 1) << 5); R = (st >> 1) * 16 + swz / 64; C = (st & 1) * 32 + (swz % 64) / 2; }
__host__ __device__ __forceinline__ int perm32(int rho) { const int n = rho >> 4, i = rho & 15; return 8 * (i >> 2) + 4 * n + (i & 3); }

struct Unit { int pm, pn; };
struct Gemm { const bf16* A; const bf16* Bt; int M, N, K; };

template <int NN>
struct RowOrder {
    int G, v;
    __device__ __forceinline__ void init(int G_, int c) { G = G_; v = (G_ % 8 == 0) ? (c % 8) * (G_ / 8) + c / 8 : c; }
    __device__ __forceinline__ bool next(int i, Unit& u) const {
        const int L = i * G + v; if (L >= (33792 / BM) * NN) return false;
        constexpr int NM = 33792 / BM, NFULL = (NM / 8) * 8 * NN;
        if (L < NFULL) { const int g = L / (8 * NN), idx = L % (8 * NN); u.pm = g * 8 + (idx & 7); u.pn = idx >> 3; }
        else { constexpr int GS = NM % 8 ? NM % 8 : 8; const int idx = L - NFULL; u.pm = (NM / 8) * 8 + idx % GS; u.pn = idx / GS; }
        return true;
    }
};

template <int KK, class Epi, class Sched, bool ALIGN_EPI = true>
__device__ __forceinline__ void gemm_phase(LAS unsigned char* lds, const bf16* gA, const bf16* gBt, const Sched& S, const Epi& E, const int wid) {
    const int lane = lane_id();
    const int tid = wid * 64 + lane, wr = wid >> 2, wc = wid & 3, fr = lane & 15, fq = lane >> 4;
    constexpr int K = KK, nt = K / BK;
    unsigned voffA[2], voffB[2];
#pragma unroll
    for (int i = 0; i < 2; ++i) { int R, C; stage_rc(tid * 16 + i * 8192, R, C); const int Rb = Epi::PERM ? ((R & ~31) + perm32(R & 31)) : R;
        voffA[i] = (unsigned)(R * K + C) * 2u; voffB[i] = (unsigned)(Rb * K + C) * 2u; }
    const size_t kstep = (size_t)(BK * 2);
    const size_t hstep = (size_t)HALF * K * 2;
    const size_t tstep = 2 * hstep;
    const unsigned ldsw = (unsigned)wid * 1024u;
    const int aoff = lds_byte(wr * 64 + fr, fq * 8), boff = lds_byte(wc * 32 + fr, fq * 8);
#define PG8_SA(b, h) (((b) * 2 + (h)) * HTB)
#define PG8_SB(b, h) ((4 + (b) * 2 + (h)) * HTB)
#define PG8_STAGE(bufoff, gbase, voff) do { _Pragma("unroll") for (int _i = 0; _i < 2; ++_i) \
        __builtin_amdgcn_global_load_lds((const unsigned*)((const char*)(gbase) + (voff)[_i]), (LAS unsigned*)(lds + (bufoff) + ldsw + _i * 8192), 16, 0, 0); } while (0)
#define PG8_LDA(dst, b, h) do { _Pragma("unroll") for (int m = 0; m < 4; ++m) _Pragma("unroll") for (int k = 0; k < 2; ++k) dst[m][k] = *(const LAS bf16x8*)(lds + PG8_SA(b, h) + aoff + m * 2048 + k * 1024); } while (0)
#define PG8_LDB(dst, b, h) do { _Pragma("unroll") for (int n = 0; n < 2; ++n) _Pragma("unroll") for (int k = 0; k < 2; ++k) dst[n][k] = *(const LAS bf16x8*)(lds + PG8_SB(b, h) + boff + n * 2048 + k * 1024); } while (0)
#define PG8_MMA(ai, bj, At, Bt) do { __builtin_amdgcn_s_setprio(1); _Pragma("unroll") for (int m = 0; m < 4; ++m) _Pragma("unroll") for (int n = 0; n < 2; ++n) _Pragma("unroll") for (int k = 0; k < 2; ++k) \
        acc[ai][bj][m][n] = __builtin_amdgcn_mfma_f32_16x16x32_bf16(Bt[n][k], At[m][k], acc[ai][bj][m][n], 0, 0, 0); __builtin_amdgcn_s_setprio(0); } while (0)
#define PG8_WAIT_V(n) asm volatile("s_waitcnt vmcnt(" #n ")" ::: "memory")
#define PG8_WAIT_L(n) asm volatile("s_waitcnt lgkmcnt(" #n ")" ::: "memory")
#define PG8_BAR __builtin_amdgcn_s_barrier()
#define PG8_SCHED __builtin_amdgcn_sched_barrier(0)
    Unit cur, nxt; int ui = 0;
    if (!S.next(0, cur)) return;
    f32x4 acc[2][2][4][2];
#pragma unroll
    for (int a = 0; a < 2; ++a)
#pragma unroll
        for (int b = 0; b < 2; ++b)
#pragma unroll
            for (int m = 0; m < 4; ++m)
#pragma unroll
                for (int n = 0; n < 2; ++n) acc[a][b][m][n] = (f32x4){0.f, 0.f, 0.f, 0.f};
    bf16x8 At[4][2], B0[2][2], B1[2][2];
    const char* cA = (const char*)gA + (size_t)cur.pm * tstep; const char* cB = (const char*)gBt + (size_t)cur.pn * tstep;
    PG8_STAGE(PG8_SB(0, 0), cB, voffB); PG8_STAGE(PG8_SB(0, 1), cB + hstep, voffB); PG8_STAGE(PG8_SA(0, 0), cA, voffA); PG8_STAGE(PG8_SA(0, 1), cA + hstep, voffA);
    if (wr == 1) PG8_BAR;
    PG8_WAIT_V(2); PG8_BAR;
    PG8_STAGE(PG8_SB(1, 0), cB + kstep, voffB); PG8_STAGE(PG8_SA(1, 0), cA + kstep, voffA); PG8_STAGE(PG8_SB(1, 1), cB + hstep + kstep, voffB);
    PG8_WAIT_V(6); PG8_BAR;
    for (;;) {
        const bool has_next = S.next(ui + 1, nxt);
        const char* nA = has_next ? (const char*)gA + (size_t)nxt.pm * tstep : cA; const char* nB = has_next ? (const char*)gBt + (size_t)nxt.pn * tstep : cB;
#pragma unroll 1
        for (int t = 0; t < nt; t += 2) {
            const bool last = (t == nt - 2);
            const char* a1 = cA + (size_t)(t + 1) * kstep;
            const char* a2 = last ? nA : cA + (size_t)(t + 2) * kstep; const char* b2 = last ? nB : cB + (size_t)(t + 2) * kstep;
            const char* a3 = a2 + kstep; const char* b3 = b2 + kstep;
            PG8_LDB(B0, 0, 0); PG8_LDB(B1, 0, 1); PG8_SCHED; PG8_LDA(At, 0, 0); PG8_STAGE(PG8_SA(1, 1), a1 + hstep, voffA);
            PG8_WAIT_V(8); PG8_WAIT_L(0); PG8_BAR; PG8_MMA(0, 0, At, B0); PG8_MMA(0, 1, At, B1); PG8_BAR; PG8_SCHED;
            PG8_LDA(At, 0, 1); PG8_STAGE(PG8_SB(0, 0), b2, voffB); PG8_STAGE(PG8_SB(0, 1), b2 + hstep, voffB); PG8_STAGE(PG8_SA(0, 0), a2, voffA);
            PG8_WAIT_V(8); PG8_WAIT_L(0); PG8_BAR; PG8_MMA(1, 0, At, B0); PG8_MMA(1, 1, At, B1); PG8_BAR; PG8_SCHED;
            PG8_LDB(B0, 1, 0); PG8_LDB(B1, 1, 1); PG8_SCHED; PG8_LDA(At, 1, 0); PG8_STAGE(PG8_SA(0, 1), a2 + hstep, voffA);
            PG8_WAIT_V(8); PG8_WAIT_L(0); PG8_BAR; PG8_MMA(0, 0, At, B0); PG8_MMA(0, 1, At, B1); PG8_BAR; PG8_SCHED;
            PG8_LDA(At, 1, 1); PG8_STAGE(PG8_SB(1, 0), b3, voffB); PG8_STAGE(PG8_SB(1, 1), b3 + hstep, voffB); PG8_STAGE(PG8_SA(1, 0), a3, voffA);
            PG8_WAIT_V(8); PG8_WAIT_L(0); PG8_BAR; PG8_MMA(1, 0, At, B0); PG8_MMA(1, 1, At, B1); PG8_BAR; PG8_SCHED;
        }
        if constexpr (ALIGN_EPI) { if (wr == 0) PG8_BAR; }
        E(acc, cur, wr, wc, fr, fq);
        if (!has_next) break;
#pragma unroll
        for (int a = 0; a < 2; ++a)
#pragma unroll
            for (int b = 0; b < 2; ++b)
#pragma unroll
                for (int m = 0; m < 4; ++m)
#pragma unroll
                    for (int n = 0; n < 2; ++n) acc[a][b][m][n] = (f32x4){0.f, 0.f, 0.f, 0.f};
        cur = nxt; cA = nA; cB = nB; ++ui;
        if constexpr (ALIGN_EPI) { if (wr == 1) PG8_BAR; }
    }
    PG8_WAIT_V(0);
    if constexpr (!ALIGN_EPI) { if (wr == 0) PG8_BAR; }
    PG8_BAR;
#undef PG8_SA
#undef PG8_SB
#undef PG8_STAGE
#undef PG8_LDA
#undef PG8_LDB
#undef PG8_MMA
#undef PG8_WAIT_V
#undef PG8_WAIT_L
#undef PG8_BAR
#undef PG8_SCHED
}
}

constexpr size_t MiB = 1u << 20;
constexpr size_t WS_CTL = 0;
constexpr size_t WS_SSQ = 4096;
constexpr size_t WS_ROPE = 1 * MiB;
constexpr size_t WS_W = 2 * MiB;
constexpr size_t W_IN = 0, W_OUT = W_IN + (size_t)NIN * DM * 2, W_GU = W_OUT + (size_t)DM * DM * 2, W_D = W_GU + (size_t)2 * FF * DM * 2,
                 W_PP = W_D + (size_t)DM * FF * 2, W_PG = W_PP + (size_t)DM * DPLE * 2, W_LAYER = W_PG + (size_t)DM * DM * 2;
constexpr size_t WS_XB = WS_W + 2 * W_LAYER + MiB;
constexpr size_t ACT_DM = (size_t)MT * DM * 2;
constexpr size_t WS_HB = WS_XB + ACT_DM;
constexpr size_t WS_Z = WS_HB + ACT_DM;
constexpr size_t WS_O = WS_Z + (size_t)MT * NIN * 2;
constexpr size_t WS_ACT = WS_Z;
constexpr size_t WS_PB = WS_O + ACT_DM;
constexpr size_t WS_CKA = WS_PB + (size_t)2 * MT * DPLE * 2;
constexpr size_t CA_BYTES = (size_t)2 * 16 * 512 * 512 * 2, CB_BYTES = (size_t)2 * 16 * 128 * 128 * 2;
constexpr size_t WS_CVA = WS_CKA + CA_BYTES, WS_CKB = WS_CVA + CA_BYTES, WS_CVB = WS_CKB + CB_BYTES, WS_END = WS_CVB + CB_BYTES;
static_assert((size_t)MT * FF * 2 <= (size_t)MT * NIN * 2 + ACT_DM, "ACT overlay fits Z|O");
static_assert(WS_END <= 512 * MiB, "workspace map");

constexpr size_t O_Y = 0, O_AKP = (size_t)MT * DM, O_AVP = O_AKP + 2 * 2 * 512 * 512, O_BKP = O_AVP + 2 * 2 * 512 * 512, O_BVP = O_BKP + 2 * 2 * 128 * 128,
                 O_AKS = O_BVP + 2 * 2 * 128 * 128, O_AVS = O_AKS + (size_t)2 * 16 * 512 * 512, O_BKS = O_AVS + (size_t)2 * 16 * 512 * 512, O_BVS = O_BKS + 2 * 16 * 128 * 128,
                 O_END = O_BVS + 2 * 16 * 128 * 128;

constexpr int LDS_BYTES = 131072 + 4096;
constexpr int W_ITEMS_EARLY = (DM / 64) * (NIN / 32) + (DM / 64) * (DM / 32);
constexpr int NWAVES = 8;

typedef const f32x4 (&AccRef)[2][2][4][2];

struct EpiIn {
    static constexpr bool PERM = true;
    unsigned char* ws_; float* out_; int ssq_off; int l;
    __device__ __forceinline__ void operator()(AccRef acc, const pg8::Unit& u, int wr, int wc, int, int) const {
        GAS unsigned char* wsg_ = (GAS unsigned char*)ws_; GAS float* outg_ = (GAS float*)out_; asm volatile("" : "+s"(wsg_), "+s"(outg_)); unsigned char* ws = (unsigned char*)wsg_; float* out = (float*)outg_;
        const int lane_ = lane_id(); const int fr = lane_ & 15, fq = lane_ >> 4;
        const float* ssq = (const float*)(ws + WS_SSQ) + ssq_off;
        const int pn = u.pn, pm = u.pm;
        const bool samp = pm >= (MP / 256);
        const bool isq = (pn < 2) || (pn == 6) || (pn == 7);
        bf16* Z = (bf16*)(ws + WS_Z); const float* rope = (const float*)(ws + WS_ROPE);
        const bool wrA = (pn >= 2 && pn <= 5) && (samp || (pm & 63) >= 62);
        const bool wrB = (pn == 8) && (samp || (pm & 63) == 63);
        float sq[2][4];
#pragma unroll
        for (int ai = 0; ai < 2; ++ai)
#pragma unroll
            for (int m = 0; m < 4; ++m) sq[ai][m] = ssq[pm * 256 + ai * 128 + wr * 64 + m * 16 + fr];
        asm volatile("" ::: "memory");
#pragma unroll
        for (int ai = 0; ai < 2; ++ai)
#pragma unroll
            for (int m = 0; m < 4; ++m) {
                const int row = pm * 256 + ai * 128 + wr * 64 + m * 16 + fr;
                const float rstd = __builtin_amdgcn_rsqf(sq[ai][m] * (1.0f / DM) + EPS) * (isq ? QSCALE : 1.0f);
                const int pos = samp ? 2048 + ((row - MP) & 63) : (row & 16383);
#pragma unroll
                for (int bj = 0; bj < 2; ++bj) {
                    const int c0 = pn * 256 + bj * 128 + wc * 32 + 8 * fq;
                    float v[8];
#pragma unroll
                    for (int j = 0; j < 4; ++j) { v[j] = acc[ai][bj][m][0][j] * rstd; v[4 + j] = acc[ai][bj][m][1][j] * rstd; }
                    const bool ropet = (pn == 6 || pn == 7 || (pn == 8 && bj == 0)) && ((wc & 1) == 0);
                    if (ropet) {
                        float pv[8];
#pragma unroll
                        for (int j = 0; j < 8; ++j) pv[j] = __shfl_xor(v[j], 16);
                        if (fq < 2) {
                            const f32x4* cs = (const f32x4*)(rope + (size_t)pos * 16);
                            const float sg = (fq == 0) ? -1.f : 1.f;
#pragma unroll
                            for (int jj = 0; jj < 4; ++jj) { const f32x4 t = cs[jj];
                                v[2 * jj] = v[2 * jj] * t[0] + sg * pv[2 * jj] * t[1];
                                v[2 * jj + 1] = v[2 * jj + 1] * t[2] + sg * pv[2 * jj + 1] * t[3]; }
                        }
                    }
                    v4u w; w.x = cvt_pk(v[0], v[1]); w.y = cvt_pk(v[2], v[3]); w.z = cvt_pk(v[4], v[5]); w.w = cvt_pk(v[6], v[7]);
                    *(v4u*)(Z + (size_t)row * NIN + c0) = w;
                    if (wrA) {
                        const int colA = c0 - (pn < 4 ? 512 : 1024);
                        float* dst;
                        if (samp) { const int rs = row - MP; dst = out + (pn < 4 ? O_AKS : O_AVS) + (size_t)l * 16 * 512 * 512 + ((size_t)((rs >> 6) * 512 + 448 + (rs & 63))) * 512 + colA; }
                        else { const int sq = (row & 16383) - 15872; dst = out + (pn < 4 ? O_AKP : O_AVP) + (size_t)l * 2 * 512 * 512 + ((size_t)((row >> 14) * 512 + sq)) * 512 + colA; }
                        *(f32x4*)dst = (f32x4){v[0], v[1], v[2], v[3]}; *(f32x4*)(dst + 4) = (f32x4){v[4], v[5], v[6], v[7]};
                    }
                    if (wrB && (samp || ai == 1)) {
                        const int colB = c0 - (bj == 0 ? 2048 : 2176);
                        float* dst;
                        if (samp) { const int rs = row - MP; dst = out + (bj == 0 ? O_BKS : O_BVS) + (size_t)l * 16 * 128 * 128 + ((size_t)((rs >> 6) * 128 + 64 + (rs & 63))) * 128 + colB; }
                        else { const int sq = (row & 16383) - 16256; dst = out + (bj == 0 ? O_BKP : O_BVP) + (size_t)l * 2 * 128 * 128 + ((size_t)((row >> 14) * 128 + sq)) * 128 + colB; }
                        *(f32x4*)dst = (f32x4){v[0], v[1], v[2], v[3]}; *(f32x4*)(dst + 4) = (f32x4){v[4], v[5], v[6], v[7]};
                    }
                }
            }
    }
};

#define EPI_ENTRY() GAS unsigned char* wsg_ = (GAS unsigned char*)ws_; GAS float* outg_ = (GAS float*)out_; asm volatile("" : "+s"(wsg_), "+s"(outg_)); unsigned char* ws = (unsigned char*)wsg_; float* out = (float*)outg_; const int lane_ = lane_id(); const int fr = lane_ & 15, fq = lane_ >> 4; (void)ws; (void)out

struct EpiRes {
    static constexpr bool PERM = true;
    unsigned char* ws_; float* out_; const float *xp, *xs; int from_xb; int ssq_off;
    __device__ __forceinline__ void operator()(AccRef acc, const pg8::Unit& u, int wr, int wc, int, int) const {
        EPI_ENTRY();
        bf16* HB = (bf16*)(ws + WS_HB); const bf16* RB = (const bf16*)(ws + (from_xb ? WS_XB : WS_HB)); float* ssq = (float*)(ws + WS_SSQ) + ssq_off;
#pragma unroll
        for (int ai = 0; ai < 2; ++ai) {
            f32x4 r0[4][2], r1[4][2];
            if (xp) {
#pragma unroll
                for (int m = 0; m < 4; ++m) { const int row = u.pm * 256 + ai * 128 + wr * 64 + m * 16 + fr;
                    const float* rsrc = (row < MP) ? xp + (size_t)row * DM : xs + (size_t)(row - MP) * DM;
#pragma unroll
                    for (int bj = 0; bj < 2; ++bj) { const int c0 = u.pn * 256 + bj * 128 + wc * 32 + 8 * fq; r0[m][bj] = *(const f32x4*)(rsrc + c0); r1[m][bj] = *(const f32x4*)(rsrc + c0 + 4); } }
            } else {
                v4u pw[4][2];
#pragma unroll
                for (int m = 0; m < 4; ++m) { const int row = u.pm * 256 + ai * 128 + wr * 64 + m * 16 + fr;
#pragma unroll
                    for (int bj = 0; bj < 2; ++bj) pw[m][bj] = *(const v4u*)(RB + (size_t)row * DM + u.pn * 256 + bj * 128 + wc * 32 + 8 * fq); }
#pragma unroll
                for (int m = 0; m < 4; ++m)
#pragma unroll
                    for (int bj = 0; bj < 2; ++bj) { const v4u w = pw[m][bj]; r0[m][bj] = (f32x4){bf_lo(w.x), bf_hi(w.x), bf_lo(w.y), bf_hi(w.y)}; r1[m][bj] = (f32x4){bf_lo(w.z), bf_hi(w.z), bf_lo(w.w), bf_hi(w.w)}; }
            }
            asm volatile("" ::: "memory");
#pragma unroll
            for (int m = 0; m < 4; ++m) {
                const int row = u.pm * 256 + ai * 128 + wr * 64 + m * 16 + fr;
                float ss = 0.f;
#pragma unroll
                for (int bj = 0; bj < 2; ++bj) {
                    const int c0 = u.pn * 256 + bj * 128 + wc * 32 + 8 * fq;
                    const f32x4 o0 = r0[m][bj] + acc[ai][bj][m][0], o1 = r1[m][bj] + acc[ai][bj][m][1];
                    v4u w; w.x = cvt_pk(o0[0], o0[1]); w.y = cvt_pk(o0[2], o0[3]); w.z = cvt_pk(o1[0], o1[1]); w.w = cvt_pk(o1[2], o1[3]);
                    *(v4u*)(HB + (size_t)row * DM + c0) = w;
                    ss += (o0[0] * o0[0] + o0[1] * o0[1]) + (o0[2] * o0[2] + o0[3] * o0[3]) + (o1[0] * o1[0] + o1[1] * o1[1]) + (o1[2] * o1[2] + o1[3] * o1[3]);
                }
                if (ssq_off >= 0) { ss += __shfl_xor(ss, 16); ss += __shfl_xor(ss, 32); if (fq == 0) __hip_atomic_fetch_add(ssq + row, ss, __ATOMIC_RELAXED, __HIP_MEMORY_SCOPE_AGENT); }
            }
        }
    }
};

typedef float f32x2 __attribute__((ext_vector_type(2)));
struct EpiGU {
    static constexpr bool PERM = true;
    unsigned char* ws_; float* out_; int ssq_off;
    __device__ __forceinline__ void operator()(AccRef acc, const pg8::Unit& u, int wr, int wc, int, int) const {
        EPI_ENTRY();
        bf16* ACT = (bf16*)(ws + WS_ACT); const float* ssq = (const float*)(ws + WS_SSQ) + ssq_off;
        float sq[2][4];
#pragma unroll
        for (int ai = 0; ai < 2; ++ai)
#pragma unroll
            for (int m = 0; m < 4; ++m) sq[ai][m] = ssq[u.pm * 256 + ai * 128 + wr * 64 + m * 16 + fr];
        asm volatile("" ::: "memory");
#pragma unroll
        for (int ai = 0; ai < 2; ++ai)
#pragma unroll
            for (int m = 0; m < 4; ++m) {
                const int row = u.pm * 256 + ai * 128 + wr * 64 + m * 16 + fr;
                const float rstd = __builtin_amdgcn_rsqf(sq[ai][m] * (1.0f / DM) + EPS);
                const float rc = -rstd * LOG2E, r2 = rstd * rstd;
                unsigned pk[4];
#pragma unroll
                for (int n = 0; n < 2; ++n)
#pragma unroll
                    for (int h = 0; h < 2; ++h) {
                        const f32x2 g2 = {acc[ai][0][m][n][2 * h], acc[ai][0][m][n][2 * h + 1]}, u2 = {acc[ai][1][m][n][2 * h], acc[ai][1][m][n][2 * h + 1]};
                        const f32x2 x2 = g2 * rc; f32x2 d2; d2.x = fexp2(x2.x); d2.y = fexp2(x2.y); d2 = d2 + 1.0f;
                        f32x2 q2; q2.x = frcp(d2.x); q2.y = frcp(d2.y);
                        const f32x2 t2 = (g2 * u2) * r2 * q2;
                        pk[2 * n + h] = cvt_pk(t2.x, t2.y);
                    }
                v4u w; w.x = pk[0]; w.y = pk[1]; w.z = pk[2]; w.w = pk[3];
                *(v4u*)(ACT + (size_t)row * FF + u.pn * 128 + wc * 32 + 8 * fq) = w;
            }
    }
};

struct EpiPP {
    static constexpr bool PERM = true;
    unsigned char* ws_; float* out_;
    __device__ __forceinline__ void operator()(AccRef acc, const pg8::Unit& u, int wr, int wc, int, int) const {
        EPI_ENTRY();
        bf16* PP = (bf16*)(ws + WS_XB);
#pragma unroll
        for (int ai = 0; ai < 2; ++ai)
#pragma unroll
            for (int m = 0; m < 4; ++m) {
                const int row = u.pm * 256 + ai * 128 + wr * 64 + m * 16 + fr;
#pragma unroll
                for (int bj = 0; bj < 2; ++bj) {
                    const int c0 = u.pn * 256 + bj * 128 + wc * 32 + 8 * fq;
                    const f32x4 o0 = acc[ai][bj][m][0], o1 = acc[ai][bj][m][1];
                    v4u w; w.x = cvt_pk(o0[0], o0[1]); w.y = cvt_pk(o0[2], o0[3]); w.z = cvt_pk(o1[0], o1[1]); w.w = cvt_pk(o1[2], o1[3]);
                    *(v4u*)(PP + (size_t)row * DM + c0) = w;
                }
            }
    }
};

struct EpiPG {
    static constexpr bool PERM = true;
    unsigned char* ws_; float* out_; int ssq_off;
    __device__ __forceinline__ void operator()(AccRef acc, const pg8::Unit& u, int wr, int wc, int, int) const {
        EPI_ENTRY();
        const bf16* HB = (const bf16*)(ws + WS_HB); bf16* XB = (bf16*)(ws + WS_XB); float* ssq = (float*)(ws + WS_SSQ) + ssq_off;
#pragma unroll
        for (int ai = 0; ai < 2; ++ai) {
            v4u hwv[4][2], pwv[4][2];
#pragma unroll
            for (int m = 0; m < 4; ++m) { const int row = u.pm * 256 + ai * 128 + wr * 64 + m * 16 + fr;
#pragma unroll
                for (int bj = 0; bj < 2; ++bj) { const size_t off = (size_t)row * DM + u.pn * 256 + bj * 128 + wc * 32 + 8 * fq; hwv[m][bj] = *(const v4u*)(HB + off); pwv[m][bj] = *(const v4u*)(XB + off); } }
            asm volatile("" ::: "memory");
#pragma unroll
            for (int m = 0; m < 4; ++m) {
                const int row = u.pm * 256 + ai * 128 + wr * 64 + m * 16 + fr;
                float ss = 0.f;
#pragma unroll
                for (int bj = 0; bj < 2; ++bj) {
                    const int c0 = u.pn * 256 + bj * 128 + wc * 32 + 8 * fq;
                    const v4u hw = hwv[m][bj], pw = pwv[m][bj];
                    const float hh[8] = {bf_lo(hw.x), bf_hi(hw.x), bf_lo(hw.y), bf_hi(hw.y), bf_lo(hw.z), bf_hi(hw.z), bf_lo(hw.w), bf_hi(hw.w)};
                    const float pp[8] = {bf_lo(pw.x), bf_hi(pw.x), bf_lo(pw.y), bf_hi(pw.y), bf_lo(pw.z), bf_hi(pw.z), bf_lo(pw.w), bf_hi(pw.w)};
                    float o[8];
#pragma unroll
                    for (int j = 0; j < 4; ++j) {
                        o[j] = hh[j] + pp[j] * frcp(1.0f + fexp2(-acc[ai][bj][m][0][j] * LOG2E));
                        o[4 + j] = hh[4 + j] + pp[4 + j] * frcp(1.0f + fexp2(-acc[ai][bj][m][1][j] * LOG2E));
                    }
                    v4u w; w.x = cvt_pk(o[0], o[1]); w.y = cvt_pk(o[2], o[3]); w.z = cvt_pk(o[4], o[5]); w.w = cvt_pk(o[6], o[7]);
                    *(v4u*)(XB + (size_t)row * DM + c0) = w;
#pragma unroll
                    for (int j = 0; j < 8; ++j) ss += o[j] * o[j];
                }
                ss += __shfl_xor(ss, 16); ss += __shfl_xor(ss, 32);
                if (fq == 0) __hip_atomic_fetch_add(ssq + row, ss, __ATOMIC_RELAXED, __HIP_MEMORY_SCOPE_AGENT);
            }
        }
    }
};

template <bool GU>
__device__ __forceinline__ void transpose_item(const float* W, int K, int N, bf16* WT, const float* gs, LAS float* scr, int item, int lane) {
    const int nblk = N / 32, kb = item / nblk, nb = item % nblk, k0 = 64 * kb, n0 = 32 * nb;
#pragma unroll 16
    for (int i = 0; i < 32; ++i) { const int kk = 2 * i + (lane >> 5); float w = W[(size_t)(k0 + kk) * N + n0 + (lane & 31)]; if (gs) w *= gs[k0 + kk]; scr[kk * 33 + (lane & 31)] = w; }
    asm volatile("s_waitcnt lgkmcnt(0)" ::: "memory");
    int d0 = n0;
    if (GU) { const int f = (n0 < FF) ? n0 : n0 - FF; d0 = 256 * (f >> 7) + (f & 127) + ((n0 < FF) ? 0 : 128); }
    const int c = lane & 7;
#pragma unroll
    for (int j = 0; j < 4; ++j) { const int n = (lane >> 3) + 8 * j; const LAS float* s = scr + (8 * c) * 33 + n;
        v4u o; o.x = cvt_pk(s[0 * 33], s[1 * 33]); o.y = cvt_pk(s[2 * 33], s[3 * 33]); o.z = cvt_pk(s[4 * 33], s[5 * 33]); o.w = cvt_pk(s[6 * 33], s[7 * 33]);
        *(v4u*)(WT + (size_t)(d0 + n) * K + k0 + 8 * c) = o; }
    asm volatile("s_waitcnt lgkmcnt(0)" ::: "memory");
}

__device__ __forceinline__ void convert_flat(const float* src, bf16* dst, size_t n, size_t gtid, size_t gthreads) {
    for (size_t i = gtid * 8; i < n; i += gthreads * 8) {
        const f32x4 a = *(const f32x4*)(src + i), b = *(const f32x4*)(src + i + 4);
        v4u w; w.x = cvt_pk(a[0], a[1]); w.y = cvt_pk(a[2], a[3]); w.z = cvt_pk(b[0], b[1]); w.w = cvt_pk(b[2], b[3]);
        *(v4u*)(dst + i) = w;
    }
}

constexpr float ATT_THR = 6.0f;
constexpr int AL_V = 0, AL_EXT = 65536, AL_RED = AL_EXT + 26624, AL_UNIT = AL_RED + 2048;
struct AttnArgs { const bf16 *Z, *CKA, *CVA, *CKB, *CVB; const float *sinks, *goa, *gob; bf16* O; unsigned* ctr; };

template <bool ISA>
__device__ __forceinline__ void attn_unit(LAS unsigned char* lds, const AttnArgs& T, int sc, int wave, int) {
    const int lane = lane_id();
    const int fr = lane & 15, fq = lane >> 4;
    const bool samp = sc >= 512;
    const int b = samp ? sc - 512 : sc >> 8, c = samp ? 255 : (sc & 255);
    const int row0 = samp ? MP + b * 64 : b * 16384 + c * 64;
    constexpr int NPREV = ISA ? 8 : 2;
    const int kc0 = (NPREV - c) > 0 ? (NPREV - c) : 0;
    const int hd = wave, kv = wave >> 2;
    const int qcol = ISA ? hd * 64 : 1536 + hd * 64;
    LAS unsigned char* vst = lds + AL_V + wave * 8192;
    const LAS float* ext = (const LAS float*)(lds + AL_EXT) + hd * 832;
    LAS float* red = (LAS float*)(lds + AL_RED);

    bf16x8 qf[4][2];
#pragma unroll
    for (int qb = 0; qb < 4; ++qb)
#pragma unroll
        for (int ks = 0; ks < 2; ++ks) qf[qb][ks] = *(const bf16x8*)((const char*)(T.Z + (size_t)(row0 + 16 * qb) * NIN + qcol + 32 * ks) + (unsigned)((fr * NIN + 8 * fq) * 2));
    f32x4 o[4][4];
#pragma unroll
    for (int db = 0; db < 4; ++db)
#pragma unroll
        for (int qb = 0; qb < 4; ++qb) o[db][qb] = (f32x4){0.f, 0.f, 0.f, 0.f};
    const float sink2 = ISA ? 0.f : T.sinks[hd] * LOG2E;
    float mrow[4], lrow[4];
#pragma unroll
    for (int qb = 0; qb < 4; ++qb) { mrow[qb] = ISA ? -1e30f : sink2; lrow[qb] = 0.f; }

#define ATT_TILE_PTRS(KC, KP, VP, PITCH) do { \
        if (samp && (KC) < NPREV) { \
            if (ISA) { const size_t off_ = ((size_t)(b * 512 + (KC) * 64)) * 512 + hd * 64; KP = T.CKA + off_; VP = T.CVA + off_; PITCH = 512; } \
            else { const size_t off_ = ((size_t)(b * 128 + (KC) * 64)) * 128 + kv * 64; KP = T.CKB + off_; VP = T.CVB + off_; PITCH = 128; } \
        } else { \
            const size_t r_ = (size_t)(row0 - (NPREV - (KC)) * 64) * NIN; \
            KP = T.Z + r_ + (ISA ? 512 + hd * 64 : 2048 + kv * 64); VP = T.Z + r_ + (ISA ? 1024 + hd * 64 : 2176 + kv * 64); PITCH = NIN; \
        } } while (0)
#define ATT_LOAD_K(KP, PITCH) do { _Pragma("unroll") for (int kb = 0; kb < 4; ++kb) { \
        const char* kr_ = (const char*)((KP) + (size_t)(16 * kb) * (PITCH)) + (unsigned)((fr * (PITCH) + 8 * fq) * 2); kf[kb][0] = *(const bf16x8*)kr_; kf[kb][1] = *(const bf16x8*)(kr_ + 64); } } while (0)
    bf16x8 kf[4][2];
    { const bf16 *kp0, *vp0; int pitch0; ATT_TILE_PTRS(kc0, kp0, vp0, pitch0); (void)vp0; ATT_LOAD_K(kp0, pitch0); }
    for (int kc = kc0; kc <= NPREV; ++kc) {
        const bf16 *kp, *vp; int pitch;
        ATT_TILE_PTRS(kc, kp, vp, pitch); (void)kp;
        {
            const unsigned voff = (unsigned)(((lane >> 3) * pitch + (((lane & 7) ^ ((lane >> 3) & 6)) * 8)) * 2);
#pragma unroll
            for (int i = 0; i < 8; ++i)
                __builtin_amdgcn_global_load_lds((const unsigned*)((const char*)(vp + (size_t)(8 * i) * pitch) + voff), (LAS unsigned*)(vst + i * 1024), 16, 0, 0);
        }
        bf16x8 pf[4][2];
#pragma unroll
        for (int qh = 0; qh < 2; ++qh) {
            f32x4 s[4][2];
            const LAS float* eb = ext + (768 + 32 * qh + fr - 64 * kc - 4 * fq);
#pragma unroll
            for (int kb = 0; kb < 4; ++kb)
#pragma unroll
                for (int q2 = 0; q2 < 2; ++q2) {
                    f32x4 c0 = (f32x4){0.f, 0.f, 0.f, 0.f};
                    if (ISA) { const LAS float* e = eb + (16 * q2 - 16 * kb); c0 = (f32x4){e[0], e[-1], e[-2], e[-3]}; }
                    f32x4 t = __builtin_amdgcn_mfma_f32_16x16x32_bf16(kf[kb][0], qf[2 * qh + q2][0], c0, 0, 0, 0);
                    s[kb][q2] = __builtin_amdgcn_mfma_f32_16x16x32_bf16(kf[kb][1], qf[2 * qh + q2][1], t, 0, 0, 0);
                }
            if (qh == 1) { const int kn = kc < NPREV ? kc + 1 : kc; const bf16 *kpn, *vpn; int pitchn; ATT_TILE_PTRS(kn, kpn, vpn, pitchn); (void)vpn; ATT_LOAD_K(kpn, pitchn); }
#pragma unroll
            for (int q2 = 0; q2 < 2; ++q2) {
                const int qb = 2 * qh + q2;
                float mx = fmaxf(fmaxf(s[0][q2][0], s[0][q2][1]), s[0][q2][2]);
                mx = fmaxf(fmaxf(mx, s[0][q2][3]), s[1][q2][0]); mx = fmaxf(fmaxf(mx, s[1][q2][1]), s[1][q2][2]); mx = fmaxf(fmaxf(mx, s[1][q2][3]), s[2][q2][0]);
                mx = fmaxf(fmaxf(mx, s[2][q2][1]), s[2][q2][2]); mx = fmaxf(fmaxf(mx, s[2][q2][3]), s[3][q2][0]); mx = fmaxf(fmaxf(mx, s[3][q2][1]), s[3][q2][2]); mx = fmaxf(mx, s[3][q2][3]);
                if (!__all(mx <= mrow[qb] + ATT_THR)) {
                    mx = fmaxf(mx, __shfl_xor(mx, 16)); mx = fmaxf(mx, __shfl_xor(mx, 32));
                    const float mnew = fmaxf(mrow[qb], mx), alpha = fexp2(mrow[qb] - mnew);
                    mrow[qb] = mnew; lrow[qb] = lrow[qb] * alpha;
#pragma unroll
                    for (int db = 0; db < 4; ++db) o[db][qb] = o[db][qb] * alpha;
                }
                const float mcur = mrow[qb];
                float ps = 0.f; float p[4][4];
#pragma unroll
                for (int kb = 0; kb < 4; ++kb)
#pragma unroll
                    for (int j = 0; j < 4; ++j) { p[kb][j] = fexp2(s[kb][q2][j] - mcur); ps += p[kb][j]; }
                lrow[qb] += ps;
#pragma unroll
                for (int kp2 = 0; kp2 < 2; ++kp2) {
                    v4u w; w.x = cvt_pk(p[2 * kp2][0], p[2 * kp2][1]); w.y = cvt_pk(p[2 * kp2][2], p[2 * kp2][3]);
                    w.z = cvt_pk(p[2 * kp2 + 1][0], p[2 * kp2 + 1][1]); w.w = cvt_pk(p[2 * kp2 + 1][2], p[2 * kp2 + 1][3]);
                    pf[qb][kp2] = __builtin_bit_cast(bf16x8, w);
                }
            }
        }
        asm volatile("s_waitcnt vmcnt(8)" ::: "memory");
        __builtin_amdgcn_wave_barrier();
        const int tq = (lane & 15) >> 2, tp = lane & 3;
#pragma unroll
        for (int kp2 = 0; kp2 < 2; ++kp2) {
            bf16x8 vf[4];
#pragma unroll
            for (int db = 0; db < 4; ++db) {
                const int r8 = 4 * (fq & 1) + tq;
                LAS unsigned char* a0 = vst + (4 * kp2 + (fq >> 1)) * 1024 + r8 * 128 + (((2 * db + (tp >> 1)) ^ (r8 & 6)) * 16) + (tp & 1) * 8;
                const s16x4 lo = __builtin_bit_cast(s16x4, __builtin_amdgcn_ds_read_tr16_b64_v4i16((LAS s16x4*)a0));
                const s16x4 hi = __builtin_bit_cast(s16x4, __builtin_amdgcn_ds_read_tr16_b64_v4i16((LAS s16x4*)(a0 + 2048)));
                vf[db] = (bf16x8){lo[0], lo[1], lo[2], lo[3], hi[0], hi[1], hi[2], hi[3]};
            }
#pragma unroll
            for (int qb = 0; qb < 4; ++qb)
#pragma unroll
                for (int db = 0; db < 4; ++db) o[db][qb] = __builtin_amdgcn_mfma_f32_16x16x32_bf16(vf[db], pf[qb][kp2], o[db][qb], 0, 0, 0);
        }
        asm volatile("" ::: "memory");
    }
#pragma unroll
    for (int qb = 0; qb < 4; ++qb) {
        float lt = lrow[qb]; lt += __shfl_xor(lt, 16); lt += __shfl_xor(lt, 32);
        if (!ISA) lt += fexp2(sink2 - mrow[qb]);
        const float inv = 1.0f / lt; float ss = 0.f;
#pragma unroll
        for (int db = 0; db < 4; ++db) { o[db][qb] = o[db][qb] * inv;
#pragma unroll
            for (int j = 0; j < 4; ++j) ss += o[db][qb][j] * o[db][qb][j]; }
        ss += __shfl_xor(ss, 16); ss += __shfl_xor(ss, 32);
        if (fq == 0) red[wave * 64 + 16 * qb + fr] = ss;
    }
    __syncthreads();
    const float* gout = (ISA ? T.goa : T.gob) + hd * 64 + 4 * (lane_id() >> 4);
    f32x4 gv[4];
#pragma unroll
    for (int db = 0; db < 4; ++db) gv[db] = *(const f32x4*)(gout + 16 * db);
#pragma unroll
    for (int qb = 0; qb < 4; ++qb) {
        float tot = 0.f;
#pragma unroll
        for (int w = 0; w < 8; ++w) tot += red[w * 64 + 16 * qb + fr];
        const float rstd = __builtin_amdgcn_rsqf(tot * (1.0f / 512.0f) + EPS);
        char* orow = (char*)(T.O + (size_t)(row0 + 16 * qb) * DM + (ISA ? 0 : 512) + hd * 64) + (unsigned)((fr * DM + 4 * fq) * 2);
#pragma unroll
        for (int db = 0; db < 4; ++db) { const f32x4 v = o[db][qb] * rstd * gv[db];
            v2u w; w.x = cvt_pk(v[0], v[1]); w.y = cvt_pk(v[2], v[3]); *(v2u*)(orow + 32 * db) = w; }
    }
}

__device__ __forceinline__ void attn_phase(LAS unsigned char* lds, const AttnArgs& T, const float* relb, const int wave) {
    const int lane = lane_id(), tid = wave * 64 + lane;
    LAS float* ext = (LAS float*)(lds + AL_EXT);
    for (int i = tid; i < 8 * 832; i += NWAVES * 64) { const int h = i / 832, k = i % 832; ext[i] = relb[h * 513 + (k < 512 ? k : 512)] * LOG2E; }
    volatile LAS unsigned* uw = (volatile LAS unsigned*)(lds + AL_UNIT);
    int qcur = (int)(blockIdx.x & 7u), qleft = 8;
    for (;;) {
        __syncthreads();
        if (tid == 0) {
            unsigned code = 0xffffffffu;
            while (qleft > 0) {
                const unsigned j = __hip_atomic_fetch_add(T.ctr + 16 * qcur, 1u, __ATOMIC_RELAXED, __HIP_MEMORY_SCOPE_AGENT);
                if (j < 132u) { code = (unsigned)qcur * 132u + j; break; }
                qcur = (qcur + 1) & 7; --qleft;
            }
            uw[0] = code;
        }
        __syncthreads();
        const unsigned u = (unsigned)__builtin_amdgcn_readfirstlane((int)uw[0]);
        if (u == 0xffffffffu) break;
        const int qq = (int)(u / 132u), j = (int)(u % 132u);
        if (j < 66) attn_unit<true>(lds, T, qq * 66 + j, wave, lane); else attn_unit<false>(lds, T, qq * 66 + j - 66, wave, lane);
    }
    __syncthreads();
}

struct Args { const float* in[21]; float* out; unsigned char* ws; };

constexpr size_t WS_SMALL = 768 * 1024, WS_BAR = 2048;
constexpr int SM_RELB = 0, SM_SINK = 8448, SM_GOA = 8512, SM_GOB = 9536, SM_GFIN = 10560, SM_END = 11584;
static_assert(WS_SSQ + (size_t)5 * MT * 4 <= WS_SMALL && WS_SMALL + SM_END * 4 <= WS_ROPE, "control region map");

__device__ __forceinline__ void grid_bar(unsigned* bar, unsigned k, unsigned G, unsigned bid, bool leader) {
    asm volatile("s_waitcnt vmcnt(0) lgkmcnt(0)" ::: "memory");
    __syncthreads();
    if (leader) {
        const unsigned g = bid & 7u, gsz = (G - g + 7u) >> 3, ng = G < 8u ? G : 8u;
        unsigned* gcnt = bar + 16 * (1 + g); unsigned* ggen = bar + 16 * (9 + g); unsigned* top = bar + 16 * 17;
        __builtin_amdgcn_fence(__ATOMIC_RELEASE, "agent");
        asm volatile("s_waitcnt vmcnt(0)" ::: "memory");
        const unsigned old = __hip_atomic_fetch_add(gcnt, 1u, __ATOMIC_RELAXED, __HIP_MEMORY_SCOPE_AGENT);
        if (old + 1u == k * gsz) {
            __hip_atomic_fetch_add(top, 1u, __ATOMIC_RELAXED, __HIP_MEMORY_SCOPE_AGENT);
            while (__hip_atomic_load(top, __ATOMIC_RELAXED, __HIP_MEMORY_SCOPE_AGENT) < k * ng) __builtin_amdgcn_s_sleep(1);
            __hip_atomic_fetch_add(ggen, 1u, __ATOMIC_RELAXED, __HIP_MEMORY_SCOPE_AGENT);
        } else {
            while (__hip_atomic_load(ggen, __ATOMIC_RELAXED, __HIP_MEMORY_SCOPE_AGENT) < k) __builtin_amdgcn_s_sleep(1);
        }
        __builtin_amdgcn_fence(__ATOMIC_ACQUIRE, "agent");
        asm volatile("s_waitcnt vmcnt(0)" ::: "memory");
    }
    __syncthreads();
}

struct PIn { const float *w_in, *w_out, *w_gu, *w_d, *w_pp, *w_pg, *g_mix, *g_ffn, *p_p, *p_s, *cak, *cav, *cbk, *cbv; };

__device__ __forceinline__ void conv_weights(LAS unsigned char* lds, unsigned char* ws, const PIn& I, const int l, const int wave, const int lane, const int gw, const int NGW, const int r_lo, const int r_hi) {
    LAS float* scr = (LAS float*)(lds + wave * 8448);
    constexpr int I_IN = (DM / 64) * (NIN / 32), I_OUT = (DM / 64) * (DM / 32), I_GU = (DM / 64) * (2 * FF / 32), I_D = (FF / 64) * (DM / 32), I_PP = (DPLE / 64) * (DM / 32), I_PG = I_OUT;
    constexpr int I_LAYER = I_IN + I_OUT + I_GU + I_D + I_PP + I_PG;
    unsigned char* wb = ws + WS_W + (size_t)l * W_LAYER;
    for (int it = r_lo + gw; it < (r_hi < I_LAYER ? r_hi : I_LAYER); it += NGW) {
        int r = it;
        if (r < I_IN) { transpose_item<false>(I.w_in + (size_t)l * DM * NIN, DM, NIN, (bf16*)(wb + W_IN), I.g_mix + l * DM, scr, r, lane); continue; } r -= I_IN;
        if (r < I_OUT) { transpose_item<false>(I.w_out + (size_t)l * DM * DM, DM, DM, (bf16*)(wb + W_OUT), nullptr, scr, r, lane); continue; } r -= I_OUT;
        if (r < I_GU) { transpose_item<true>(I.w_gu + (size_t)l * DM * 2 * FF, DM, 2 * FF, (bf16*)(wb + W_GU), I.g_ffn + l * DM, scr, r, lane); continue; } r -= I_GU;
        if (r < I_D) { transpose_item<false>(I.w_d + (size_t)l * FF * DM, FF, DM, (bf16*)(wb + W_D), nullptr, scr, r, lane); continue; } r -= I_D;
        if (r < I_PP) { transpose_item<false>(I.w_pp + (size_t)l * DPLE * DM, DPLE, DM, (bf16*)(wb + W_PP), nullptr, scr, r, lane); continue; } r -= I_PP;
        transpose_item<false>(I.w_pg + (size_t)l * DM * DM, DM, DM, (bf16*)(wb + W_PG), nullptr, scr, r, lane);
    }
}
__device__ __forceinline__ void conv_p_caches(unsigned char* ws, float* out, const PIn& I, const int l, const size_t gtid, const size_t gth, const int part = 3) {
    bf16* PB = (bf16*)(ws + WS_PB);
    if (part & 1) {
    convert_flat(I.p_p + (size_t)l * MP * DPLE, PB + (size_t)l * MT * DPLE, (size_t)MP * DPLE, gtid, gth);
    convert_flat(I.p_s + (size_t)l * MS * DPLE, PB + (size_t)l * MT * DPLE + (size_t)MP * DPLE, (size_t)MS * DPLE, gtid, gth);
    }
    if (!(part & 2)) return;
    constexpr size_t NA = (size_t)16 * 512 * 512, NB = (size_t)16 * 128 * 128;
    for (size_t i = gtid * 8; i < NA; i += gth * 8) {
        const size_t gi = (size_t)l * NA + i;
        const f32x4 a = *(const f32x4*)(I.cak + gi), b = *(const f32x4*)(I.cak + gi + 4), c = *(const f32x4*)(I.cav + gi), d = *(const f32x4*)(I.cav + gi + 4);
        v4u w; w.x = cvt_pk(a[0], a[1]); w.y = cvt_pk(a[2], a[3]); w.z = cvt_pk(b[0], b[1]); w.w = cvt_pk(b[2], b[3]);
        *(v4u*)((bf16*)(ws + WS_CKA) + gi) = w;
        w.x = cvt_pk(c[0], c[1]); w.y = cvt_pk(c[2], c[3]); w.z = cvt_pk(d[0], d[1]); w.w = cvt_pk(d[2], d[3]);
        *(v4u*)((bf16*)(ws + WS_CVA) + gi) = w;
        if (((i >> 9) & 511) >= 64) { float* dk = out + O_AKS + gi - 32768; float* dv = out + O_AVS + gi - 32768;
            *(f32x4*)dk = a; *(f32x4*)(dk + 4) = b; *(f32x4*)dv = c; *(f32x4*)(dv + 4) = d; }
    }
    for (size_t i = gtid * 8; i < NB; i += gth * 8) {
        const size_t gi = (size_t)l * NB + i;
        const f32x4 a = *(const f32x4*)(I.cbk + gi), b = *(const f32x4*)(I.cbk + gi + 4), c = *(const f32x4*)(I.cbv + gi), d = *(const f32x4*)(I.cbv + gi + 4);
        v4u w; w.x = cvt_pk(a[0], a[1]); w.y = cvt_pk(a[2], a[3]); w.z = cvt_pk(b[0], b[1]); w.w = cvt_pk(b[2], b[3]);
        *(v4u*)((bf16*)(ws + WS_CKB) + gi) = w;
        w.x = cvt_pk(c[0], c[1]); w.y = cvt_pk(c[2], c[3]); w.z = cvt_pk(d[0], d[1]); w.w = cvt_pk(d[2], d[3]);
        *(v4u*)((bf16*)(ws + WS_CVB) + gi) = w;
        if (((i >> 7) & 127) >= 64) { float* dk = out + O_BKS + gi - 8192; float* dv = out + O_BVS + gi - 8192;
            *(f32x4*)dk = a; *(f32x4*)(dk + 4) = b; *(f32x4*)dv = c; *(f32x4*)(dv + 4) = d; }
    }
}

template <int l>
__device__ __forceinline__ void run_layer(LAS unsigned char* lds, unsigned char* ws_in, float* out_in, const float* x_p, const float* x_s, const PIn* pin, const int G, const int bid, const int wave) {
    GAS unsigned char* wsg_ = (GAS unsigned char*)ws_in; GAS float* outg_ = (GAS float*)out_in; asm volatile("" : "+s"(wsg_), "+s"(outg_));
    unsigned char* ws = (unsigned char*)wsg_; float* out = (float*)outg_;
    unsigned* const bar = (unsigned*)(ws + WS_BAR);
#define GRID_BAR(k) grid_bar(bar, (unsigned)((k) + 1), (unsigned)G, (unsigned)bid, wave == 0 && lane_id() == 0)
        unsigned char* wb = ws + WS_W + (size_t)l * W_LAYER;
        bf16 *XB = (bf16*)(ws + WS_XB), *HB = (bf16*)(ws + WS_HB), *O = (bf16*)(ws + WS_O), *ACT = (bf16*)(ws + WS_ACT);
        {
            pg8::RowOrder<NIN / 256> S; S.init(G, bid);
            EpiIn E{ws, out, (l == 0) ? 0 : 2 * MT, l};
            pg8::gemm_phase<DM, EpiIn, pg8::RowOrder<NIN / 256>>(lds, XB, (const bf16*)(wb + W_IN), S, E, wave);
            if (l == 0) {
                const int nbusy = (MT / 256 * (NIN / 256)) % G;
                if (S.v >= nbusy) { const int lane = lane_id(); const PIn I = *pin;
                    conv_p_caches(ws, out, I, 0, (size_t)(S.v - nbusy) * (NWAVES * 64) + wave * 64 + lane, (size_t)(G - nbusy) * (NWAVES * 64)); }
            }
        }
        GRID_BAR(6 * l + 1);
        {
            const float* sm = (const float*)(ws + WS_SMALL);
            AttnArgs T{(const bf16*)(ws + WS_Z), (const bf16*)(ws + WS_CKA) + (size_t)l * 16 * 512 * 512, (const bf16*)(ws + WS_CVA) + (size_t)l * 16 * 512 * 512,
                       (const bf16*)(ws + WS_CKB) + (size_t)l * 16 * 128 * 128, (const bf16*)(ws + WS_CVB) + (size_t)l * 16 * 128 * 128,
                       sm + SM_SINK + l * 8, sm + SM_GOA + l * 512, sm + SM_GOB + l * 512, O, (unsigned*)(ws + WS_CTL) + 128 * l};
            attn_phase(lds, T, sm + SM_RELB + (size_t)l * 8 * 513, wave);
        }
        GRID_BAR(6 * l + 2);
        {
            pg8::RowOrder<DM / 256> S; S.init(G, bid);
            EpiRes E{ws, out, (l == 0) ? x_p : nullptr, x_s, 1, (1 + 2 * l) * MT};
            pg8::gemm_phase<DM, EpiRes, pg8::RowOrder<DM / 256>>(lds, O, (const bf16*)(wb + W_OUT), S, E, wave);
            if (l == 0) {
                const int nbusy = (MT / 256 * 4) % G;
                if (S.v >= nbusy) { const int lane = lane_id(); const PIn I = *pin; __syncthreads();
                    conv_weights(lds, ws, I, 0, wave, lane, (S.v - nbusy) * NWAVES + wave, (G - nbusy) * NWAVES, W_ITEMS_EARLY, 1 << 30); }
            }
        }
        GRID_BAR(6 * l + 3);
        {
            pg8::RowOrder<2 * FF / 256> S; S.init(G, bid);
            EpiGU E{ws, out, (1 + 2 * l) * MT};
            pg8::gemm_phase<DM, EpiGU, pg8::RowOrder<2 * FF / 256>>(lds, HB, (const bf16*)(wb + W_GU), S, E, wave);
            if (l == 0) {
                const int nbusy = (MT / 256 * (2 * FF / 256)) % G;
                if (S.v >= nbusy) { const int lane = lane_id(); const PIn I = *pin;
                    conv_p_caches(ws, out, I, 1, (size_t)(S.v - nbusy) * (NWAVES * 64) + wave * 64 + lane, (size_t)(G - nbusy) * (NWAVES * 64), 1); }
            }
        }
        GRID_BAR(6 * l + 4);
        {
            pg8::RowOrder<DM / 256> S; S.init(G, bid);
            EpiRes E{ws, out, nullptr, nullptr, 0, -1};
            pg8::gemm_phase<FF, EpiRes, pg8::RowOrder<DM / 256>>(lds, ACT, (const bf16*)(wb + W_D), S, E, wave);
            pg8::RowOrder<DM / 256> S2; S2.init(G, G - 1 - bid);
            EpiPP E2{ws, out};
            pg8::gemm_phase<DPLE, EpiPP, pg8::RowOrder<DM / 256>>(lds, (const bf16*)(ws + WS_PB) + (size_t)l * MT * DPLE, (const bf16*)(wb + W_PP), S2, E2, wave);
            if (l == 0) {
                const int nbusy = (MT / 256 * 4) % G;
                if (S.v >= nbusy) { const int lane = lane_id(); const PIn I = *pin; __syncthreads();
                    conv_weights(lds, ws, I, 1, wave, lane, (S.v - nbusy) * NWAVES + wave, (G - nbusy) * NWAVES, 0, 1 << 30); }
            }
        }
        GRID_BAR(6 * l + 5);
        {
            pg8::RowOrder<DM / 256> S; S.init(G, bid);
            EpiPG E{ws, out, (2 + 2 * l) * MT};
            pg8::gemm_phase<DM, EpiPG, pg8::RowOrder<DM / 256>>(lds, HB, (const bf16*)(wb + W_PG), S, E, wave);
            if (l == 0) {
                const int nbusy = (MT / 256 * 4) % G;
                if (S.v >= nbusy) { const int lane = lane_id(); const PIn I = *pin;
                    conv_p_caches(ws, out, I, 1, (size_t)(S.v - nbusy) * (NWAVES * 64) + wave * 64 + lane, (size_t)(G - nbusy) * (NWAVES * 64), 2); }
            }
        }
        GRID_BAR(6 * l + 6);
    }
#undef GRID_BAR

__global__ void __launch_bounds__(NWAVES * 64, 2) mega_fwd(Args args) {
    extern __shared__ __attribute__((aligned(16))) unsigned char lds_raw[];
    LAS unsigned char* lds = (LAS unsigned char*)lds_raw;
    const int wave = __builtin_amdgcn_readfirstlane((int)threadIdx.x >> 6);
    const int G = gridDim.x, bid = blockIdx.x;
    unsigned char* const ws = args.ws;
    float* const out = args.out;
    float* const H = out + O_Y;

    if (args.ws == nullptr) cg::this_grid().sync();
    {
        const float *x_p = args.in[0], *x_s = args.in[1], *p_p = args.in[2], *p_s = args.in[3], *cak = args.in[4], *cav = args.in[5], *cbk = args.in[6], *cbv = args.in[7],
                    *g_mix = args.in[8], *w_in = args.in[9], *relb = args.in[10], *sinks = args.in[11], *goa = args.in[12], *gob = args.in[13], *w_out = args.in[14],
                    *g_ffn = args.in[15], *w_gu = args.in[16], *w_d = args.in[17], *w_pp = args.in[18], *w_pg = args.in[19], *g_fin = args.in[20];
        float* ssqb = (float*)(ws + WS_SSQ);
        float* rope = (float*)(ws + WS_ROPE);
        float* sm = (float*)(ws + WS_SMALL);
        bf16 *XB = (bf16*)(ws + WS_XB), *PB = (bf16*)(ws + WS_PB);
        const int lane = lane_id(), tid = wave * 64 + lane;
        const int gw = bid * NWAVES + wave, NGW = G * NWAVES;
        const size_t gtid = (size_t)bid * (NWAVES * 64) + tid, gth = (size_t)G * (NWAVES * 64);
        const PIn I{w_in, w_out, w_gu, w_d, w_pp, w_pg, g_mix, g_ffn, p_p, p_s, cak, cav, cbk, cbv};
        conv_weights(lds, ws, I, 0, wave, lane, gw, NGW, 0, W_ITEMS_EARLY);
        for (int m0 = gw; m0 < MT; m0 += 2 * NGW) {
            const int m1 = m0 + NGW; const bool has1 = m1 < MT;
            const float* xr0 = (m0 < MP) ? x_p + (size_t)m0 * DM : x_s + (size_t)(m0 - MP) * DM;
            const float* xr1 = has1 ? ((m1 < MP) ? x_p + (size_t)m1 * DM : x_s + (size_t)(m1 - MP) * DM) : xr0;
            f32x4 a[2][4];
#pragma unroll
            for (int j = 0; j < 2; ++j) { a[0][2 * j] = *(const f32x4*)(xr0 + j * 512 + lane * 8); a[0][2 * j + 1] = *(const f32x4*)(xr0 + j * 512 + lane * 8 + 4);
                                          a[1][2 * j] = *(const f32x4*)(xr1 + j * 512 + lane * 8); a[1][2 * j + 1] = *(const f32x4*)(xr1 + j * 512 + lane * 8 + 4); }
#pragma unroll
            for (int r = 0; r < 2; ++r) {
                const int m = r ? m1 : m0; float ss = 0.f;
#pragma unroll
                for (int j = 0; j < 2; ++j) { const f32x4 p = a[r][2 * j], q = a[r][2 * j + 1];
                    ss += (p[0] * p[0] + p[1] * p[1]) + (p[2] * p[2] + p[3] * p[3]) + (q[0] * q[0] + q[1] * q[1]) + (q[2] * q[2] + q[3] * q[3]);
                    v4u w; w.x = cvt_pk(p[0], p[1]); w.y = cvt_pk(p[2], p[3]); w.z = cvt_pk(q[0], q[1]); w.w = cvt_pk(q[2], q[3]);
                    if (r == 0 || has1) *(v4u*)(XB + (size_t)m * DM + j * 512 + lane * 8) = w; }
#pragma unroll
                for (int o = 1; o < 64; o <<= 1) ss += __shfl_xor(ss, o);
                if (lane == 0 && (r == 0 || has1)) ssqb[m] = ss;
            }
        }
        for (size_t i = gtid; i < (size_t)16384 * 8; i += gth) {
            const int pos = (int)(i >> 3), j = (int)(i & 7);
            const double rv = (j == 0) ? 0.15915494309189535 : (j == 1) ? 0.03086376340470123 : (j == 2) ? 0.005985185712713705 : (j == 3) ? 0.001160663641240061 :
                              (j == 4) ? 0.00022507907903927653 : (j == 5) ? 4.364795279280289e-05 : (j == 6) ? 8.464330808241401e-06 : 1.6414262627950345e-06;
            const double t = (double)pos * rv; const float fr_ = (float)(t - __builtin_floor(t));
            rope[2 * i] = __builtin_amdgcn_cosf(fr_); rope[2 * i + 1] = __builtin_amdgcn_sinf(fr_);
        }
        for (size_t i = gtid; i < (size_t)SM_END; i += gth) {
            float v = 0.f; const int k = (int)i;
            if (k < 2 * 8 * 513) v = relb[k];
            else if (k >= SM_SINK && k < SM_SINK + 16) v = sinks[k - SM_SINK];
            else if (k >= SM_GOA && k < SM_GOB) v = goa[k - SM_GOA];
            else if (k >= SM_GOB && k < SM_GFIN) v = gob[k - SM_GOB];
            else if (k >= SM_GFIN) v = g_fin[k - SM_GFIN];
            sm[k] = v;
        }
        for (size_t i = gtid; i < (size_t)4 * MT; i += gth) ssqb[MT + i] = 0.f;
        if (gtid < 256) ((unsigned*)(ws + WS_CTL))[gtid] = 0u;
    }
    grid_bar((unsigned*)(ws + WS_BAR), 1u, (unsigned)G, (unsigned)bid, wave == 0 && lane_id() == 0);

    const float* const x_p = args.in[0]; const float* const x_s = args.in[1];
    const PIn pin{args.in[9], args.in[14], args.in[16], args.in[17], args.in[18], args.in[19], args.in[8], args.in[15], args.in[2], args.in[3], args.in[4], args.in[5], args.in[6], args.in[7]};
    run_layer<0>(lds, ws, out, x_p, x_s, &pin, G, bid, wave);
    run_layer<1>(lds, ws, out, x_p, x_s, &pin, G, bid, wave);
    {
        const int lane = lane_id();
        const int gw = bid * NWAVES + wave, NGW = G * NWAVES;
        const float* ssq = (const float*)(ws + WS_SSQ) + 4 * (size_t)MT;
        const float* g_fin = (const float*)(ws + WS_SMALL) + SM_GFIN;
        const bf16* XB = (const bf16*)(ws + WS_XB);
        f32x4 gf[2][2];
#pragma unroll
        for (int j = 0; j < 2; ++j) { gf[j][0] = *(const f32x4*)(g_fin + j * 512 + lane * 8); gf[j][1] = *(const f32x4*)(g_fin + j * 512 + lane * 8 + 4); }
        for (int m = gw; m < MT; m += NGW) {
            const float rstd = __builtin_amdgcn_rsqf(ssq[m] * (1.0f / DM) + EPS);
            float* yr = H + (size_t)m * DM;
#pragma unroll
            for (int j = 0; j < 2; ++j) {
                const v4u w = *(const v4u*)(XB + (size_t)m * DM + j * 512 + lane * 8);
                const f32x4 a = (f32x4){bf_lo(w.x), bf_hi(w.x), bf_lo(w.y), bf_hi(w.y)}, b2 = (f32x4){bf_lo(w.z), bf_hi(w.z), bf_lo(w.w), bf_hi(w.w)};
                *(f32x4*)(yr + j * 512 + lane * 8) = a * rstd * gf[j][0]; *(f32x4*)(yr + j * 512 + lane * 8 + 4) = b2 * rstd * gf[j][1];
            }
        }
    }
}

extern "C" void kernel_launch(void* const* d_in, const int* in_sizes, int n_in, void* d_out, int out_size, void* d_ws, size_t ws_size, hipStream_t stream) {
    static int grid = 0;
    if (grid == 0) {
        if (n_in != 21 || (size_t)out_size != O_END || ws_size < WS_END) { fprintf(stderr, "kernel_launch: unexpected problem: n_in %d out %d ws %zu (need out %zu ws %zu)\n", n_in, out_size, ws_size, (size_t)O_END, (size_t)WS_END); grid = -1; return; }
        int dev = 0, cus = 0, per_cu = 0;
        (void)hipGetDevice(&dev);
        (void)hipDeviceGetAttribute(&cus, hipDeviceAttributeMultiprocessorCount, dev);
        if (hipFuncSetAttribute((const void*)mega_fwd, hipFuncAttributeMaxDynamicSharedMemorySize, LDS_BYTES) != hipSuccess) { fprintf(stderr, "kernel_launch: hipFuncSetAttribute failed\n"); grid = -1; return; }
        if (hipOccupancyMaxActiveBlocksPerMultiprocessor(&per_cu, (const void*)mega_fwd, NWAVES * 64, LDS_BYTES) != hipSuccess || per_cu < 1) { fprintf(stderr, "kernel_launch: occupancy query says %d blocks per CU\n", per_cu); (void)hipGetLastError(); per_cu = 1; }
        grid = cus * 1;
        if (grid <= 0) { grid = -1; return; }
    }
    if (grid < 0) return;
    (void)hipMemsetAsync((unsigned char*)d_ws + WS_BAR, 0, 2048, stream);
    Args a{};
    for (int i = 0; i < 21; ++i) a.in[i] = (const float*)d_in[i];
    a.out = (float*)d_out; a.ws = (unsigned char*)d_ws;
    void* kargs[] = {&a};
    hipError_t e = hipLaunchCooperativeKernel((const void*)mega_fwd, dim3(grid), dim3(NWAVES * 64), kargs, LDS_BYTES, stream);
    if (e != hipSuccess) fprintf(stderr, "kernel_launch: cooperative launch failed: %s (grid %d)\n", hipGetErrorString(e), grid);
}
```

```cpp
#include <hip/hip_runtime.h>
#include <hip/hip_cooperative_groups.h>
#include <cstdio>
#include <cstdint>
namespace cg = cooperative_groups;

#define GAS __attribute__((address_space(1)))
#define LAS __attribute__((address_space(3)))
typedef unsigned short bf16;
typedef unsigned v4u __attribute__((ext_vector_type(4)));
typedef unsigned v2u __attribute__((ext_vector_type(2)));
typedef float f32x4 __attribute__((ext_vector_type(4)));
typedef short bf16x8 __attribute__((ext_vector_type(8)));
typedef short s16x4 __attribute__((ext_vector_type(4)));

constexpr int MP = 32768, MS = 1024, MT = MP + MS;
constexpr int DM = 1024, NIN = 2304, FF = 2816, DPLE = 256;
constexpr float EPS = 1e-6f;
constexpr float LOG2E = 1.4426950408889634f;
constexpr float QSCALE = 0.125f * LOG2E;

__device__ __forceinline__ unsigned cvt_pk(float lo, float hi) { unsigned r; asm("v_cvt_pk_bf16_f32 %0, %1, %2" : "=v"(r) : "v"(lo), "v"(hi)); return r; }
__device__ __forceinline__ float bf_lo(unsigned w) { return __builtin_bit_cast(float, w << 16); }
__device__ __forceinline__ float bf_hi(unsigned w) { return __builtin_bit_cast(float, w & 0xffff0000u); }
__device__ __forceinline__ float fexp2(float x) { return __builtin_amdgcn_exp2f(x); }
__device__ __forceinline__ float frcp(float x) { return __builtin_amdgcn_rcpf(x); }

__device__ __forceinline__ int lane_id() { int l = __builtin_amdgcn_mbcnt_hi(~0u, __builtin_amdgcn_mbcnt_lo(~0u, 0u)); asm volatile("" : "+v"(l)); return l; }

namespace pg8 {
constexpr int BM = 256, BK = 64, HALF = 128, HTB = HALF * BK * 2, STAGE_BYTES = 8 * HTB, NXCD = 8, WGM = 8;
__host__ __device__ __forceinline__ int lds_byte(int r, int c) { const int st = (r >> 4) * 2 + (c >> 5), rr = r & 15, cc = c & 31, ob = rr * 64 + cc * 2; return st * 1024 + (ob ^ (((ob >> 9) & 1) << 5)); }
__host__ __device__ __forceinline__ void stage_rc(int b, int& R, int& C) { const int st = b / 1024, sb = b % 1024, swz = sb ^ (((sb >> 9) & 1) << 5); R = (st >> 1) * 16 + swz / 64; C = (st & 1) * 32 + (swz % 64) / 2; }
__host__ __device__ __forceinline__ int perm32(int rho) { const int n = rho >> 4, i = rho & 15; return 8 * (i >> 2) + 4 * n + (i & 3); }

struct Unit { int pm, pn; };
struct Gemm { const bf16* A; const bf16* Bt; int M, N, K; };

template <int NN>
struct RowOrder {
    int G, v;
    __device__ __forceinline__ void init(int G_, int c) { G = G_; v = (G_ % 8 == 0) ? (c % 8) * (G_ / 8) + c / 8 : c; }
    __device__ __forceinline__ bool next(int i, Unit& u) const {
        const int L = i * G + v; if (L >= (33792 / BM) * NN) return false;
        constexpr int NM = 33792 / BM, NFULL = (NM / 8) * 8 * NN;
        if (L < NFULL) { const int g = L / (8 * NN), idx = L % (8 * NN); u.pm = g * 8 + (idx & 7); u.pn = idx >> 3; }
        else { constexpr int GS = NM % 8 ? NM % 8 : 8; const int idx = L - NFULL; u.pm = (NM / 8) * 8 + idx % GS; u.pn = idx / GS; }
        return true;
    }
};

template <int KK, class Epi, class Sched, bool ALIGN_EPI = true>
__device__ __forceinline__ void gemm_phase(LAS unsigned char* lds, const bf16* gA, const bf16* gBt, const Sched& S, const Epi& E, const int wid) {
    const int lane = lane_id();
    const int tid = wid * 64 + lane, wr = wid >> 2, wc = wid & 3, fr = lane & 15, fq = lane >> 4;
    constexpr int K = KK, nt = K / BK;
    unsigned voffA[2], voffB[2];
#pragma unroll
    for (int i = 0; i < 2; ++i) { int R, C; stage_rc(tid * 16 + i * 8192, R, C); const int Rb = Epi::PERM ? ((R & ~31) + perm32(R & 31)) : R;
        voffA[i] = (unsigned)(R * K + C) * 2u; voffB[i] = (unsigned)(Rb * K + C) * 2u; }
    const size_t kstep = (size_t)(BK * 2);
    const size_t hstep = (size_t)HALF * K * 2;
    const size_t tstep = 2 * hstep;
    const unsigned ldsw = (unsigned)wid * 1024u;
    const int aoff = lds_byte(wr * 64 + fr, fq * 8), boff = lds_byte(wc * 32 + fr, fq * 8);
#define PG8_SA(b, h) (((b) * 2 + (h)) * HTB)
#define PG8_SB(b, h) ((4 + (b) * 2 + (h)) * HTB)
#define PG8_STAGE(bufoff, gbase, voff) do { _Pragma("unroll") for (int _i = 0; _i < 2; ++_i) \
        __builtin_amdgcn_global_load_lds((const unsigned*)((const char*)(gbase) + (voff)[_i]), (LAS unsigned*)(lds + (bufoff) + ldsw + _i * 8192), 16, 0, 0); } while (0)
#define PG8_LDA(dst, b, h) do { _Pragma("unroll") for (int m = 0; m < 4; ++m) _Pragma("unroll") for (int k = 0; k < 2; ++k) dst[m][k] = *(const LAS bf16x8*)(lds + PG8_SA(b, h) + aoff + m * 2048 + k * 1024); } while (0)
#define PG8_LDB(dst, b, h) do { _Pragma("unroll") for (int n = 0; n < 2; ++n) _Pragma("unroll") for (int k = 0; k < 2; ++k) dst[n][k] = *(const LAS bf16x8*)(lds + PG8_SB(b, h) + boff + n * 2048 + k * 1024); } while (0)
#define PG8_MMA(ai, bj, At, Bt) do { __builtin_amdgcn_s_setprio(1); _Pragma("unroll") for (int m = 0; m < 4; ++m) _Pragma("unroll") for (int n = 0; n < 2; ++n) _Pragma("unroll") for (int k = 0; k < 2; ++k) \
        acc[ai][bj][m][n] = __builtin_amdgcn_mfma_f32_16x16x32_bf16(Bt[n][k], At[m][k], acc[ai][bj][m][n], 0, 0, 0); __builtin_amdgcn_s_setprio(0); } while (0)
#define PG8_WAIT_V(n) asm volatile("s_waitcnt vmcnt(" #n ")" ::: "memory")
#define PG8_WAIT_L(n) asm volatile("s_waitcnt lgkmcnt(" #n ")" ::: "memory")
#define PG8_BAR __builtin_amdgcn_s_barrier()
#define PG8_SCHED __builtin_amdgcn_sched_barrier(0)
    Unit cur, nxt; int ui = 0;
    if (!S.next(0, cur)) return;
    f32x4 acc[2][2][4][2];
#pragma unroll
    for (int a = 0; a < 2; ++a)
#pragma unroll
        for (int b = 0; b < 2; ++b)
#pragma unroll
            for (int m = 0; m < 4; ++m)
#pragma unroll
                for (int n = 0; n < 2; ++n) acc[a][b][m][n] = (f32x4){0.f, 0.f, 0.f, 0.f};
    bf16x8 At[4][2], B0[2][2], B1[2][2];
    const char* cA = (const char*)gA + (size_t)cur.pm * tstep; const char* cB = (const char*)gBt + (size_t)cur.pn * tstep;
    PG8_STAGE(PG8_SB(0, 0), cB, voffB); PG8_STAGE(PG8_SB(0, 1), cB + hstep, voffB); PG8_STAGE(PG8_SA(0, 0), cA, voffA); PG8_STAGE(PG8_SA(0, 1), cA + hstep, voffA);
    if (wr == 1) PG8_BAR;
    PG8_WAIT_V(2); PG8_BAR;
    PG8_STAGE(PG8_SB(1, 0), cB + kstep, voffB); PG8_STAGE(PG8_SA(1, 0), cA + kstep, voffA); PG8_STAGE(PG8_SB(1, 1), cB + hstep + kstep, voffB);
    PG8_WAIT_V(6); PG8_BAR;
    for (;;) {
        const bool has_next = S.next(ui + 1, nxt);
        const char* nA = has_next ? (const char*)gA + (size_t)nxt.pm * tstep : cA; const char* nB = has_next ? (const char*)gBt + (size_t)nxt.pn * tstep : cB;
#pragma unroll 1
        for (int t = 0; t < nt; t += 2) {
            const bool last = (t == nt - 2);
            const char* a1 = cA + (size_t)(t + 1) * kstep;
            const char* a2 = last ? nA : cA + (size_t)(t + 2) * kstep; const char* b2 = last ? nB : cB + (size_t)(t + 2) * kstep;
            const char* a3 = a2 + kstep; const char* b3 = b2 + kstep;
            PG8_LDB(B0, 0, 0); PG8_LDB(B1, 0, 1); PG8_SCHED; PG8_LDA(At, 0, 0); PG8_STAGE(PG8_SA(1, 1), a1 + hstep, voffA);
            PG8_WAIT_V(8); PG8_WAIT_L(0); PG8_BAR; PG8_MMA(0, 0, At, B0); PG8_MMA(0, 1, At, B1); PG8_BAR; PG8_SCHED;
            PG8_LDA(At, 0, 1); PG8_STAGE(PG8_SB(0, 0), b2, voffB); PG8_STAGE(PG8_SB(0, 1), b2 + hstep, voffB); PG8_STAGE(PG8_SA(0, 0), a2, voffA);
            PG8_WAIT_V(8); PG8_WAIT_L(0); PG8_BAR; PG8_MMA(1, 0, At, B0); PG8_MMA(1, 1, At, B1); PG8_BAR; PG8_SCHED;
            PG8_LDB(B0, 1, 0); PG8_LDB(B1, 1, 1); PG8_SCHED; PG8_LDA(At, 1, 0); PG8_STAGE(PG8_SA(0, 1), a2 + hstep, voffA);
            PG8_WAIT_V(8); PG8_WAIT_L(0); PG8_BAR; PG8_MMA(0, 0, At, B0); PG8_MMA(0, 1, At, B1); PG8_BAR; PG8_SCHED;
            PG8_LDA(At, 1, 1); PG8_STAGE(PG8_SB(1, 0), b3, voffB); PG8_STAGE(PG8_SB(1, 1), b3 + hstep, voffB); PG8_STAGE(PG8_SA(1, 0), a3, voffA);
            PG8_WAIT_V(8); PG8_WAIT_L(0); PG8_BAR; PG8_MMA(1, 0, At, B0); PG8_MMA(1, 1, At, B1); PG8_BAR; PG8_SCHED;
        }
        if constexpr (ALIGN_EPI) { if (wr == 0) PG8_BAR; }
        E(acc, cur, wr, wc, fr, fq);
        if (!has_next) break;
#pragma unroll
        for (int a = 0; a < 2; ++a)
#pragma unroll
            for (int b = 0; b < 2; ++b)
#pragma unroll
                for (int m = 0; m < 4; ++m)
#pragma unroll
                    for (int n = 0; n < 2; ++n) acc[a][b][m][n] = (f32x4){0.f, 0.f, 0.f, 0.f};
        cur = nxt; cA = nA; cB = nB; ++ui;
        if constexpr (ALIGN_EPI) { if (wr == 1) PG8_BAR; }
    }
    PG8_WAIT_V(0);
    if constexpr (!ALIGN_EPI) { if (wr == 0) PG8_BAR; }
    PG8_BAR;
#undef PG8_SA
#undef PG8_SB
#undef PG8_STAGE
#undef PG8_LDA
#undef PG8_LDB
#undef PG8_MMA
#undef PG8_WAIT_V
#undef PG8_WAIT_L
#undef PG8_BAR
#undef PG8_SCHED
}
}

constexpr size_t MiB = 1u << 20;
constexpr size_t WS_CTL = 0;
constexpr size_t WS_SSQ = 4096;
constexpr size_t WS_ROPE = 1 * MiB;
constexpr size_t WS_W = 2 * MiB;
constexpr size_t W_IN = 0, W_OUT = W_IN + (size_t)NIN * DM * 2, W_GU = W_OUT + (size_t)DM * DM * 2, W_D = W_GU + (size_t)2 * FF * DM * 2,
                 W_PP = W_D + (size_t)DM * FF * 2, W_PG = W_PP + (size_t)DM * DPLE * 2, W_LAYER = W_PG + (size_t)DM * DM * 2;
constexpr size_t WS_XB = WS_W + 2 * W_LAYER + MiB;
constexpr size_t ACT_DM = (size_t)MT * DM * 2;
constexpr size_t WS_HB = WS_XB + ACT_DM;
constexpr size_t WS_Z = WS_HB + ACT_DM;
constexpr size_t WS_O = WS_Z + (size_t)MT * NIN * 2;
constexpr size_t WS_ACT = WS_Z;
constexpr size_t WS_PB = WS_O + ACT_DM;
constexpr size_t WS_CKA = WS_PB + (size_t)2 * MT * DPLE * 2;
constexpr size_t CA_BYTES = (size_t)2 * 16 * 512 * 512 * 2, CB_BYTES = (size_t)2 * 16 * 128 * 128 * 2;
constexpr size_t WS_CVA = WS_CKA + CA_BYTES, WS_CKB = WS_CVA + CA_BYTES, WS_CVB = WS_CKB + CB_BYTES, WS_END = WS_CVB + CB_BYTES;
static_assert((size_t)MT * FF * 2 <= (size_t)MT * NIN * 2 + ACT_DM, "ACT overlay fits Z|O");
static_assert(WS_END <= 512 * MiB, "workspace map");

constexpr size_t O_Y = 0, O_AKP = (size_t)MT * DM, O_AVP = O_AKP + 2 * 2 * 512 * 512, O_BKP = O_AVP + 2 * 2 * 512 * 512, O_BVP = O_BKP + 2 * 2 * 128 * 128,
                 O_AKS = O_BVP + 2 * 2 * 128 * 128, O_AVS = O_AKS + (size_t)2 * 16 * 512 * 512, O_BKS = O_AVS + (size_t)2 * 16 * 512 * 512, O_BVS = O_BKS + 2 * 16 * 128 * 128,
                 O_END = O_BVS + 2 * 16 * 128 * 128;

constexpr int LDS_BYTES = 131072 + 4096;
constexpr int W_ITEMS_EARLY = (DM / 64) * (NIN / 32) + (DM / 64) * (DM / 32);
constexpr int NWAVES = 8;

typedef const f32x4 (&AccRef)[2][2][4][2];

struct EpiIn {
    static constexpr bool PERM = true;
    unsigned char* ws_; float* out_; int ssq_off; int l;
    __device__ __forceinline__ void operator()(AccRef acc, const pg8::Unit& u, int wr, int wc, int, int) const {
        GAS unsigned char* wsg_ = (GAS unsigned char*)ws_; GAS float* outg_ = (GAS float*)out_; asm volatile("" : "+s"(wsg_), "+s"(outg_)); unsigned char* ws = (unsigned char*)wsg_; float* out = (float*)outg_;
        const int lane_ = lane_id(); const int fr = lane_ & 15, fq = lane_ >> 4;
        const float* ssq = (const float*)(ws + WS_SSQ) + ssq_off;
        const int pn = u.pn, pm = u.pm;
        const bool samp = pm >= (MP / 256);
        const bool isq = (pn < 2) || (pn == 6) || (pn == 7);
        bf16* Z = (bf16*)(ws + WS_Z); const float* rope = (const float*)(ws + WS_ROPE);
        const bool wrA = (pn >= 2 && pn <= 5) && (samp || (pm & 63) >= 62);
        const bool wrB = (pn == 8) && (samp || (pm & 63) == 63);
        float sq[2][4];
#pragma unroll
        for (int ai = 0; ai < 2; ++ai)
#pragma unroll
            for (int m = 0; m < 4; ++m) sq[ai][m] = ssq[pm * 256 + ai * 128 + wr * 64 + m * 16 + fr];
        asm volatile("" ::: "memory");
#pragma unroll
        for (int ai = 0; ai < 2; ++ai)
#pragma unroll
            for (int m = 0; m < 4; ++m) {
                const int row = pm * 256 + ai * 128 + wr * 64 + m * 16 + fr;
                const float rstd = __builtin_amdgcn_rsqf(sq[ai][m] * (1.0f / DM) + EPS) * (isq ? QSCALE : 1.0f);
                const int pos = samp ? 2048 + ((row - MP) & 63) : (row & 16383);
#pragma unroll
                for (int bj = 0; bj < 2; ++bj) {
                    const int c0 = pn * 256 + bj * 128 + wc * 32 + 8 * fq;
                    float v[8];
#pragma unroll
                    for (int j = 0; j < 4; ++j) { v[j] = acc[ai][bj][m][0][j] * rstd; v[4 + j] = acc[ai][bj][m][1][j] * rstd; }
                    const bool ropet = (pn == 6 || pn == 7 || (pn == 8 && bj == 0)) && ((wc & 1) == 0);
                    if (ropet) {
                        float pv[8];
#pragma unroll
                        for (int j = 0; j < 8; ++j) pv[j] = __shfl_xor(v[j], 16);
                        if (fq < 2) {
                            const f32x4* cs = (const f32x4*)(rope + (size_t)pos * 16);
                            const float sg = (fq == 0) ? -1.f : 1.f;
#pragma unroll
                            for (int jj = 0; jj < 4; ++jj) { const f32x4 t = cs[jj];
                                v[2 * jj] = v[2 * jj] * t[0] + sg * pv[2 * jj] * t[1];
                                v[2 * jj + 1] = v[2 * jj + 1] * t[2] + sg * pv[2 * jj + 1] * t[3]; }
                        }
                    }
                    v4u w; w.x = cvt_pk(v[0], v[1]); w.y = cvt_pk(v[2], v[3]); w.z = cvt_pk(v[4], v[5]); w.w = cvt_pk(v[6], v[7]);
                    *(v4u*)(Z + (size_t)row * NIN + c0) = w;
                    if (wrA) {
                        const int colA = c0 - (pn < 4 ? 512 : 1024);
                        float* dst;
                        if (samp) { const int rs = row - MP; dst = out + (pn < 4 ? O_AKS : O_AVS) + (size_t)l * 16 * 512 * 512 + ((size_t)((rs >> 6) * 512 + 448 + (rs & 63))) * 512 + colA; }
                        else { const int sq = (row & 16383) - 15872; dst = out + (pn < 4 ? O_AKP : O_AVP) + (size_t)l * 2 * 512 * 512 + ((size_t)((row >> 14) * 512 + sq)) * 512 + colA; }
                        *(f32x4*)dst = (f32x4){v[0], v[1], v[2], v[3]}; *(f32x4*)(dst + 4) = (f32x4){v[4], v[5], v[6], v[7]};
                    }
                    if (wrB && (samp || ai == 1)) {
                        const int colB = c0 - (bj == 0 ? 2048 : 2176);
                        float* dst;
                        if (samp) { const int rs = row - MP; dst = out + (bj == 0 ? O_BKS : O_BVS) + (size_t)l * 16 * 128 * 128 + ((size_t)((rs >> 6) * 128 + 64 + (rs & 63))) * 128 + colB; }
                        else { const int sq = (row & 16383) - 16256; dst = out + (bj == 0 ? O_BKP : O_BVP) + (size_t)l * 2 * 128 * 128 + ((size_t)((row >> 14) * 128 + sq)) * 128 + colB; }
                        *(f32x4*)dst = (f32x4){v[0], v[1], v[2], v[3]}; *(f32x4*)(dst + 4) = (f32x4){v[4], v[5], v[6], v[7]};
                    }
                }
            }
    }
};

#define EPI_ENTRY() GAS unsigned char* wsg_ = (GAS unsigned char*)ws_; GAS float* outg_ = (GAS float*)out_; asm volatile("" : "+s"(wsg_), "+s"(outg_)); unsigned char* ws = (unsigned char*)wsg_; float* out = (float*)outg_; const int lane_ = lane_id(); const int fr = lane_ & 15, fq = lane_ >> 4; (void)ws; (void)out

struct EpiRes {
    static constexpr bool PERM = true;
    unsigned char* ws_; float* out_; const float *xp, *xs; int from_xb; int ssq_off;
    __device__ __forceinline__ void operator()(AccRef acc, const pg8::Unit& u, int wr, int wc, int, int) const {
        EPI_ENTRY();
        bf16* HB = (bf16*)(ws + WS_HB); const bf16* RB = (const bf16*)(ws + (from_xb ? WS_XB : WS_HB)); float* ssq = (float*)(ws + WS_SSQ) + ssq_off;
#pragma unroll
        for (int ai = 0; ai < 2; ++ai) {
            f32x4 r0[4][2], r1[4][2];
            if (xp) {
#pragma unroll
                for (int m = 0; m < 4; ++m) { const int row = u.pm * 256 + ai * 128 + wr * 64 + m * 16 + fr;
                    const float* rsrc = (row < MP) ? xp + (size_t)row * DM : xs + (size_t)(row - MP) * DM;
#pragma unroll
                    for (int bj = 0; bj < 2; ++bj) { const int c0 = u.pn * 256 + bj * 128 + wc * 32 + 8 * fq; r0[m][bj] = *(const f32x4*)(rsrc + c0); r1[m][bj] = *(const f32x4*)(rsrc + c0 + 4); } }
            } else {
                v4u pw[4][2];
#pragma unroll
                for (int m = 0; m < 4; ++m) { const int row = u.pm * 256 + ai * 128 + wr * 64 + m * 16 + fr;
#pragma unroll
                    for (int bj = 0; bj < 2; ++bj) pw[m][bj] = *(const v4u*)(RB + (size_t)row * DM + u.pn * 256 + bj * 128 + wc * 32 + 8 * fq); }
#pragma unroll
                for (int m = 0; m < 4; ++m)
#pragma unroll
                    for (int bj = 0; bj < 2; ++bj) { const v4u w = pw[m][bj]; r0[m][bj] = (f32x4){bf_lo(w.x), bf_hi(w.x), bf_lo(w.y), bf_hi(w.y)}; r1[m][bj] = (f32x4){bf_lo(w.z), bf_hi(w.z), bf_lo(w.w), bf_hi(w.w)}; }
            }
            asm volatile("" ::: "memory");
#pragma unroll
            for (int m = 0; m < 4; ++m) {
                const int row = u.pm * 256 + ai * 128 + wr * 64 + m * 16 + fr;
                float ss = 0.f;
#pragma unroll
                for (int bj = 0; bj < 2; ++bj) {
                    const int c0 = u.pn * 256 + bj * 128 + wc * 32 + 8 * fq;
                    const f32x4 o0 = r0[m][bj] + acc[ai][bj][m][0], o1 = r1[m][bj] + acc[ai][bj][m][1];
                    v4u w; w.x = cvt_pk(o0[0], o0[1]); w.y = cvt_pk(o0[2], o0[3]); w.z = cvt_pk(o1[0], o1[1]); w.w = cvt_pk(o1[2], o1[3]);
                    *(v4u*)(HB + (size_t)row * DM + c0) = w;
                    ss += (o0[0] * o0[0] + o0[1] * o0[1]) + (o0[2] * o0[2] + o0[3] * o0[3]) + (o1[0] * o1[0] + o1[1] * o1[1]) + (o1[2] * o1[2] + o1[3] * o1[3]);
                }
                if (ssq_off >= 0) { ss += __shfl_xor(ss, 16); ss += __shfl_xor(ss, 32); if (fq == 0) __hip_atomic_fetch_add(ssq + row, ss, __ATOMIC_RELAXED, __HIP_MEMORY_SCOPE_AGENT); }
            }
        }
    }
};

typedef float f32x2 __attribute__((ext_vector_type(2)));
struct EpiGU {
    static constexpr bool PERM = true;
    unsigned char* ws_; float* out_; int ssq_off;
    __device__ __forceinline__ void operator()(AccRef acc, const pg8::Unit& u, int wr, int wc, int, int) const {
        EPI_ENTRY();
        bf16* ACT = (bf16*)(ws + WS_ACT); const float* ssq = (const float*)(ws + WS_SSQ) + ssq_off;
        float sq[2][4];
#pragma unroll
        for (int ai = 0; ai < 2; ++ai)
#pragma unroll
            for (int m = 0; m < 4; ++m) sq[ai][m] = ssq[u.pm * 256 + ai * 128 + wr * 64 + m * 16 + fr];
        asm volatile("" ::: "memory");
#pragma unroll
        for (int ai = 0; ai < 2; ++ai)
#pragma unroll
            for (int m = 0; m < 4; ++m) {
                const int row = u.pm * 256 + ai * 128 + wr * 64 + m * 16 + fr;
                const float rstd = __builtin_amdgcn_rsqf(sq[ai][m] * (1.0f / DM) + EPS);
                const float rc = -rstd * LOG2E, r2 = rstd * rstd;
                unsigned pk[4];
#pragma unroll
                for (int n = 0; n < 2; ++n)
#pragma unroll
                    for (int h = 0; h < 2; ++h) {
                        const f32x2 g2 = {acc[ai][0][m][n][2 * h], acc[ai][0][m][n][2 * h + 1]}, u2 = {acc[ai][1][m][n][2 * h], acc[ai][1][m][n][2 * h + 1]};
                        const f32x2 x2 = g2 * rc; f32x2 d2; d2.x = fexp2(x2.x); d2.y = fexp2(x2.y); d2 = d2 + 1.0f;
                        f32x2 q2; q2.x = frcp(d2.x); q2.y = frcp(d2.y);
                        const f32x2 t2 = (g2 * u2) * r2 * q2;
                        pk[2 * n + h] = cvt_pk(t2.x, t2.y);
                    }
                v4u w; w.x = pk[0]; w.y = pk[1]; w.z = pk[2]; w.w = pk[3];
                *(v4u*)(ACT + (size_t)row * FF + u.pn * 128 + wc * 32 + 8 * fq) = w;
            }
    }
};

struct EpiPP {
    static constexpr bool PERM = true;
    unsigned char* ws_; float* out_;
    __device__ __forceinline__ void operator()(AccRef acc, const pg8::Unit& u, int wr, int wc, int, int) const {
        EPI_ENTRY();
        bf16* PP = (bf16*)(ws + WS_XB);
#pragma unroll
        for (int ai = 0; ai < 2; ++ai)
#pragma unroll
            for (int m = 0; m < 4; ++m) {
                const int row = u.pm * 256 + ai * 128 + wr * 64 + m * 16 + fr;
#pragma unroll
                for (int bj = 0; bj < 2; ++bj) {
                    const int c0 = u.pn * 256 + bj * 128 + wc * 32 + 8 * fq;
                    const f32x4 o0 = acc[ai][bj][m][0], o1 = acc[ai][bj][m][1];
                    v4u w; w.x = cvt_pk(o0[0], o0[1]); w.y = cvt_pk(o0[2], o0[3]); w.z = cvt_pk(o1[0], o1[1]); w.w = cvt_pk(o1[2], o1[3]);
                    *(v4u*)(PP + (size_t)row * DM + c0) = w;
                }
            }
    }
};

struct EpiPG {
    static constexpr bool PERM = true;
    unsigned char* ws_; float* out_; int ssq_off;
    __device__ __forceinline__ void operator()(AccRef acc, const pg8::Unit& u, int wr, int wc, int, int) const {
        EPI_ENTRY();
        const bf16* HB = (const bf16*)(ws + WS_HB); bf16* XB = (bf16*)(ws + WS_XB); float* ssq = (float*)(ws + WS_SSQ) + ssq_off;
#pragma unroll
        for (int ai = 0; ai < 2; ++ai) {
            v4u hwv[4][2], pwv[4][2];
#pragma unroll
            for (int m = 0; m < 4; ++m) { const int row = u.pm * 256 + ai * 128 + wr * 64 + m * 16 + fr;
#pragma unroll
                for (int bj = 0; bj < 2; ++bj) { const size_t off = (size_t)row * DM + u.pn * 256 + bj * 128 + wc * 32 + 8 * fq; hwv[m][bj] = *(const v4u*)(HB + off); pwv[m][bj] = *(const v4u*)(XB + off); } }
            asm volatile("" ::: "memory");
#pragma unroll
            for (int m = 0; m < 4; ++m) {
                const int row = u.pm * 256 + ai * 128 + wr * 64 + m * 16 + fr;
                float ss = 0.f;
#pragma unroll
                for (int bj = 0; bj < 2; ++bj) {
                    const int c0 = u.pn * 256 + bj * 128 + wc * 32 + 8 * fq;
                    const v4u hw = hwv[m][bj], pw = pwv[m][bj];
                    const float hh[8] = {bf_lo(hw.x), bf_hi(hw.x), bf_lo(hw.y), bf_hi(hw.y), bf_lo(hw.z), bf_hi(hw.z), bf_lo(hw.w), bf_hi(hw.w)};
                    const float pp[8] = {bf_lo(pw.x), bf_hi(pw.x), bf_lo(pw.y), bf_hi(pw.y), bf_lo(pw.z), bf_hi(pw.z), bf_lo(pw.w), bf_hi(pw.w)};
                    float o[8];
#pragma unroll
                    for (int j = 0; j < 4; ++j) {
                        o[j] = hh[j] + pp[j] * frcp(1.0f + fexp2(-acc[ai][bj][m][0][j] * LOG2E));
                        o[4 + j] = hh[4 + j] + pp[4 + j] * frcp(1.0f + fexp2(-acc[ai][bj][m][1][j] * LOG2E));
                    }
                    v4u w; w.x = cvt_pk(o[0], o[1]); w.y = cvt_pk(o[2], o[3]); w.z = cvt_pk(o[4], o[5]); w.w = cvt_pk(o[6], o[7]);
                    *(v4u*)(XB + (size_t)row * DM + c0) = w;
#pragma unroll
                    for (int j = 0; j < 8; ++j) ss += o[j] * o[j];
                }
                ss += __shfl_xor(ss, 16); ss += __shfl_xor(ss, 32);
                if (fq == 0) __hip_atomic_fetch_add(ssq + row, ss, __ATOMIC_RELAXED, __HIP_MEMORY_SCOPE_AGENT);
            }
        }
    }
};

template <bool GU>
__device__ __forceinline__ void transpose_item(const float* W, int K, int N, bf16* WT, const float* gs, LAS float* scr, int item, int lane) {
    const int nblk = N / 32, kb = item / nblk, nb = item % nblk, k0 = 64 * kb, n0 = 32 * nb;
#pragma unroll 16
    for (int i = 0; i < 32; ++i) { const int kk = 2 * i + (lane >> 5); float w = W[(size_t)(k0 + kk) * N + n0 + (lane & 31)]; if (gs) w *= gs[k0 + kk]; scr[kk * 33 + (lane & 31)] = w; }
    asm volatile("s_waitcnt lgkmcnt(0)" ::: "memory");
    int d0 = n0;
    if (GU) { const int f = (n0 < FF) ? n0 : n0 - FF; d0 = 256 * (f >> 7) + (f & 127) + ((n0 < FF) ? 0 : 128); }
    const int c = lane & 7;
#pragma unroll
    for (int j = 0; j < 4; ++j) { const int n = (lane >> 3) + 8 * j; const LAS float* s = scr + (8 * c) * 33 + n;
        v4u o; o.x = cvt_pk(s[0 * 33], s[1 * 33]); o.y = cvt_pk(s[2 * 33], s[3 * 33]); o.z = cvt_pk(s[4 * 33], s[5 * 33]); o.w = cvt_pk(s[6 * 33], s[7 * 33]);
        *(v4u*)(WT + (size_t)(d0 + n) * K + k0 + 8 * c) = o; }
    asm volatile("s_waitcnt lgkmcnt(0)" ::: "memory");
}

__device__ __forceinline__ void convert_flat(const float* src, bf16* dst, size_t n, size_t gtid, size_t gthreads) {
    for (size_t i = gtid * 8; i < n; i += gthreads * 8) {
        const f32x4 a = *(const f32x4*)(src + i), b = *(const f32x4*)(src + i + 4);
        v4u w; w.x = cvt_pk(a[0], a[1]); w.y = cvt_pk(a[2], a[3]); w.z = cvt_pk(b[0], b[1]); w.w = cvt_pk(b[2], b[3]);
        *(v4u*)(dst + i) = w;
    }
}

constexpr float ATT_THR = 6.0f;
constexpr int AL_V = 0, AL_EXT = 65536, AL_RED = AL_EXT + 26624, AL_UNIT = AL_RED + 2048;
struct AttnArgs { const bf16 *Z, *CKA, *CVA, *CKB, *CVB; const float *sinks, *goa, *gob; bf16* O; unsigned* ctr; };

template <bool ISA>
__device__ __forceinline__ void attn_unit(LAS unsigned char* lds, const AttnArgs& T, int sc, int wave, int) {
    const int lane = lane_id();
    const int fr = lane & 15, fq = lane >> 4;
    const bool samp = sc >= 512;
    const int b = samp ? sc - 512 : sc >> 8, c = samp ? 255 : (sc & 255);
    const int row0 = samp ? MP + b * 64 : b * 16384 + c * 64;
    constexpr int NPREV = ISA ? 8 : 2;
    const int kc0 = (NPREV - c) > 0 ? (NPREV - c) : 0;
    const int hd = wave, kv = wave >> 2;
    const int qcol = ISA ? hd * 64 : 1536 + hd * 64;
    LAS unsigned char* vst = lds + AL_V + wave * 8192;
    const LAS float* ext = (const LAS float*)(lds + AL_EXT) + hd * 832;
    LAS float* red = (LAS float*)(lds + AL_RED);

    bf16x8 qf[4][2];
#pragma unroll
    for (int qb = 0; qb < 4; ++qb)
#pragma unroll
        for (int ks = 0; ks < 2; ++ks) qf[qb][ks] = *(const bf16x8*)((const char*)(T.Z + (size_t)(row0 + 16 * qb) * NIN + qcol + 32 * ks) + (unsigned)((fr * NIN + 8 * fq) * 2));
    f32x4 o[4][4];
#pragma unroll
    for (int db = 0; db < 4; ++db)
#pragma unroll
        for (int qb = 0; qb < 4; ++qb) o[db][qb] = (f32x4){0.f, 0.f, 0.f, 0.f};
    const float sink2 = ISA ? 0.f : T.sinks[hd] * LOG2E;
    float mrow[4], lrow[4];
#pragma unroll
    for (int qb = 0; qb < 4; ++qb) { mrow[qb] = ISA ? -1e30f : sink2; lrow[qb] = 0.f; }

#define ATT_TILE_PTRS(KC, KP, VP, PITCH) do { \
        if (samp && (KC) < NPREV) { \
            if (ISA) { const size_t off_ = ((size_t)(b * 512 + (KC) * 64)) * 512 + hd * 64; KP = T.CKA + off_; VP = T.CVA + off_; PITCH = 512; } \
            else { const size_t off_ = ((size_t)(b * 128 + (KC) * 64)) * 128 + kv * 64; KP = T.CKB + off_; VP = T.CVB + off_; PITCH = 128; } \
        } else { \
            const size_t r_ = (size_t)(row0 - (NPREV - (KC)) * 64) * NIN; \
            KP = T.Z + r_ + (ISA ? 512 + hd * 64 : 2048 + kv * 64); VP = T.Z + r_ + (ISA ? 1024 + hd * 64 : 2176 + kv * 64); PITCH = NIN; \
        } } while (0)
#define ATT_LOAD_K(KP, PITCH) do { _Pragma("unroll") for (int kb = 0; kb < 4; ++kb) { \
        const char* kr_ = (const char*)((KP) + (size_t)(16 * kb) * (PITCH)) + (unsigned)((fr * (PITCH) + 8 * fq) * 2); kf[kb][0] = *(const bf16x8*)kr_; kf[kb][1] = *(const bf16x8*)(kr_ + 64); } } while (0)
    bf16x8 kf[4][2];
    { const bf16 *kp0, *vp0; int pitch0; ATT_TILE_PTRS(kc0, kp0, vp0, pitch0); (void)vp0; ATT_LOAD_K(kp0, pitch0); }
    for (int kc = kc0; kc <= NPREV; ++kc) {
        const bf16 *kp, *vp; int pitch;
        ATT_TILE_PTRS(kc, kp, vp, pitch); (void)kp;
        {
            const unsigned voff = (unsigned)(((lane >> 3) * pitch + (((lane & 7) ^ ((lane >> 3) & 6)) * 8)) * 2);
#pragma unroll
            for (int i = 0; i < 8; ++i)
                __builtin_amdgcn_global_load_lds((const unsigned*)((const char*)(vp + (size_t)(8 * i) * pitch) + voff), (LAS unsigned*)(vst + i * 1024), 16, 0, 0);
        }
        bf16x8 pf[4][2];
#pragma unroll
        for (int qh = 0; qh < 2; ++qh) {
            f32x4 s[4][2];
            const LAS float* eb = ext + (768 + 32 * qh + fr - 64 * kc - 4 * fq);
#pragma unroll
            for (int kb = 0; kb < 4; ++kb)
#pragma unroll
                for (int q2 = 0; q2 < 2; ++q2) {
                    f32x4 c0 = (f32x4){0.f, 0.f, 0.f, 0.f};
                    if (ISA) { const LAS float* e = eb + (16 * q2 - 16 * kb); c0 = (f32x4){e[0], e[-1], e[-2], e[-3]}; }
                    f32x4 t = __builtin_amdgcn_mfma_f32_16x16x32_bf16(kf[kb][0], qf[2 * qh + q2][0], c0, 0, 0, 0);
                    s[kb][q2] = __builtin_amdgcn_mfma_f32_16x16x32_bf16(kf[kb][1], qf[2 * qh + q2][1], t, 0, 0, 0);
                }
            if (qh == 1) { const int kn = kc < NPREV ? kc + 1 : kc; const bf16 *kpn, *vpn; int pitchn; ATT_TILE_PTRS(kn, kpn, vpn, pitchn); (void)vpn; ATT_LOAD_K(kpn, pitchn); }
#pragma unroll
            for (int q2 = 0; q2 < 2; ++q2) {
                const int qb = 2 * qh + q2;
                float mx = fmaxf(fmaxf(s[0][q2][0], s[0][q2][1]), s[0][q2][2]);
                mx = fmaxf(fmaxf(mx, s[0][q2][3]), s[1][q2][0]); mx = fmaxf(fmaxf(mx, s[1][q2][1]), s[1][q2][2]); mx = fmaxf(fmaxf(mx, s[1][q2][3]), s[2][q2][0]);
                mx = fmaxf(fmaxf(mx, s[2][q2][1]), s[2][q2][2]); mx = fmaxf(fmaxf(mx, s[2][q2][3]), s[3][q2][0]); mx = fmaxf(fmaxf(mx, s[3][q2][1]), s[3][q2][2]); mx = fmaxf(mx, s[3][q2][3]);
                if (!__all(mx <= mrow[qb] + ATT_THR)) {
                    mx = fmaxf(mx, __shfl_xor(mx, 16)); mx = fmaxf(mx, __shfl_xor(mx, 32));
                    const float mnew = fmaxf(mrow[qb], mx), alpha = fexp2(mrow[qb] - mnew);
                    mrow[qb] = mnew; lrow[qb] = lrow[qb] * alpha;
#pragma unroll
                    for (int db = 0; db < 4; ++db) o[db][qb] = o[db][qb] * alpha;
                }
                const float mcur = mrow[qb];
                float ps = 0.f; float p[4][4];
#pragma unroll
                for (int kb = 0; kb < 4; ++kb)
#pragma unroll
                    for (int j = 0; j < 4; ++j) { p[kb][j] = fexp2(s[kb][q2][j] - mcur); ps += p[kb][j]; }
                lrow[qb] += ps;
#pragma unroll
                for (int kp2 = 0; kp2 < 2; ++kp2) {
                    v4u w; w.x = cvt_pk(p[2 * kp2][0], p[2 * kp2][1]); w.y = cvt_pk(p[2 * kp2][2], p[2 * kp2][3]);
                    w.z = cvt_pk(p[2 * kp2 + 1][0], p[2 * kp2 + 1][1]); w.w = cvt_pk(p[2 * kp2 + 1][2], p[2 * kp2 + 1][3]);
                    pf[qb][kp2] = __builtin_bit_cast(bf16x8, w);
                }
            }
        }
        asm volatile("s_waitcnt vmcnt(8)" ::: "memory");
        __builtin_amdgcn_wave_barrier();
        const int tq = (lane & 15) >> 2, tp = lane & 3;
#pragma unroll
        for (int kp2 = 0; kp2 < 2; ++kp2) {
            bf16x8 vf[4];
#pragma unroll
            for (int db = 0; db < 4; ++db) {
                const int r8 = 4 * (fq & 1) + tq;
                LAS unsigned char* a0 = vst + (4 * kp2 + (fq >> 1)) * 1024 + r8 * 128 + (((2 * db + (tp >> 1)) ^ (r8 & 6)) * 16) + (tp & 1) * 8;
                const s16x4 lo = __builtin_bit_cast(s16x4, __builtin_amdgcn_ds_read_tr16_b64_v4i16((LAS s16x4*)a0));
                const s16x4 hi = __builtin_bit_cast(s16x4, __builtin_amdgcn_ds_read_tr16_b64_v4i16((LAS s16x4*)(a0 + 2048)));
                vf[db] = (bf16x8){lo[0], lo[1], lo[2], lo[3], hi[0], hi[1], hi[2], hi[3]};
            }
#pragma unroll
            for (int qb = 0; qb < 4; ++qb)
#pragma unroll
                for (int db = 0; db < 4; ++db) o[db][qb] = __builtin_amdgcn_mfma_f32_16x16x32_bf16(vf[db], pf[qb][kp2], o[db][qb], 0, 0, 0);
        }
        asm volatile("" ::: "memory");
    }
#pragma unroll
    for (int qb = 0; qb < 4; ++qb) {
        float lt = lrow[qb]; lt += __shfl_xor(lt, 16); lt += __shfl_xor(lt, 32);
        if (!ISA) lt += fexp2(sink2 - mrow[qb]);
        const float inv = 1.0f / lt; float ss = 0.f;
#pragma unroll
        for (int db = 0; db < 4; ++db) { o[db][qb] = o[db][qb] * inv;
#pragma unroll
            for (int j = 0; j < 4; ++j) ss += o[db][qb][j] * o[db][qb][j]; }
        ss += __shfl_xor(ss, 16); ss += __shfl_xor(ss, 32);
        if (fq == 0) red[wave * 64 + 16 * qb + fr] = ss;
    }
    __syncthreads();
    const float* gout = (ISA ? T.goa : T.gob) + hd * 64 + 4 * (lane_id() >> 4);
    f32x4 gv[4];
#pragma unroll
    for (int db = 0; db < 4; ++db) gv[db] = *(const f32x4*)(gout + 16 * db);
#pragma unroll
    for (int qb = 0; qb < 4; ++qb) {
        float tot = 0.f;
#pragma unroll
        for (int w = 0; w < 8; ++w) tot += red[w * 64 + 16 * qb + fr];
        const float rstd = __builtin_amdgcn_rsqf(tot * (1.0f / 512.0f) + EPS);
        char* orow = (char*)(T.O + (size_t)(row0 + 16 * qb) * DM + (ISA ? 0 : 512) + hd * 64) + (unsigned)((fr * DM + 4 * fq) * 2);
#pragma unroll
        for (int db = 0; db < 4; ++db) { const f32x4 v = o[db][qb] * rstd * gv[db];
            v2u w; w.x = cvt_pk(v[0], v[1]); w.y = cvt_pk(v[2], v[3]); *(v2u*)(orow + 32 * db) = w; }
    }
}

__device__ __forceinline__ void attn_phase(LAS unsigned char* lds, const AttnArgs& T, const float* relb, const int wave) {
    const int lane = lane_id(), tid = wave * 64 + lane;
    LAS float* ext = (LAS float*)(lds + AL_EXT);
    for (int i = tid; i < 8 * 832; i += NWAVES * 64) { const int h = i / 832, k = i % 832; ext[i] = relb[h * 513 + (k < 512 ? k : 512)] * LOG2E; }
    volatile LAS unsigned* uw = (volatile LAS unsigned*)(lds + AL_UNIT);
    int qcur = (int)(blockIdx.x & 7u), qleft = 8;
    for (;;) {
        __syncthreads();
        if (tid == 0) {
            unsigned code = 0xffffffffu;
            while (qleft > 0) {
                const unsigned j = __hip_atomic_fetch_add(T.ctr + 16 * qcur, 1u, __ATOMIC_RELAXED, __HIP_MEMORY_SCOPE_AGENT);
                if (j < 132u) { code = (unsigned)qcur * 132u + j; break; }
                qcur = (qcur + 1) & 7; --qleft;
            }
            uw[0] = code;
        }
        __syncthreads();
        const unsigned u = (unsigned)__builtin_amdgcn_readfirstlane((int)uw[0]);
        if (u == 0xffffffffu) break;
        const int qq = (int)(u / 132u), j = (int)(u % 132u);
        if (j < 66) attn_unit<true>(lds, T, qq * 66 + j, wave, lane); else attn_unit<false>(lds, T, qq * 66 + j - 66, wave, lane);
    }
    __syncthreads();
}

struct Args { const float* in[21]; float* out; unsigned char* ws; };

constexpr size_t WS_SMALL = 768 * 1024, WS_BAR = 2048;
constexpr int SM_RELB = 0, SM_SINK = 8448, SM_GOA = 8512, SM_GOB = 9536, SM_GFIN = 10560, SM_END = 11584;
static_assert(WS_SSQ + (size_t)5 * MT * 4 <= WS_SMALL && WS_SMALL + SM_END * 4 <= WS_ROPE, "control region map");

__device__ __forceinline__ void grid_bar(unsigned* bar, unsigned k, unsigned G, unsigned bid, bool leader) {
    asm volatile("s_waitcnt vmcnt(0) lgkmcnt(0)" ::: "memory");
    __syncthreads();
    if (leader) {
        const unsigned g = bid & 7u, gsz = (G - g + 7u) >> 3, ng = G < 8u ? G : 8u;
        unsigned* gcnt = bar + 16 * (1 + g); unsigned* ggen = bar + 16 * (9 + g); unsigned* top = bar + 16 * 17;
        __builtin_amdgcn_fence(__ATOMIC_RELEASE, "agent");
        asm volatile("s_waitcnt vmcnt(0)" ::: "memory");
        const unsigned old = __hip_atomic_fetch_add(gcnt, 1u, __ATOMIC_RELAXED, __HIP_MEMORY_SCOPE_AGENT);
        if (old + 1u == k * gsz) {
            __hip_atomic_fetch_add(top, 1u, __ATOMIC_RELAXED, __HIP_MEMORY_SCOPE_AGENT);
            while (__hip_atomic_load(top, __ATOMIC_RELAXED, __HIP_MEMORY_SCOPE_AGENT) < k * ng) __builtin_amdgcn_s_sleep(1);
            __hip_atomic_fetch_add(ggen, 1u, __ATOMIC_RELAXED, __HIP_MEMORY_SCOPE_AGENT);
        } else {
            while (__hip_atomic_load(ggen, __ATOMIC_RELAXED, __HIP_MEMORY_SCOPE_AGENT) < k) __builtin_amdgcn_s_sleep(1);
        }
        __builtin_amdgcn_fence(__ATOMIC_ACQUIRE, "agent");
        asm volatile("s_waitcnt vmcnt(0)" ::: "memory");
    }
    __syncthreads();
}

struct PIn { const float *w_in, *w_out, *w_gu, *w_d, *w_pp, *w_pg, *g_mix, *g_ffn, *p_p, *p_s, *cak, *cav, *cbk, *cbv; };

__device__ __forceinline__ void conv_weights(LAS unsigned char* lds, unsigned char* ws, const PIn& I, const int l, const int wave, const int lane, const int gw, const int NGW, const int r_lo, const int r_hi) {
    LAS float* scr = (LAS float*)(lds + wave * 8448);
    constexpr int I_IN = (DM / 64) * (NIN / 32), I_OUT = (DM / 64) * (DM / 32), I_GU = (DM / 64) * (2 * FF / 32), I_D = (FF / 64) * (DM / 32), I_PP = (DPLE / 64) * (DM / 32), I_PG = I_OUT;
    constexpr int I_LAYER = I_IN + I_OUT + I_GU + I_D + I_PP + I_PG;
    unsigned char* wb = ws + WS_W + (size_t)l * W_LAYER;
    for (int it = r_lo + gw; it < (r_hi < I_LAYER ? r_hi : I_LAYER); it += NGW) {
        int r = it;
        if (r < I_IN) { transpose_item<false>(I.w_in + (size_t)l * DM * NIN, DM, NIN, (bf16*)(wb + W_IN), I.g_mix + l * DM, scr, r, lane); continue; } r -= I_IN;
        if (r < I_OUT) { transpose_item<false>(I.w_out + (size_t)l * DM * DM, DM, DM, (bf16*)(wb + W_OUT), nullptr, scr, r, lane); continue; } r -= I_OUT;
        if (r < I_GU) { transpose_item<true>(I.w_gu + (size_t)l * DM * 2 * FF, DM, 2 * FF, (bf16*)(wb + W_GU), I.g_ffn + l * DM, scr, r, lane); continue; } r -= I_GU;
        if (r < I_D) { transpose_item<false>(I.w_d + (size_t)l * FF * DM, FF, DM, (bf16*)(wb + W_D), nullptr, scr, r, lane); continue; } r -= I_D;
        if (r < I_PP) { transpose_item<false>(I.w_pp + (size_t)l * DPLE * DM, DPLE, DM, (bf16*)(wb + W_PP), nullptr, scr, r, lane); continue; } r -= I_PP;
        transpose_item<false>(I.w_pg + (size_t)l * DM * DM, DM, DM, (bf16*)(wb + W_PG), nullptr, scr, r, lane);
    }
}
__device__ __forceinline__ void conv_p_caches(unsigned char* ws, float* out, const PIn& I, const int l, const size_t gtid, const size_t gth, const int part = 3) {
    bf16* PB = (bf16*)(ws + WS_PB);
    if (part & 1) {
    convert_flat(I.p_p + (size_t)l * MP * DPLE, PB + (size_t)l * MT * DPLE, (size_t)MP * DPLE, gtid, gth);
    convert_flat(I.p_s + (size_t)l * MS * DPLE, PB + (size_t)l * MT * DPLE + (size_t)MP * DPLE, (size_t)MS * DPLE, gtid, gth);
    }
    if (!(part & 2)) return;
    constexpr size_t NA = (size_t)16 * 512 * 512, NB = (size_t)16 * 128 * 128;
    for (size_t i = gtid * 8; i < NA; i += gth * 8) {
        const size_t gi = (size_t)l * NA + i;
        const f32x4 a = *(const f32x4*)(I.cak + gi), b = *(const f32x4*)(I.cak + gi + 4), c = *(const f32x4*)(I.cav + gi), d = *(const f32x4*)(I.cav + gi + 4);
        v4u w; w.x = cvt_pk(a[0], a[1]); w.y = cvt_pk(a[2], a[3]); w.z = cvt_pk(b[0], b[1]); w.w = cvt_pk(b[2], b[3]);
        *(v4u*)((bf16*)(ws + WS_CKA) + gi) = w;
        w.x = cvt_pk(c[0], c[1]); w.y = cvt_pk(c[2], c[3]); w.z = cvt_pk(d[0], d[1]); w.w = cvt_pk(d[2], d[3]);
        *(v4u*)((bf16*)(ws + WS_CVA) + gi) = w;
        if (((i >> 9) & 511) >= 64) { float* dk = out + O_AKS + gi - 32768; float* dv = out + O_AVS + gi - 32768;
            *(f32x4*)dk = a; *(f32x4*)(dk + 4) = b; *(f32x4*)dv = c; *(f32x4*)(dv + 4) = d; }
    }
    for (size_t i = gtid * 8; i < NB; i += gth * 8) {
        const size_t gi = (size_t)l * NB + i;
        const f32x4 a = *(const f32x4*)(I.cbk + gi), b = *(const f32x4*)(I.cbk + gi + 4), c = *(const f32x4*)(I.cbv + gi), d = *(const f32x4*)(I.cbv + gi + 4);
        v4u w; w.x = cvt_pk(a[0], a[1]); w.y = cvt_pk(a[2], a[3]); w.z = cvt_pk(b[0], b[1]); w.w = cvt_pk(b[2], b[3]);
        *(v4u*)((bf16*)(ws + WS_CKB) + gi) = w;
        w.x = cvt_pk(c[0], c[1]); w.y = cvt_pk(c[2], c[3]); w.z = cvt_pk(d[0], d[1]); w.w = cvt_pk(d[2], d[3]);
        *(v4u*)((bf16*)(ws + WS_CVB) + gi) = w;
        if (((i >> 7) & 127) >= 64) { float* dk = out + O_BKS + gi - 8192; float* dv = out + O_BVS + gi - 8192;
            *(f32x4*)dk = a; *(f32x4*)(dk + 4) = b; *(f32x4*)dv = c; *(f32x4*)(dv + 4) = d; }
    }
}

template <int l>
__device__ __forceinline__ void run_layer(LAS unsigned char* lds, unsigned char* ws_in, float* out_in, const float* x_p, const float* x_s, const PIn* pin, const int G, const int bid, const int wave) {
    GAS unsigned char* wsg_ = (GAS unsigned char*)ws_in; GAS float* outg_ = (GAS float*)out_in; asm volatile("" : "+s"(wsg_), "+s"(outg_));
    unsigned char* ws = (unsigned char*)wsg_; float* out = (float*)outg_;
    unsigned* const bar = (unsigned*)(ws + WS_BAR);
#define GRID_BAR(k) grid_bar(bar, (unsigned)((k) + 1), (unsigned)G, (unsigned)bid, wave == 0 && lane_id() == 0)
        unsigned char* wb = ws + WS_W + (size_t)l * W_LAYER;
        bf16 *XB = (bf16*)(ws + WS_XB), *HB = (bf16*)(ws + WS_HB), *O = (bf16*)(ws + WS_O), *ACT = (bf16*)(ws + WS_ACT);
        {
            pg8::RowOrder<NIN / 256> S; S.init(G, bid);
            EpiIn E{ws, out, (l == 0) ? 0 : 2 * MT, l};
            pg8::gemm_phase<DM, EpiIn, pg8::RowOrder<NIN / 256>>(lds, XB, (const bf16*)(wb + W_IN), S, E, wave);
            if (l == 0) {
                const int nbusy = (MT / 256 * (NIN / 256)) % G;
                if (S.v >= nbusy) { const int lane = lane_id(); const PIn I = *pin;
                    conv_p_caches(ws, out, I, 0, (size_t)(S.v - nbusy) * (NWAVES * 64) + wave * 64 + lane, (size_t)(G - nbusy) * (NWAVES * 64)); }
            }
        }
        GRID_BAR(6 * l + 1);
        {
            const float* sm = (const float*)(ws + WS_SMALL);
            AttnArgs T{(const bf16*)(ws + WS_Z), (const bf16*)(ws + WS_CKA) + (size_t)l * 16 * 512 * 512, (const bf16*)(ws + WS_CVA) + (size_t)l * 16 * 512 * 512,
                       (const bf16*)(ws + WS_CKB) + (size_t)l * 16 * 128 * 128, (const bf16*)(ws + WS_CVB) + (size_t)l * 16 * 128 * 128,
                       sm + SM_SINK + l * 8, sm + SM_GOA + l * 512, sm + SM_GOB + l * 512, O, (unsigned*)(ws + WS_CTL) + 128 * l};
            attn_phase(lds, T, sm + SM_RELB + (size_t)l * 8 * 513, wave);
        }
        GRID_BAR(6 * l + 2);
        {
            pg8::RowOrder<DM / 256> S; S.init(G, bid);
            EpiRes E{ws, out, nullptr, nullptr, 1, (1 + 2 * l) * MT};
            pg8::gemm_phase<DM, EpiRes, pg8::RowOrder<DM / 256>>(lds, O, (const bf16*)(wb + W_OUT), S, E, wave);
            if (l == 0) {
                const int nbusy = (MT / 256 * 4) % G;
                if (S.v >= nbusy) { const int lane = lane_id(); const PIn I = *pin; __syncthreads();
                    conv_weights(lds, ws, I, 0, wave, lane, (S.v - nbusy) * NWAVES + wave, (G - nbusy) * NWAVES, W_ITEMS_EARLY, 1 << 30); }
            }
        }
        GRID_BAR(6 * l + 3);
        {
            pg8::RowOrder<2 * FF / 256> S; S.init(G, bid);
            EpiGU E{ws, out, (1 + 2 * l) * MT};
            pg8::gemm_phase<DM, EpiGU, pg8::RowOrder<2 * FF / 256>>(lds, HB, (const bf16*)(wb + W_GU), S, E, wave);
            if (l == 0) {
                const int nbusy = (MT / 256 * (2 * FF / 256)) % G;
                if (S.v >= nbusy) { const int lane = lane_id(); const PIn I = *pin;
                    conv_p_caches(ws, out, I, 1, (size_t)(S.v - nbusy) * (NWAVES * 64) + wave * 64 + lane, (size_t)(G - nbusy) * (NWAVES * 64), 1); }
            }
        }
        GRID_BAR(6 * l + 4);
        {
            pg8::RowOrder<DM / 256> S; S.init(G, bid);
            EpiRes E{ws, out, nullptr, nullptr, 0, -1};
            pg8::gemm_phase<FF, EpiRes, pg8::RowOrder<DM / 256>>(lds, ACT, (const bf16*)(wb + W_D), S, E, wave);
            pg8::RowOrder<DM / 256> S2; S2.init(G, G - 1 - bid);
            EpiPP E2{ws, out};
            pg8::gemm_phase<DPLE, EpiPP, pg8::RowOrder<DM / 256>>(lds, (const bf16*)(ws + WS_PB) + (size_t)l * MT * DPLE, (const bf16*)(wb + W_PP), S2, E2, wave);
            if (l == 0) {
                const int nbusy = (MT / 256 * 4) % G;
                if (S.v >= nbusy) { const int lane = lane_id(); const PIn I = *pin; __syncthreads();
                    conv_weights(lds, ws, I, 1, wave, lane, (S.v - nbusy) * NWAVES + wave, (G - nbusy) * NWAVES, 0, 1 << 30); }
            }
        }
        GRID_BAR(6 * l + 5);
        {
            pg8::RowOrder<DM / 256> S; S.init(G, bid);
            EpiPG E{ws, out, (2 + 2 * l) * MT};
            pg8::gemm_phase<DM, EpiPG, pg8::RowOrder<DM / 256>>(lds, HB, (const bf16*)(wb + W_PG), S, E, wave);
            if (l == 0) {
                const int nbusy = (MT / 256 * 4) % G;
                if (S.v >= nbusy) { const int lane = lane_id(); const PIn I = *pin;
                    conv_p_caches(ws, out, I, 1, (size_t)(S.v - nbusy) * (NWAVES * 64) + wave * 64 + lane, (size_t)(G - nbusy) * (NWAVES * 64), 2); }
            }
        }
        GRID_BAR(6 * l + 6);
    }
#undef GRID_BAR

__global__ void __launch_bounds__(NWAVES * 64, 2) mega_fwd(Args args) {
    extern __shared__ __attribute__((aligned(16))) unsigned char lds_raw[];
    LAS unsigned char* lds = (LAS unsigned char*)lds_raw;
    const int wave = __builtin_amdgcn_readfirstlane((int)threadIdx.x >> 6);
    const int G = gridDim.x, bid = blockIdx.x;
    unsigned char* const ws = args.ws;
    float* const out = args.out;
    float* const H = out + O_Y;

    if (args.ws == nullptr) cg::this_grid().sync();
    {
        const float *x_p = args.in[0], *x_s = args.in[1], *p_p = args.in[2], *p_s = args.in[3], *cak = args.in[4], *cav = args.in[5], *cbk = args.in[6], *cbv = args.in[7],
                    *g_mix = args.in[8], *w_in = args.in[9], *relb = args.in[10], *sinks = args.in[11], *goa = args.in[12], *gob = args.in[13], *w_out = args.in[14],
                    *g_ffn = args.in[15], *w_gu = args.in[16], *w_d = args.in[17], *w_pp = args.in[18], *w_pg = args.in[19], *g_fin = args.in[20];
        float* ssqb = (float*)(ws + WS_SSQ);
        float* rope = (float*)(ws + WS_ROPE);
        float* sm = (float*)(ws + WS_SMALL);
        bf16 *XB = (bf16*)(ws + WS_XB), *PB = (bf16*)(ws + WS_PB);
        const int lane = lane_id(), tid = wave * 64 + lane;
        const int gw = bid * NWAVES + wave, NGW = G * NWAVES;
        const size_t gtid = (size_t)bid * (NWAVES * 64) + tid, gth = (size_t)G * (NWAVES * 64);
        const PIn I{w_in, w_out, w_gu, w_d, w_pp, w_pg, g_mix, g_ffn, p_p, p_s, cak, cav, cbk, cbv};
        conv_weights(lds, ws, I, 0, wave, lane, gw, NGW, 0, W_ITEMS_EARLY);
        for (int m0 = gw; m0 < MT; m0 += 2 * NGW) {
            const int m1 = m0 + NGW; const bool has1 = m1 < MT;
            const float* xr0 = (m0 < MP) ? x_p + (size_t)m0 * DM : x_s + (size_t)(m0 - MP) * DM;
            const float* xr1 = has1 ? ((m1 < MP) ? x_p + (size_t)m1 * DM : x_s + (size_t)(m1 - MP) * DM) : xr0;
            f32x4 a[2][4];
#pragma unroll
            for (int j = 0; j < 2; ++j) { a[0][2 * j] = *(const f32x4*)(xr0 + j * 512 + lane * 8); a[0][2 * j + 1] = *(const f32x4*)(xr0 + j * 512 + lane * 8 + 4);
                                          a[1][2 * j] = *(const f32x4*)(xr1 + j * 512 + lane * 8); a[1][2 * j + 1] = *(const f32x4*)(xr1 + j * 512 + lane * 8 + 4); }
#pragma unroll
            for (int r = 0; r < 2; ++r) {
                const int m = r ? m1 : m0; float ss = 0.f;
#pragma unroll
                for (int j = 0; j < 2; ++j) { const f32x4 p = a[r][2 * j], q = a[r][2 * j + 1];
                    ss += (p[0] * p[0] + p[1] * p[1]) + (p[2] * p[2] + p[3] * p[3]) + (q[0] * q[0] + q[1] * q[1]) + (q[2] * q[2] + q[3] * q[3]);
                    v4u w; w.x = cvt_pk(p[0], p[1]); w.y = cvt_pk(p[2], p[3]); w.z = cvt_pk(q[0], q[1]); w.w = cvt_pk(q[2], q[3]);
                    if (r == 0 || has1) *(v4u*)(XB + (size_t)m * DM + j * 512 + lane * 8) = w; }
#pragma unroll
                for (int o = 1; o < 64; o <<= 1) ss += __shfl_xor(ss, o);
                if (lane == 0 && (r == 0 || has1)) ssqb[m] = ss;
            }
        }
        for (size_t i = gtid; i < (size_t)16384 * 8; i += gth) {
            const int pos = (int)(i >> 3), j = (int)(i & 7);
            const double rv = (j == 0) ? 0.15915494309189535 : (j == 1) ? 0.03086376340470123 : (j == 2) ? 0.005985185712713705 : (j == 3) ? 0.001160663641240061 :
                              (j == 4) ? 0.00022507907903927653 : (j == 5) ? 4.364795279280289e-05 : (j == 6) ? 8.464330808241401e-06 : 1.6414262627950345e-06;
            const double t = (double)pos * rv; const float fr_ = (float)(t - __builtin_floor(t));
            rope[2 * i] = __builtin_amdgcn_cosf(fr_); rope[2 * i + 1] = __builtin_amdgcn_sinf(fr_);
        }
        for (size_t i = gtid; i < (size_t)SM_END; i += gth) {
            float v = 0.f; const int k = (int)i;
            if (k < 2 * 8 * 513) v = relb[k];
            else if (k >= SM_SINK && k < SM_SINK + 16) v = sinks[k - SM_SINK];
            else if (k >= SM_GOA && k < SM_GOB) v = goa[k - SM_GOA];
            else if (k >= SM_GOB && k < SM_GFIN) v = gob[k - SM_GOB];
            else if (k >= SM_GFIN) v = g_fin[k - SM_GFIN];
            sm[k] = v;
        }
        for (size_t i = gtid; i < (size_t)4 * MT; i += gth) ssqb[MT + i] = 0.f;
        if (gtid < 256) ((unsigned*)(ws + WS_CTL))[gtid] = 0u;
    }
    grid_bar((unsigned*)(ws + WS_BAR), 1u, (unsigned)G, (unsigned)bid, wave == 0 && lane_id() == 0);

    const float* const x_p = args.in[0]; const float* const x_s = args.in[1];
    const PIn pin{args.in[9], args.in[14], args.in[16], args.in[17], args.in[18], args.in[19], args.in[8], args.in[15], args.in[2], args.in[3], args.in[4], args.in[5], args.in[6], args.in[7]};
    run_layer<0>(lds, ws, out, x_p, x_s, &pin, G, bid, wave);
    run_layer<1>(lds, ws, out, x_p, x_s, &pin, G, bid, wave);
    {
        const int lane = lane_id();
        const int gw = bid * NWAVES + wave, NGW = G * NWAVES;
        const float* ssq = (const float*)(ws + WS_SSQ) + 4 * (size_t)MT;
        const float* g_fin = (const float*)(ws + WS_SMALL) + SM_GFIN;
        const bf16* XB = (const bf16*)(ws + WS_XB);
        f32x4 gf[2][2];
#pragma unroll
        for (int j = 0; j < 2; ++j) { gf[j][0] = *(const f32x4*)(g_fin + j * 512 + lane * 8); gf[j][1] = *(const f32x4*)(g_fin + j * 512 + lane * 8 + 4); }
        for (int m = gw; m < MT; m += NGW) {
            const float rstd = __builtin_amdgcn_rsqf(ssq[m] * (1.0f / DM) + EPS);
            float* yr = H + (size_t)m * DM;
#pragma unroll
            for (int j = 0; j < 2; ++j) {
                const v4u w = *(const v4u*)(XB + (size_t)m * DM + j * 512 + lane * 8);
                const f32x4 a = (f32x4){bf_lo(w.x), bf_hi(w.x), bf_lo(w.y), bf_hi(w.y)}, b2 = (f32x4){bf_lo(w.z), bf_hi(w.z), bf_lo(w.w), bf_hi(w.w)};
                *(f32x4*)(yr + j * 512 + lane * 8) = a * rstd * gf[j][0]; *(f32x4*)(yr + j * 512 + lane * 8 + 4) = b2 * rstd * gf[j][1];
            }
        }
    }
}

extern "C" void kernel_launch(void* const* d_in, const int* in_sizes, int n_in, void* d_out, int out_size, void* d_ws, size_t ws_size, hipStream_t stream) {
    static int grid = 0;
    if (grid == 0) {
        if (n_in != 21 || (size_t)out_size != O_END || ws_size < WS_END) { fprintf(stderr, "kernel_launch: unexpected problem: n_in %d out %d ws %zu (need out %zu ws %zu)\n", n_in, out_size, ws_size, (size_t)O_END, (size_t)WS_END); grid = -1; return; }
        int dev = 0, cus = 0, per_cu = 0;
        (void)hipGetDevice(&dev);
        (void)hipDeviceGetAttribute(&cus, hipDeviceAttributeMultiprocessorCount, dev);
        if (hipFuncSetAttribute((const void*)mega_fwd, hipFuncAttributeMaxDynamicSharedMemorySize, LDS_BYTES) != hipSuccess) { fprintf(stderr, "kernel_launch: hipFuncSetAttribute failed\n"); grid = -1; return; }
        if (hipOccupancyMaxActiveBlocksPerMultiprocessor(&per_cu, (const void*)mega_fwd, NWAVES * 64, LDS_BYTES) != hipSuccess || per_cu < 1) { fprintf(stderr, "kernel_launch: occupancy query says %d blocks per CU\n", per_cu); (void)hipGetLastError(); per_cu = 1; }
        grid = cus * 1;
        if (grid <= 0) { grid = -1; return; }
    }
    if (grid < 0) return;
    (void)hipMemsetAsync((unsigned char*)d_ws + WS_BAR, 0, 2048, stream);
    Args a{};
    for (int i = 0; i < 21; ++i) a.in[i] = (const float*)d_in[i];
    a.out = (float*)d_out; a.ws = (unsigned char*)d_ws;
    void* kargs[] = {&a};
    hipError_t e = hipLaunchCooperativeKernel((const void*)mega_fwd, dim3(grid), dim3(NWAVES * 64), kargs, LDS_BYTES, stream);
    if (e != hipSuccess) fprintf(stderr, "kernel_launch: cooperative launch failed: %s (grid %d)\n", hipGetErrorString(e), grid);
}
```

```cpp
#include <hip/hip_runtime.h>
#include <hip/hip_cooperative_groups.h>
#include <cstdio>
#include <cstdint>
namespace cg = cooperative_groups;

#define GAS __attribute__((address_space(1)))
#define LAS __attribute__((address_space(3)))
typedef unsigned short bf16;
typedef unsigned v4u __attribute__((ext_vector_type(4)));
typedef unsigned v2u __attribute__((ext_vector_type(2)));
typedef float f32x4 __attribute__((ext_vector_type(4)));
typedef short bf16x8 __attribute__((ext_vector_type(8)));
typedef short s16x4 __attribute__((ext_vector_type(4)));

constexpr int MP = 32768, MS = 1024, MT = MP + MS;
constexpr int DM = 1024, NIN = 2304, FF = 2816, DPLE = 256;
constexpr float EPS = 1e-6f;
constexpr float LOG2E = 1.4426950408889634f;
constexpr float QSCALE = 0.125f * LOG2E;

__device__ __forceinline__ unsigned cvt_pk(float lo, float hi) { unsigned r; asm("v_cvt_pk_bf16_f32 %0, %1, %2" : "=v"(r) : "v"(lo), "v"(hi)); return r; }
__device__ __forceinline__ float bf_lo(unsigned w) { return __builtin_bit_cast(float, w << 16); }
__device__ __forceinline__ float bf_hi(unsigned w) { return __builtin_bit_cast(float, w & 0xffff0000u); }
__device__ __forceinline__ float fexp2(float x) { return __builtin_amdgcn_exp2f(x); }
__device__ __forceinline__ float frcp(float x) { return __builtin_amdgcn_rcpf(x); }

__device__ __forceinline__ int lane_id() { int l = __builtin_amdgcn_mbcnt_hi(~0u, __builtin_amdgcn_mbcnt_lo(~0u, 0u)); asm volatile("" : "+v"(l)); return l; }

namespace pg8 {
constexpr int BM = 256, BK = 64, HALF = 128, HTB = HALF * BK * 2, STAGE_BYTES = 8 * HTB, NXCD = 8, WGM = 8;
__host__ __device__ __forceinline__ int lds_byte(int r, int c) { const int st = (r >> 4) * 2 + (c >> 5), rr = r & 15, cc = c & 31, ob = rr * 64 + cc * 2; return st * 1024 + (ob ^ (((ob >> 9) & 1) << 5)); }
__host__ __device__ __forceinline__ void stage_rc(int b, int& R, int& C) { const int st = b / 1024, sb = b % 1024, swz = sb ^ (((sb >> 9) & 1) << 5); R = (st >> 1) * 16 + swz / 64; C = (st & 1) * 32 + (swz % 64) / 2; }
__host__ __device__ __forceinline__ int perm32(int rho) { const int n = rho >> 4, i = rho & 15; return 8 * (i >> 2) + 4 * n + (i & 3); }

struct Unit { int pm, pn; };
struct Gemm { const bf16* A; const bf16* Bt; int M, N, K; };

template <int NN>
struct RowOrder {
    int G, v;
    __device__ __forceinline__ void init(int G_, int c) { G = G_; v = (G_ % 8 == 0) ? (c % 8) * (G_ / 8) + c / 8 : c; }
    __device__ __forceinline__ bool next(int i, Unit& u) const {
        const int L = i * G + v; if (L >= (33792 / BM) * NN) return false;
        constexpr int NM = 33792 / BM, NFULL = (NM / 8) * 8 * NN;
        if (L < NFULL) { const int g = L / (8 * NN), idx = L % (8 * NN); u.pm = g * 8 + (idx & 7); u.pn = idx >> 3; }
        else { constexpr int GS = NM % 8 ? NM % 8 : 8; const int idx = L - NFULL; u.pm = (NM / 8) * 8 + idx % GS; u.pn = idx / GS; }
        return true;
    }
};

template <int KK, class Epi, class Sched, bool ALIGN_EPI = true>
__device__ __forceinline__ void gemm_phase(LAS unsigned char* lds, const bf16* gA, const bf16* gBt, const Sched& S, const Epi& E, const int wid) {
    const int lane = lane_id();
    const int tid = wid * 64 + lane, wr = wid >> 2, wc = wid & 3, fr = lane & 15, fq = lane >> 4;
    constexpr int K = KK, nt = K / BK;
    unsigned voffA[2], voffB[2];
#pragma unroll
    for (int i = 0; i < 2; ++i) { int R, C; stage_rc(tid * 16 + i * 8192, R, C); const int Rb = Epi::PERM ? ((R & ~31) + perm32(R & 31)) : R;
        voffA[i] = (unsigned)(R * K + C) * 2u; voffB[i] = (unsigned)(Rb * K + C) * 2u; }
    const size_t kstep = (size_t)(BK * 2);
    const size_t hstep = (size_t)HALF * K * 2;
    const size_t tstep = 2 * hstep;
    const unsigned ldsw = (unsigned)wid * 1024u;
    const int aoff = lds_byte(wr * 64 + fr, fq * 8), boff = lds_byte(wc * 32 + fr, fq * 8);
#define PG8_SA(b, h) (((b) * 2 + (h)) * HTB)
#define PG8_SB(b, h) ((4 + (b) * 2 + (h)) * HTB)
#define PG8_STAGE(bufoff, gbase, voff) do { _Pragma("unroll") for (int _i = 0; _i < 2; ++_i) \
        __builtin_amdgcn_global_load_lds((const unsigned*)((const char*)(gbase) + (voff)[_i]), (LAS unsigned*)(lds + (bufoff) + ldsw + _i * 8192), 16, 0, 0); } while (0)
#define PG8_LDA(dst, b, h) do { _Pragma("unroll") for (int m = 0; m < 4; ++m) _Pragma("unroll") for (int k = 0; k < 2; ++k) dst[m][k] = *(const LAS bf16x8*)(lds + PG8_SA(b, h) + aoff + m * 2048 + k * 1024); } while (0)
#define PG8_LDB(dst, b, h) do { _Pragma("unroll") for (int n = 0; n < 2; ++n) _Pragma("unroll") for (int k = 0; k < 2; ++k) dst[n][k] = *(const LAS bf16x8*)(lds + PG8_SB(b, h) + boff + n * 2048 + k * 1024); } while (0)
#define PG8_MMA(ai, bj, At, Bt) do { __builtin_amdgcn_s_setprio(1); _Pragma("unroll") for (int m = 0; m < 4; ++m) _Pragma("unroll") for (int n = 0; n < 2; ++n) _Pragma("unroll") for (int k = 0; k < 2; ++k) \
        acc[ai][bj][m][n] = __builtin_amdgcn_mfma_f32_16x16x32_bf16(Bt[n][k], At[m][k], acc[ai][bj][m][n], 0, 0, 0); __builtin_amdgcn_s_setprio(0); } while (0)
#define PG8_WAIT_V(n) asm volatile("s_waitcnt vmcnt(" #n ")" ::: "memory")
#define PG8_WAIT_L(n) asm volatile("s_waitcnt lgkmcnt(" #n ")" ::: "memory")
#define PG8_BAR __builtin_amdgcn_s_barrier()
#define PG8_SCHED __builtin_amdgcn_sched_barrier(0)
    Unit cur, nxt; int ui = 0;
    if (!S.next(0, cur)) return;
    f32x4 acc[2][2][4][2];
#pragma unroll
    for (int a = 0; a < 2; ++a)
#pragma unroll
        for (int b = 0; b < 2; ++b)
#pragma unroll
            for (int m = 0; m < 4; ++m)
#pragma unroll
                for (int n = 0; n < 2; ++n) acc[a][b][m][n] = (f32x4){0.f, 0.f, 0.f, 0.f};
    bf16x8 At[4][2], B0[2][2], B1[2][2];
    const char* cA = (const char*)gA + (size_t)cur.pm * tstep; const char* cB = (const char*)gBt + (size_t)cur.pn * tstep;
    PG8_STAGE(PG8_SB(0, 0), cB, voffB); PG8_STAGE(PG8_SB(0, 1), cB + hstep, voffB); PG8_STAGE(PG8_SA(0, 0), cA, voffA); PG8_STAGE(PG8_SA(0, 1), cA + hstep, voffA);
    PG8_STAGE(PG8_SB(1, 0), cB + kstep, voffB); PG8_STAGE(PG8_SA(1, 0), cA + kstep, voffA); PG8_STAGE(PG8_SB(1, 1), cB + hstep + kstep, voffB);
    if (wr == 1) PG8_BAR;
    PG8_WAIT_V(8); PG8_BAR;
    PG8_WAIT_V(6); PG8_BAR;
    for (;;) {
        const bool has_next = S.next(ui + 1, nxt);
        const char* nA = has_next ? (const char*)gA + (size_t)nxt.pm * tstep : cA; const char* nB = has_next ? (const char*)gBt + (size_t)nxt.pn * tstep : cB;
#pragma unroll 1
        for (int t = 0; t < nt; t += 2) {
            const bool last = (t == nt - 2);
            const char* a1 = cA + (size_t)(t + 1) * kstep;
            const char* a2 = last ? nA : cA + (size_t)(t + 2) * kstep; const char* b2 = last ? nB : cB + (size_t)(t + 2) * kstep;
            const char* a3 = a2 + kstep; const char* b3 = b2 + kstep;
            PG8_LDB(B0, 0, 0); PG8_LDB(B1, 0, 1); PG8_SCHED; PG8_LDA(At, 0, 0); PG8_STAGE(PG8_SA(1, 1), a1 + hstep, voffA);
            PG8_WAIT_V(8); PG8_WAIT_L(0); PG8_BAR; PG8_MMA(0, 0, At, B0); PG8_MMA(0, 1, At, B1); PG8_BAR; PG8_SCHED;
            PG8_LDA(At, 0, 1); PG8_STAGE(PG8_SB(0, 0), b2, voffB); PG8_STAGE(PG8_SB(0, 1), b2 + hstep, voffB); PG8_STAGE(PG8_SA(0, 0), a2, voffA);
            PG8_WAIT_V(8); PG8_WAIT_L(0); PG8_BAR; PG8_MMA(1, 0, At, B0); PG8_MMA(1, 1, At, B1); PG8_BAR; PG8_SCHED;
            PG8_LDB(B0, 1, 0); PG8_LDB(B1, 1, 1); PG8_SCHED; PG8_LDA(At, 1, 0); PG8_STAGE(PG8_SA(0, 1), a2 + hstep, voffA);
            PG8_WAIT_V(8); PG8_WAIT_L(0); PG8_BAR; PG8_MMA(0, 0, At, B0); PG8_MMA(0, 1, At, B1); PG8_BAR; PG8_SCHED;
            PG8_LDA(At, 1, 1); PG8_STAGE(PG8_SB(1, 0), b3, voffB); PG8_STAGE(PG8_SB(1, 1), b3 + hstep, voffB); PG8_STAGE(PG8_SA(1, 0), a3, voffA);
            PG8_WAIT_V(8); PG8_WAIT_L(0); PG8_BAR; PG8_MMA(1, 0, At, B0); PG8_MMA(1, 1, At, B1); PG8_BAR; PG8_SCHED;
        }
        if constexpr (ALIGN_EPI) { if (wr == 0) PG8_BAR; }
        E(acc, cur, wr, wc, fr, fq);
        if (!has_next) break;
#pragma unroll
        for (int a = 0; a < 2; ++a)
#pragma unroll
            for (int b = 0; b < 2; ++b)
#pragma unroll
                for (int m = 0; m < 4; ++m)
#pragma unroll
                    for (int n = 0; n < 2; ++n) acc[a][b][m][n] = (f32x4){0.f, 0.f, 0.f, 0.f};
        cur = nxt; cA = nA; cB = nB; ++ui;
        if constexpr (ALIGN_EPI) { if (wr == 1) PG8_BAR; }
    }
    PG8_WAIT_V(0);
    if constexpr (!ALIGN_EPI) { if (wr == 0) PG8_BAR; }
    PG8_BAR;
#undef PG8_SA
#undef PG8_SB
#undef PG8_STAGE
#undef PG8_LDA
#undef PG8_LDB
#undef PG8_MMA
#undef PG8_WAIT_V
#undef PG8_WAIT_L
#undef PG8_BAR
#undef PG8_SCHED
}
}

constexpr size_t MiB = 1u << 20;
constexpr size_t WS_CTL = 0;
constexpr size_t WS_SSQ = 4096;
constexpr size_t WS_ROPE = 1 * MiB;
constexpr size_t WS_W = 2 * MiB;
constexpr size_t W_IN = 0, W_OUT = W_IN + (size_t)NIN * DM * 2, W_GU = W_OUT + (size_t)DM * DM * 2, W_D = W_GU + (size_t)2 * FF * DM * 2,
                 W_PP = W_D + (size_t)DM * FF * 2, W_PG = W_PP + (size_t)DM * DPLE * 2, W_LAYER = W_PG + (size_t)DM * DM * 2;
constexpr size_t WS_XB = WS_W + 2 * W_LAYER + MiB;
constexpr size_t ACT_DM = (size_t)MT * DM * 2;
constexpr size_t WS_HB = WS_XB + ACT_DM;
constexpr size_t WS_Z = WS_HB + ACT_DM;
constexpr size_t WS_O = WS_Z + (size_t)MT * NIN * 2;
constexpr size_t WS_ACT = WS_Z;
constexpr size_t WS_PB = WS_O + ACT_DM;
constexpr size_t WS_CKA = WS_PB + (size_t)2 * MT * DPLE * 2;
constexpr size_t CA_BYTES = (size_t)2 * 16 * 512 * 512 * 2, CB_BYTES = (size_t)2 * 16 * 128 * 128 * 2;
constexpr size_t WS_CVA = WS_CKA + CA_BYTES, WS_CKB = WS_CVA + CA_BYTES, WS_CVB = WS_CKB + CB_BYTES, WS_END = WS_CVB + CB_BYTES;
static_assert((size_t)MT * FF * 2 <= (size_t)MT * NIN * 2 + ACT_DM, "ACT overlay fits Z|O");
static_assert(WS_END <= 512 * MiB, "workspace map");

constexpr size_t O_Y = 0, O_AKP = (size_t)MT * DM, O_AVP = O_AKP + 2 * 2 * 512 * 512, O_BKP = O_AVP + 2 * 2 * 512 * 512, O_BVP = O_BKP + 2 * 2 * 128 * 128,
                 O_AKS = O_BVP + 2 * 2 * 128 * 128, O_AVS = O_AKS + (size_t)2 * 16 * 512 * 512, O_BKS = O_AVS + (size_t)2 * 16 * 512 * 512, O_BVS = O_BKS + 2 * 16 * 128 * 128,
                 O_END = O_BVS + 2 * 16 * 128 * 128;

constexpr int LDS_BYTES = 131072 + 4096;
constexpr int W_ITEMS_EARLY = (DM / 64) * (NIN / 32) + (DM / 64) * (DM / 32);
constexpr int NWAVES = 8;

typedef const f32x4 (&AccRef)[2][2][4][2];

struct EpiIn {
    static constexpr bool PERM = true;
    unsigned char* ws_; float* out_; int ssq_off; int l;
    __device__ __forceinline__ void operator()(AccRef acc, const pg8::Unit& u, int wr, int wc, int, int) const {
        GAS unsigned char* wsg_ = (GAS unsigned char*)ws_; GAS float* outg_ = (GAS float*)out_; asm volatile("" : "+s"(wsg_), "+s"(outg_)); unsigned char* ws = (unsigned char*)wsg_; float* out = (float*)outg_;
        const int lane_ = lane_id(); const int fr = lane_ & 15, fq = lane_ >> 4;
        const float* ssq = (const float*)(ws + WS_SSQ) + ssq_off;
        const int pn = u.pn, pm = u.pm;
        const bool samp = pm >= (MP / 256);
        const bool isq = (pn < 2) || (pn == 6) || (pn == 7);
        bf16* Z = (bf16*)(ws + WS_Z); const float* rope = (const float*)(ws + WS_ROPE);
        const bool wrA = (pn >= 2 && pn <= 5) && (samp || (pm & 63) >= 62);
        const bool wrB = (pn == 8) && (samp || (pm & 63) == 63);
        float sq[2][4];
#pragma unroll
        for (int ai = 0; ai < 2; ++ai)
#pragma unroll
            for (int m = 0; m < 4; ++m) sq[ai][m] = ssq[pm * 256 + ai * 128 + wr * 64 + m * 16 + fr];
        asm volatile("" ::: "memory");
#pragma unroll
        for (int ai = 0; ai < 2; ++ai)
#pragma unroll
            for (int m = 0; m < 4; ++m) {
                const int row = pm * 256 + ai * 128 + wr * 64 + m * 16 + fr;
                const float rstd = __builtin_amdgcn_rsqf(sq[ai][m] * (1.0f / DM) + EPS) * (isq ? QSCALE : 1.0f);
                const int pos = samp ? 2048 + ((row - MP) & 63) : (row & 16383);
#pragma unroll
                for (int bj = 0; bj < 2; ++bj) {
                    const int c0 = pn * 256 + bj * 128 + wc * 32 + 8 * fq;
                    float v[8];
#pragma unroll
                    for (int j = 0; j < 4; ++j) { v[j] = acc[ai][bj][m][0][j] * rstd; v[4 + j] = acc[ai][bj][m][1][j] * rstd; }
                    const bool ropet = (pn == 6 || pn == 7 || (pn == 8 && bj == 0)) && ((wc & 1) == 0);
                    if (ropet) {
                        float pv[8];
#pragma unroll
                        for (int j = 0; j < 8; ++j) pv[j] = __shfl_xor(v[j], 16);
                        if (fq < 2) {
                            const f32x4* cs = (const f32x4*)(rope + (size_t)pos * 16);
                            const float sg = (fq == 0) ? -1.f : 1.f;
#pragma unroll
                            for (int jj = 0; jj < 4; ++jj) { const f32x4 t = cs[jj];
                                v[2 * jj] = v[2 * jj] * t[0] + sg * pv[2 * jj] * t[1];
                                v[2 * jj + 1] = v[2 * jj + 1] * t[2] + sg * pv[2 * jj + 1] * t[3]; }
                        }
                    }
                    v4u w; w.x = cvt_pk(v[0], v[1]); w.y = cvt_pk(v[2], v[3]); w.z = cvt_pk(v[4], v[5]); w.w = cvt_pk(v[6], v[7]);
                    *(v4u*)(Z + (size_t)row * NIN + c0) = w;
                    if (wrA) {
                        const int colA = c0 - (pn < 4 ? 512 : 1024);
                        float* dst;
                        if (samp) { const int rs = row - MP; dst = out + (pn < 4 ? O_AKS : O_AVS) + (size_t)l * 16 * 512 * 512 + ((size_t)((rs >> 6) * 512 + 448 + (rs & 63))) * 512 + colA; }
                        else { const int sq = (row & 16383) - 15872; dst = out + (pn < 4 ? O_AKP : O_AVP) + (size_t)l * 2 * 512 * 512 + ((size_t)((row >> 14) * 512 + sq)) * 512 + colA; }
                        *(f32x4*)dst = (f32x4){v[0], v[1], v[2], v[3]}; *(f32x4*)(dst + 4) = (f32x4){v[4], v[5], v[6], v[7]};
                    }
                    if (wrB && (samp || ai == 1)) {
                        const int colB = c0 - (bj == 0 ? 2048 : 2176);
                        float* dst;
                        if (samp) { const int rs = row - MP; dst = out + (bj == 0 ? O_BKS : O_BVS) + (size_t)l * 16 * 128 * 128 + ((size_t)((rs >> 6) * 128 + 64 + (rs & 63))) * 128 + colB; }
                        else { const int sq = (row & 16383) - 16256; dst = out + (bj == 0 ? O_BKP : O_BVP) + (size_t)l * 2 * 128 * 128 + ((size_t)((row >> 14) * 128 + sq)) * 128 + colB; }
                        *(f32x4*)dst = (f32x4){v[0], v[1], v[2], v[3]}; *(f32x4*)(dst + 4) = (f32x4){v[4], v[5], v[6], v[7]};
                    }
                }
            }
    }
};

#define EPI_ENTRY() GAS unsigned char* wsg_ = (GAS unsigned char*)ws_; GAS float* outg_ = (GAS float*)out_; asm volatile("" : "+s"(wsg_), "+s"(outg_)); unsigned char* ws = (unsigned char*)wsg_; float* out = (float*)outg_; const int lane_ = lane_id(); const int fr = lane_ & 15, fq = lane_ >> 4; (void)ws; (void)out

struct EpiRes {
    static constexpr bool PERM = true;
    unsigned char* ws_; float* out_; const float *xp, *xs; int from_xb; int ssq_off;
    __device__ __forceinline__ void operator()(AccRef acc, const pg8::Unit& u, int wr, int wc, int, int) const {
        EPI_ENTRY();
        bf16* HB = (bf16*)(ws + WS_HB); const bf16* RB = (const bf16*)(ws + (from_xb ? WS_XB : WS_HB)); float* ssq = (float*)(ws + WS_SSQ) + ssq_off;
#pragma unroll
        for (int ai = 0; ai < 2; ++ai) {
            f32x4 r0[4][2], r1[4][2];
            if (xp) {
#pragma unroll
                for (int m = 0; m < 4; ++m) { const int row = u.pm * 256 + ai * 128 + wr * 64 + m * 16 + fr;
                    const float* rsrc = (row < MP) ? xp + (size_t)row * DM : xs + (size_t)(row - MP) * DM;
#pragma unroll
                    for (int bj = 0; bj < 2; ++bj) { const int c0 = u.pn * 256 + bj * 128 + wc * 32 + 8 * fq; r0[m][bj] = *(const f32x4*)(rsrc + c0); r1[m][bj] = *(const f32x4*)(rsrc + c0 + 4); } }
            } else {
                v4u pw[4][2];
#pragma unroll
                for (int m = 0; m < 4; ++m) { const int row = u.pm * 256 + ai * 128 + wr * 64 + m * 16 + fr;
#pragma unroll
                    for (int bj = 0; bj < 2; ++bj) pw[m][bj] = *(const v4u*)(RB + (size_t)row * DM + u.pn * 256 + bj * 128 + wc * 32 + 8 * fq); }
#pragma unroll
                for (int m = 0; m < 4; ++m)
#pragma unroll
                    for (int bj = 0; bj < 2; ++bj) { const v4u w = pw[m][bj]; r0[m][bj] = (f32x4){bf_lo(w.x), bf_hi(w.x), bf_lo(w.y), bf_hi(w.y)}; r1[m][bj] = (f32x4){bf_lo(w.z), bf_hi(w.z), bf_lo(w.w), bf_hi(w.w)}; }
            }
            asm volatile("" ::: "memory");
#pragma unroll
            for (int m = 0; m < 4; ++m) {
                const int row = u.pm * 256 + ai * 128 + wr * 64 + m * 16 + fr;
                float ss = 0.f;
#pragma unroll
                for (int bj = 0; bj < 2; ++bj) {
                    const int c0 = u.pn * 256 + bj * 128 + wc * 32 + 8 * fq;
                    const f32x4 o0 = r0[m][bj] + acc[ai][bj][m][0], o1 = r1[m][bj] + acc[ai][bj][m][1];
                    v4u w; w.x = cvt_pk(o0[0], o0[1]); w.y = cvt_pk(o0[2], o0[3]); w.z = cvt_pk(o1[0], o1[1]); w.w = cvt_pk(o1[2], o1[3]);
                    *(v4u*)(HB + (size_t)row * DM + c0) = w;
                    ss += (o0[0] * o0[0] + o0[1] * o0[1]) + (o0[2] * o0[2] + o0[3] * o0[3]) + (o1[0] * o1[0] + o1[1] * o1[1]) + (o1[2] * o1[2] + o1[3] * o1[3]);
                }
                if (ssq_off >= 0) { ss += __shfl_xor(ss, 16); ss += __shfl_xor(ss, 32); if (fq == 0) __hip_atomic_fetch_add(ssq + row, ss, __ATOMIC_RELAXED, __HIP_MEMORY_SCOPE_AGENT); }
            }
        }
    }
};

typedef float f32x2 __attribute__((ext_vector_type(2)));
struct EpiGU {
    static constexpr bool PERM = true;
    unsigned char* ws_; float* out_; int ssq_off;
    __device__ __forceinline__ void operator()(AccRef acc, const pg8::Unit& u, int wr, int wc, int, int) const {
        EPI_ENTRY();
        bf16* ACT = (bf16*)(ws + WS_ACT); const float* ssq = (const float*)(ws + WS_SSQ) + ssq_off;
        float sq[2][4];
#pragma unroll
        for (int ai = 0; ai < 2; ++ai)
#pragma unroll
            for (int m = 0; m < 4; ++m) sq[ai][m] = ssq[u.pm * 256 + ai * 128 + wr * 64 + m * 16 + fr];
        asm volatile("" ::: "memory");
#pragma unroll
        for (int ai = 0; ai < 2; ++ai)
#pragma unroll
            for (int m = 0; m < 4; ++m) {
                const int row = u.pm * 256 + ai * 128 + wr * 64 + m * 16 + fr;
                const float rstd = __builtin_amdgcn_rsqf(sq[ai][m] * (1.0f / DM) + EPS);
                const float rc = -rstd * LOG2E, r2 = rstd * rstd;
                unsigned pk[4];
#pragma unroll
                for (int n = 0; n < 2; ++n)
#pragma unroll
                    for (int h = 0; h < 2; ++h) {
                        const f32x2 g2 = {acc[ai][0][m][n][2 * h], acc[ai][0][m][n][2 * h + 1]}, u2 = {acc[ai][1][m][n][2 * h], acc[ai][1][m][n][2 * h + 1]};
                        const f32x2 x2 = g2 * rc; f32x2 d2; d2.x = fexp2(x2.x); d2.y = fexp2(x2.y); d2 = d2 + 1.0f;
                        f32x2 q2; q2.x = frcp(d2.x); q2.y = frcp(d2.y);
                        const f32x2 t2 = (g2 * u2) * r2 * q2;
                        pk[2 * n + h] = cvt_pk(t2.x, t2.y);
                    }
                v4u w; w.x = pk[0]; w.y = pk[1]; w.z = pk[2]; w.w = pk[3];
                *(v4u*)(ACT + (size_t)row * FF + u.pn * 128 + wc * 32 + 8 * fq) = w;
            }
    }
};

struct EpiPP {
    static constexpr bool PERM = true;
    unsigned char* ws_; float* out_;
    __device__ __forceinline__ void operator()(AccRef acc, const pg8::Unit& u, int wr, int wc, int, int) const {
        EPI_ENTRY();
        bf16* PP = (bf16*)(ws + WS_XB);
#pragma unroll
        for (int ai = 0; ai < 2; ++ai)
#pragma unroll
            for (int m = 0; m < 4; ++m) {
                const int row = u.pm * 256 + ai * 128 + wr * 64 + m * 16 + fr;
#pragma unroll
                for (int bj = 0; bj < 2; ++bj) {
                    const int c0 = u.pn * 256 + bj * 128 + wc * 32 + 8 * fq;
                    const f32x4 o0 = acc[ai][bj][m][0], o1 = acc[ai][bj][m][1];
                    v4u w; w.x = cvt_pk(o0[0], o0[1]); w.y = cvt_pk(o0[2], o0[3]); w.z = cvt_pk(o1[0], o1[1]); w.w = cvt_pk(o1[2], o1[3]);
                    *(v4u*)(PP + (size_t)row * DM + c0) = w;
                }
            }
    }
};

struct EpiPG {
    static constexpr bool PERM = true;
    unsigned char* ws_; float* out_; int ssq_off;
    __device__ __forceinline__ void operator()(AccRef acc, const pg8::Unit& u, int wr, int wc, int, int) const {
        EPI_ENTRY();
        const bf16* HB = (const bf16*)(ws + WS_HB); bf16* XB = (bf16*)(ws + WS_XB); float* ssq = (float*)(ws + WS_SSQ) + ssq_off;
#pragma unroll
        for (int ai = 0; ai < 2; ++ai) {
            v4u hwv[4][2], pwv[4][2];
#pragma unroll
            for (int m = 0; m < 4; ++m) { const int row = u.pm * 256 + ai * 128 + wr * 64 + m * 16 + fr;
#pragma unroll
                for (int bj = 0; bj < 2; ++bj) { const size_t off = (size_t)row * DM + u.pn * 256 + bj * 128 + wc * 32 + 8 * fq; hwv[m][bj] = *(const v4u*)(HB + off); pwv[m][bj] = *(const v4u*)(XB + off); } }
            asm volatile("" ::: "memory");
#pragma unroll
            for (int m = 0; m < 4; ++m) {
                const int row = u.pm * 256 + ai * 128 + wr * 64 + m * 16 + fr;
                float ss = 0.f;
#pragma unroll
                for (int bj = 0; bj < 2; ++bj) {
                    const int c0 = u.pn * 256 + bj * 128 + wc * 32 + 8 * fq;
                    const v4u hw = hwv[m][bj], pw = pwv[m][bj];
                    const float hh[8] = {bf_lo(hw.x), bf_hi(hw.x), bf_lo(hw.y), bf_hi(hw.y), bf_lo(hw.z), bf_hi(hw.z), bf_lo(hw.w), bf_hi(hw.w)};
                    const float pp[8] = {bf_lo(pw.x), bf_hi(pw.x), bf_lo(pw.y), bf_hi(pw.y), bf_lo(pw.z), bf_hi(pw.z), bf_lo(pw.w), bf_hi(pw.w)};
                    float o[8];
#pragma unroll
                    for (int j = 0; j < 4; ++j) {
                        o[j] = hh[j] + pp[j] * frcp(1.0f + fexp2(-acc[ai][bj][m][0][j] * LOG2E));
                        o[4 + j] = hh[4 + j] + pp[4 + j] * frcp(1.0f + fexp2(-acc[ai][bj][m][1][j] * LOG2E));
                    }
                    v4u w; w.x = cvt_pk(o[0], o[1]); w.y = cvt_pk(o[2], o[3]); w.z = cvt_pk(o[4], o[5]); w.w = cvt_pk(o[6], o[7]);
                    *(v4u*)(XB + (size_t)row * DM + c0) = w;
#pragma unroll
                    for (int j = 0; j < 8; ++j) ss += o[j] * o[j];
                }
                ss += __shfl_xor(ss, 16); ss += __shfl_xor(ss, 32);
                if (fq == 0) __hip_atomic_fetch_add(ssq + row, ss, __ATOMIC_RELAXED, __HIP_MEMORY_SCOPE_AGENT);
            }
        }
    }
};

template <bool GU>
__device__ __forceinline__ void transpose_item(const float* W, int K, int N, bf16* WT, const float* gs, LAS float* scr, int item, int lane) {
    const int nblk = N / 32, kb = item / nblk, nb = item % nblk, k0 = 64 * kb, n0 = 32 * nb;
#pragma unroll 16
    for (int i = 0; i < 32; ++i) { const int kk = 2 * i + (lane >> 5); float w = W[(size_t)(k0 + kk) * N + n0 + (lane & 31)]; if (gs) w *= gs[k0 + kk]; scr[kk * 33 + (lane & 31)] = w; }
    asm volatile("s_waitcnt lgkmcnt(0)" ::: "memory");
    int d0 = n0;
    if (GU) { const int f = (n0 < FF) ? n0 : n0 - FF; d0 = 256 * (f >> 7) + (f & 127) + ((n0 < FF) ? 0 : 128); }
    const int c = lane & 7;
#pragma unroll
    for (int j = 0; j < 4; ++j) { const int n = (lane >> 3) + 8 * j; const LAS float* s = scr + (8 * c) * 33 + n;
        v4u o; o.x = cvt_pk(s[0 * 33], s[1 * 33]); o.y = cvt_pk(s[2 * 33], s[3 * 33]); o.z = cvt_pk(s[4 * 33], s[5 * 33]); o.w = cvt_pk(s[6 * 33], s[7 * 33]);
        *(v4u*)(WT + (size_t)(d0 + n) * K + k0 + 8 * c) = o; }
    asm volatile("s_waitcnt lgkmcnt(0)" ::: "memory");
}

__device__ __forceinline__ void convert_flat(const float* src, bf16* dst, size_t n, size_t gtid, size_t gthreads) {
    for (size_t i = gtid * 8; i < n; i += gthreads * 8) {
        const f32x4 a = *(const f32x4*)(src + i), b = *(const f32x4*)(src + i + 4);
        v4u w; w.x = cvt_pk(a[0], a[1]); w.y = cvt_pk(a[2], a[3]); w.z = cvt_pk(b[0], b[1]); w.w = cvt_pk(b[2], b[3]);
        *(v4u*)(dst + i) = w;
    }
}

constexpr float ATT_THR = 6.0f;
constexpr int AL_V = 0, AL_EXT = 65536, AL_RED = AL_EXT + 26624, AL_UNIT = AL_RED + 2048;
struct AttnArgs { const bf16 *Z, *CKA, *CVA, *CKB, *CVB; const float *sinks, *goa, *gob; bf16* O; unsigned* ctr; };

template <bool ISA>
__device__ __forceinline__ void attn_unit(LAS unsigned char* lds, const AttnArgs& T, int sc, int wave, int) {
    const int lane = lane_id();
    const int fr = lane & 15, fq = lane >> 4;
    const bool samp = sc >= 512;
    const int b = samp ? sc - 512 : sc >> 8, c = samp ? 255 : (sc & 255);
    const int row0 = samp ? MP + b * 64 : b * 16384 + c * 64;
    constexpr int NPREV = ISA ? 8 : 2;
    const int kc0 = (NPREV - c) > 0 ? (NPREV - c) : 0;
    const int hd = wave, kv = wave >> 2;
    const int qcol = ISA ? hd * 64 : 1536 + hd * 64;
    LAS unsigned char* vst = lds + AL_V + wave * 8192;
    const LAS float* ext = (const LAS float*)(lds + AL_EXT) + hd * 832;
    LAS float* red = (LAS float*)(lds + AL_RED);

    bf16x8 qf[4][2];
#pragma unroll
    for (int qb = 0; qb < 4; ++qb)
#pragma unroll
        for (int ks = 0; ks < 2; ++ks) qf[qb][ks] = *(const bf16x8*)((const char*)(T.Z + (size_t)(row0 + 16 * qb) * NIN + qcol + 32 * ks) + (unsigned)((fr * NIN + 8 * fq) * 2));
    f32x4 o[4][4];
#pragma unroll
    for (int db = 0; db < 4; ++db)
#pragma unroll
        for (int qb = 0; qb < 4; ++qb) o[db][qb] = (f32x4){0.f, 0.f, 0.f, 0.f};
    const float sink2 = ISA ? 0.f : T.sinks[hd] * LOG2E;
    float mrow[4], lrow[4];
#pragma unroll
    for (int qb = 0; qb < 4; ++qb) { mrow[qb] = ISA ? -1e30f : sink2; lrow[qb] = 0.f; }

#define ATT_TILE_PTRS(KC, KP, VP, PITCH) do { \
        if (samp && (KC) < NPREV) { \
            if (ISA) { const size_t off_ = ((size_t)(b * 512 + (KC) * 64)) * 512 + hd * 64; KP = T.CKA + off_; VP = T.CVA + off_; PITCH = 512; } \
            else { const size_t off_ = ((size_t)(b * 128 + (KC) * 64)) * 128 + kv * 64; KP = T.CKB + off_; VP = T.CVB + off_; PITCH = 128; } \
        } else { \
            const size_t r_ = (size_t)(row0 - (NPREV - (KC)) * 64) * NIN; \
            KP = T.Z + r_ + (ISA ? 512 + hd * 64 : 2048 + kv * 64); VP = T.Z + r_ + (ISA ? 1024 + hd * 64 : 2176 + kv * 64); PITCH = NIN; \
        } } while (0)
#define ATT_LOAD_K(KP, PITCH) do { _Pragma("unroll") for (int kb = 0; kb < 4; ++kb) { \
        const char* kr_ = (const char*)((KP) + (size_t)(16 * kb) * (PITCH)) + (unsigned)((fr * (PITCH) + 8 * fq) * 2); kf[kb][0] = *(const bf16x8*)kr_; kf[kb][1] = *(const bf16x8*)(kr_ + 64); } } while (0)
    bf16x8 kf[4][2];
    { const bf16 *kp0, *vp0; int pitch0; ATT_TILE_PTRS(kc0, kp0, vp0, pitch0); (void)vp0; ATT_LOAD_K(kp0, pitch0); }
    for (int kc = kc0; kc <= NPREV; ++kc) {
        const bf16 *kp, *vp; int pitch;
        ATT_TILE_PTRS(kc, kp, vp, pitch); (void)kp;
        {
            const unsigned voff = (unsigned)(((lane >> 3) * pitch + (((lane & 7) ^ ((lane >> 3) & 6)) * 8)) * 2);
#pragma unroll
            for (int i = 0; i < 8; ++i)
                __builtin_amdgcn_global_load_lds((const unsigned*)((const char*)(vp + (size_t)(8 * i) * pitch) + voff), (LAS unsigned*)(vst + i * 1024), 16, 0, 0);
        }
        bf16x8 pf[4][2];
#pragma unroll
        for (int qh = 0; qh < 2; ++qh) {
            f32x4 s[4][2];
            const LAS float* eb = ext + (768 + 32 * qh + fr - 64 * kc - 4 * fq);
#pragma unroll
            for (int kb = 0; kb < 4; ++kb)
#pragma unroll
                for (int q2 = 0; q2 < 2; ++q2) {
                    f32x4 c0 = (f32x4){0.f, 0.f, 0.f, 0.f};
                    if (ISA) { const LAS float* e = eb + (16 * q2 - 16 * kb); c0 = (f32x4){e[0], e[-1], e[-2], e[-3]}; }
                    f32x4 t = __builtin_amdgcn_mfma_f32_16x16x32_bf16(kf[kb][0], qf[2 * qh + q2][0], c0, 0, 0, 0);
                    s[kb][q2] = __builtin_amdgcn_mfma_f32_16x16x32_bf16(kf[kb][1], qf[2 * qh + q2][1], t, 0, 0, 0);
                }
            if (qh == 1) { const int kn = kc < NPREV ? kc + 1 : kc; const bf16 *kpn, *vpn; int pitchn; ATT_TILE_PTRS(kn, kpn, vpn, pitchn); (void)vpn; ATT_LOAD_K(kpn, pitchn); }
#pragma unroll
            for (int q2 = 0; q2 < 2; ++q2) {
                const int qb = 2 * qh + q2;
                float mx = fmaxf(fmaxf(s[0][q2][0], s[0][q2][1]), s[0][q2][2]);
                mx = fmaxf(fmaxf(mx, s[0][q2][3]), s[1][q2][0]); mx = fmaxf(fmaxf(mx, s[1][q2][1]), s[1][q2][2]); mx = fmaxf(fmaxf(mx, s[1][q2][3]), s[2][q2][0]);
                mx = fmaxf(fmaxf(mx, s[2][q2][1]), s[2][q2][2]); mx = fmaxf(fmaxf(mx, s[2][q2][3]), s[3][q2][0]); mx = fmaxf(fmaxf(mx, s[3][q2][1]), s[3][q2][2]); mx = fmaxf(mx, s[3][q2][3]);
                if (!__all(mx <= mrow[qb] + ATT_THR)) {
                    mx = fmaxf(mx, __shfl_xor(mx, 16)); mx = fmaxf(mx, __shfl_xor(mx, 32));
                    const float mnew = fmaxf(mrow[qb], mx), alpha = fexp2(mrow[qb] - mnew);
                    mrow[qb] = mnew; lrow[qb] = lrow[qb] * alpha;
#pragma unroll
                    for (int db = 0; db < 4; ++db) o[db][qb] = o[db][qb] * alpha;
                }
                const float mcur = mrow[qb];
                float ps = 0.f; float p[4][4];
#pragma unroll
                for (int kb = 0; kb < 4; ++kb)
#pragma unroll
                    for (int j = 0; j < 4; ++j) { p[kb][j] = fexp2(s[kb][q2][j] - mcur); ps += p[kb][j]; }
                lrow[qb] += ps;
#pragma unroll
                for (int kp2 = 0; kp2 < 2; ++kp2) {
                    v4u w; w.x = cvt_pk(p[2 * kp2][0], p[2 * kp2][1]); w.y = cvt_pk(p[2 * kp2][2], p[2 * kp2][3]);
                    w.z = cvt_pk(p[2 * kp2 + 1][0], p[2 * kp2 + 1][1]); w.w = cvt_pk(p[2 * kp2 + 1][2], p[2 * kp2 + 1][3]);
                    pf[qb][kp2] = __builtin_bit_cast(bf16x8, w);
                }
            }
        }
        asm volatile("s_waitcnt vmcnt(8)" ::: "memory");
        __builtin_amdgcn_wave_barrier();
        const int tq = (lane & 15) >> 2, tp = lane & 3;
#pragma unroll
        for (int kp2 = 0; kp2 < 2; ++kp2) {
            bf16x8 vf[4];
#pragma unroll
            for (int db = 0; db < 4; ++db) {
                const int r8 = 4 * (fq & 1) + tq;
                LAS unsigned char* a0 = vst + (4 * kp2 + (fq >> 1)) * 1024 + r8 * 128 + (((2 * db + (tp >> 1)) ^ (r8 & 6)) * 16) + (tp & 1) * 8;
                const s16x4 lo = __builtin_bit_cast(s16x4, __builtin_amdgcn_ds_read_tr16_b64_v4i16((LAS s16x4*)a0));
                const s16x4 hi = __builtin_bit_cast(s16x4, __builtin_amdgcn_ds_read_tr16_b64_v4i16((LAS s16x4*)(a0 + 2048)));
                vf[db] = (bf16x8){lo[0], lo[1], lo[2], lo[3], hi[0], hi[1], hi[2], hi[3]};
            }
#pragma unroll
            for (int qb = 0; qb < 4; ++qb)
#pragma unroll
                for (int db = 0; db < 4; ++db) o[db][qb] = __builtin_amdgcn_mfma_f32_16x16x32_bf16(vf[db], pf[qb][kp2], o[db][qb], 0, 0, 0);
        }
        asm volatile("" ::: "memory");
    }
#pragma unroll
    for (int qb = 0; qb < 4; ++qb) {
        float lt = lrow[qb]; lt += __shfl_xor(lt, 16); lt += __shfl_xor(lt, 32);
        if (!ISA) lt += fexp2(sink2 - mrow[qb]);
        const float inv = 1.0f / lt; float ss = 0.f;
#pragma unroll
        for (int db = 0; db < 4; ++db) { o[db][qb] = o[db][qb] * inv;
#pragma unroll
            for (int j = 0; j < 4; ++j) ss += o[db][qb][j] * o[db][qb][j]; }
        ss += __shfl_xor(ss, 16); ss += __shfl_xor(ss, 32);
        if (fq == 0) red[wave * 64 + 16 * qb + fr] = ss;
    }
    __syncthreads();
    const float* gout = (ISA ? T.goa : T.gob) + hd * 64 + 4 * (lane_id() >> 4);
    f32x4 gv[4];
#pragma unroll
    for (int db = 0; db < 4; ++db) gv[db] = *(const f32x4*)(gout + 16 * db);
#pragma unroll
    for (int qb = 0; qb < 4; ++qb) {
        float tot = 0.f;
#pragma unroll
        for (int w = 0; w < 8; ++w) tot += red[w * 64 + 16 * qb + fr];
        const float rstd = __builtin_amdgcn_rsqf(tot * (1.0f / 512.0f) + EPS);
        char* orow = (char*)(T.O + (size_t)(row0 + 16 * qb) * DM + (ISA ? 0 : 512) + hd * 64) + (unsigned)((fr * DM + 4 * fq) * 2);
#pragma unroll
        for (int db = 0; db < 4; ++db) { const f32x4 v = o[db][qb] * rstd * gv[db];
            v2u w; w.x = cvt_pk(v[0], v[1]); w.y = cvt_pk(v[2], v[3]); *(v2u*)(orow + 32 * db) = w; }
    }
}

__device__ __forceinline__ void attn_phase(LAS unsigned char* lds, const AttnArgs& T, const float* relb, const int wave) {
    const int lane = lane_id(), tid = wave * 64 + lane;
    LAS float* ext = (LAS float*)(lds + AL_EXT);
    for (int i = tid; i < 8 * 832; i += NWAVES * 64) { const int h = i / 832, k = i % 832; ext[i] = relb[h * 513 + (k < 512 ? k : 512)] * LOG2E; }
    volatile LAS unsigned* uw = (volatile LAS unsigned*)(lds + AL_UNIT);
    int qcur = (int)(blockIdx.x & 7u), qleft = 8;
    for (;;) {
        __syncthreads();
        if (tid == 0) {
            unsigned code = 0xffffffffu;
            while (qleft > 0) {
                const unsigned j = __hip_atomic_fetch_add(T.ctr + 16 * qcur, 1u, __ATOMIC_RELAXED, __HIP_MEMORY_SCOPE_AGENT);
                if (j < 132u) { code = (unsigned)qcur * 132u + j; break; }
                qcur = (qcur + 1) & 7; --qleft;
            }
            uw[0] = code;
        }
        __syncthreads();
        const unsigned u = (unsigned)__builtin_amdgcn_readfirstlane((int)uw[0]);
        if (u == 0xffffffffu) break;
        const int qq = (int)(u / 132u), j = (int)(u % 132u);
        if (j < 66) attn_unit<true>(lds, T, qq * 66 + j, wave, lane); else attn_unit<false>(lds, T, qq * 66 + j - 66, wave, lane);
    }
    __syncthreads();
}

struct Args { const float* in[21]; float* out; unsigned char* ws; };

constexpr size_t WS_SMALL = 768 * 1024, WS_BAR = 2048;
constexpr int SM_RELB = 0, SM_SINK = 8448, SM_GOA = 8512, SM_GOB = 9536, SM_GFIN = 10560, SM_END = 11584;
static_assert(WS_SSQ + (size_t)5 * MT * 4 <= WS_SMALL && WS_SMALL + SM_END * 4 <= WS_ROPE, "control region map");

__device__ __forceinline__ void grid_bar(unsigned* bar, unsigned k, unsigned G, unsigned bid, bool leader) {
    asm volatile("s_waitcnt vmcnt(0) lgkmcnt(0)" ::: "memory");
    __syncthreads();
    if (leader) {
        const unsigned g = bid & 7u, gsz = (G - g + 7u) >> 3, ng = G < 8u ? G : 8u;
        unsigned* gcnt = bar + 16 * (1 + g); unsigned* ggen = bar + 16 * (9 + g); unsigned* top = bar + 16 * 17;
        __builtin_amdgcn_fence(__ATOMIC_RELEASE, "agent");
        asm volatile("s_waitcnt vmcnt(0)" ::: "memory");
        const unsigned old = __hip_atomic_fetch_add(gcnt, 1u, __ATOMIC_RELAXED, __HIP_MEMORY_SCOPE_AGENT);
        if (old + 1u == k * gsz) {
            __hip_atomic_fetch_add(top, 1u, __ATOMIC_RELAXED, __HIP_MEMORY_SCOPE_AGENT);
            while (__hip_atomic_load(top, __ATOMIC_RELAXED, __HIP_MEMORY_SCOPE_AGENT) < k * ng) __builtin_amdgcn_s_sleep(1);
            __hip_atomic_fetch_add(ggen, 1u, __ATOMIC_RELAXED, __HIP_MEMORY_SCOPE_AGENT);
        } else {
            while (__hip_atomic_load(ggen, __ATOMIC_RELAXED, __HIP_MEMORY_SCOPE_AGENT) < k) __builtin_amdgcn_s_sleep(1);
        }
        __builtin_amdgcn_fence(__ATOMIC_ACQUIRE, "agent");
        asm volatile("s_waitcnt vmcnt(0)" ::: "memory");
    }
    __syncthreads();
}

struct PIn { const float *w_in, *w_out, *w_gu, *w_d, *w_pp, *w_pg, *g_mix, *g_ffn, *p_p, *p_s, *cak, *cav, *cbk, *cbv; };

__device__ __forceinline__ void conv_weights(LAS unsigned char* lds, unsigned char* ws, const PIn& I, const int l, const int wave, const int lane, const int gw, const int NGW, const int r_lo, const int r_hi) {
    LAS float* scr = (LAS float*)(lds + wave * 8448);
    constexpr int I_IN = (DM / 64) * (NIN / 32), I_OUT = (DM / 64) * (DM / 32), I_GU = (DM / 64) * (2 * FF / 32), I_D = (FF / 64) * (DM / 32), I_PP = (DPLE / 64) * (DM / 32), I_PG = I_OUT;
    constexpr int I_LAYER = I_IN + I_OUT + I_GU + I_D + I_PP + I_PG;
    unsigned char* wb = ws + WS_W + (size_t)l * W_LAYER;
    for (int it = r_lo + gw; it < (r_hi < I_LAYER ? r_hi : I_LAYER); it += NGW) {
        int r = it;
        if (r < I_IN) { transpose_item<false>(I.w_in + (size_t)l * DM * NIN, DM, NIN, (bf16*)(wb + W_IN), I.g_mix + l * DM, scr, r, lane); continue; } r -= I_IN;
        if (r < I_OUT) { transpose_item<false>(I.w_out + (size_t)l * DM * DM, DM, DM, (bf16*)(wb + W_OUT), nullptr, scr, r, lane); continue; } r -= I_OUT;
        if (r < I_GU) { transpose_item<true>(I.w_gu + (size_t)l * DM * 2 * FF, DM, 2 * FF, (bf16*)(wb + W_GU), I.g_ffn + l * DM, scr, r, lane); continue; } r -= I_GU;
        if (r < I_D) { transpose_item<false>(I.w_d + (size_t)l * FF * DM, FF, DM, (bf16*)(wb + W_D), nullptr, scr, r, lane); continue; } r -= I_D;
        if (r < I_PP) { transpose_item<false>(I.w_pp + (size_t)l * DPLE * DM, DPLE, DM, (bf16*)(wb + W_PP), nullptr, scr, r, lane); continue; } r -= I_PP;
        transpose_item<false>(I.w_pg + (size_t)l * DM * DM, DM, DM, (bf16*)(wb + W_PG), nullptr, scr, r, lane);
    }
}
__device__ __forceinline__ void conv_p_caches(unsigned char* ws, float* out, const PIn& I, const int l, const size_t gtid, const size_t gth, const int part = 3) {
    bf16* PB = (bf16*)(ws + WS_PB);
    if (part & 1) {
    convert_flat(I.p_p + (size_t)l * MP * DPLE, PB + (size_t)l * MT * DPLE, (size_t)MP * DPLE, gtid, gth);
    convert_flat(I.p_s + (size_t)l * MS * DPLE, PB + (size_t)l * MT * DPLE + (size_t)MP * DPLE, (size_t)MS * DPLE, gtid, gth);
    }
    if (!(part & 2)) return;
    constexpr size_t NA = (size_t)16 * 512 * 512, NB = (size_t)16 * 128 * 128;
    for (size_t i = gtid * 8; i < NA; i += gth * 8) {
        const size_t gi = (size_t)l * NA + i;
        const f32x4 a = *(const f32x4*)(I.cak + gi), b = *(const f32x4*)(I.cak + gi + 4), c = *(const f32x4*)(I.cav + gi), d = *(const f32x4*)(I.cav + gi + 4);
        v4u w; w.x = cvt_pk(a[0], a[1]); w.y = cvt_pk(a[2], a[3]); w.z = cvt_pk(b[0], b[1]); w.w = cvt_pk(b[2], b[3]);
        *(v4u*)((bf16*)(ws + WS_CKA) + gi) = w;
        w.x = cvt_pk(c[0], c[1]); w.y = cvt_pk(c[2], c[3]); w.z = cvt_pk(d[0], d[1]); w.w = cvt_pk(d[2], d[3]);
        *(v4u*)((bf16*)(ws + WS_CVA) + gi) = w;
        if (((i >> 9) & 511) >= 64) { float* dk = out + O_AKS + gi - 32768; float* dv = out + O_AVS + gi - 32768;
            *(f32x4*)dk = a; *(f32x4*)(dk + 4) = b; *(f32x4*)dv = c; *(f32x4*)(dv + 4) = d; }
    }
    for (size_t i = gtid * 8; i < NB; i += gth * 8) {
        const size_t gi = (size_t)l * NB + i;
        const f32x4 a = *(const f32x4*)(I.cbk + gi), b = *(const f32x4*)(I.cbk + gi + 4), c = *(const f32x4*)(I.cbv + gi), d = *(const f32x4*)(I.cbv + gi + 4);
        v4u w; w.x = cvt_pk(a[0], a[1]); w.y = cvt_pk(a[2], a[3]); w.z = cvt_pk(b[0], b[1]); w.w = cvt_pk(b[2], b[3]);
        *(v4u*)((bf16*)(ws + WS_CKB) + gi) = w;
        w.x = cvt_pk(c[0], c[1]); w.y = cvt_pk(c[2], c[3]); w.z = cvt_pk(d[0], d[1]); w.w = cvt_pk(d[2], d[3]);
        *(v4u*)((bf16*)(ws + WS_CVB) + gi) = w;
        if (((i >> 7) & 127) >= 64) { float* dk = out + O_BKS + gi - 8192; float* dv = out + O_BVS + gi - 8192;
            *(f32x4*)dk = a; *(f32x4*)(dk + 4) = b; *(f32x4*)dv = c; *(f32x4*)(dv + 4) = d; }
    }
}

template <int l>
__device__ __forceinline__ void run_layer(LAS unsigned char* lds, unsigned char* ws_in, float* out_in, const float* x_p, const float* x_s, const PIn* pin, const int G, const int bid, const int wave) {
    GAS unsigned char* wsg_ = (GAS unsigned char*)ws_in; GAS float* outg_ = (GAS float*)out_in; asm volatile("" : "+s"(wsg_), "+s"(outg_));
    unsigned char* ws = (unsigned char*)wsg_; float* out = (float*)outg_;
    unsigned* const bar = (unsigned*)(ws + WS_BAR);
#define GRID_BAR(k) grid_bar(bar, (unsigned)((k) + 1), (unsigned)G, (unsigned)bid, wave == 0 && lane_id() == 0)
        unsigned char* wb = ws + WS_W + (size_t)l * W_LAYER;
        bf16 *XB = (bf16*)(ws + WS_XB), *HB = (bf16*)(ws + WS_HB), *O = (bf16*)(ws + WS_O), *ACT = (bf16*)(ws + WS_ACT);
        {
            pg8::RowOrder<NIN / 256> S; S.init(G, bid);
            EpiIn E{ws, out, (l == 0) ? 0 : 2 * MT, l};
            pg8::gemm_phase<DM, EpiIn, pg8::RowOrder<NIN / 256>>(lds, XB, (const bf16*)(wb + W_IN), S, E, wave);
            if (l == 0) {
                const int nbusy = (MT / 256 * (NIN / 256)) % G;
                if (S.v >= nbusy) { const int lane = lane_id(); const PIn I = *pin;
                    conv_p_caches(ws, out, I, 0, (size_t)(S.v - nbusy) * (NWAVES * 64) + wave * 64 + lane, (size_t)(G - nbusy) * (NWAVES * 64)); }
            }
        }
        GRID_BAR(6 * l + 1);
        {
            const float* sm = (const float*)(ws + WS_SMALL);
            AttnArgs T{(const bf16*)(ws + WS_Z), (const bf16*)(ws + WS_CKA) + (size_t)l * 16 * 512 * 512, (const bf16*)(ws + WS_CVA) + (size_t)l * 16 * 512 * 512,
                       (const bf16*)(ws + WS_CKB) + (size_t)l * 16 * 128 * 128, (const bf16*)(ws + WS_CVB) + (size_t)l * 16 * 128 * 128,
                       sm + SM_SINK + l * 8, sm + SM_GOA + l * 512, sm + SM_GOB + l * 512, O, (unsigned*)(ws + WS_CTL) + 128 * l};
            attn_phase(lds, T, sm + SM_RELB + (size_t)l * 8 * 513, wave);
        }
        GRID_BAR(6 * l + 2);
        {
            pg8::RowOrder<DM / 256> S; S.init(G, bid);
            EpiRes E{ws, out, nullptr, nullptr, 1, (1 + 2 * l) * MT};
            pg8::gemm_phase<DM, EpiRes, pg8::RowOrder<DM / 256>>(lds, O, (const bf16*)(wb + W_OUT), S, E, wave);
            if (l == 0) {
                const int nbusy = (MT / 256 * 4) % G;
                if (S.v >= nbusy) { const int lane = lane_id(); const PIn I = *pin; __syncthreads();
                    conv_weights(lds, ws, I, 0, wave, lane, (S.v - nbusy) * NWAVES + wave, (G - nbusy) * NWAVES, W_ITEMS_EARLY, 1 << 30); }
            }
        }
        GRID_BAR(6 * l + 3);
        {
            pg8::RowOrder<2 * FF / 256> S; S.init(G, bid);
            EpiGU E{ws, out, (1 + 2 * l) * MT};
            pg8::gemm_phase<DM, EpiGU, pg8::RowOrder<2 * FF / 256>>(lds, HB, (const bf16*)(wb + W_GU), S, E, wave);
            if (l == 0) {
                const int nbusy = (MT / 256 * (2 * FF / 256)) % G;
                if (S.v >= nbusy) { const int lane = lane_id(); const PIn I = *pin;
                    conv_p_caches(ws, out, I, 1, (size_t)(S.v - nbusy) * (NWAVES * 64) + wave * 64 + lane, (size_t)(G - nbusy) * (NWAVES * 64), 1); }
            }
        }
        GRID_BAR(6 * l + 4);
        {
            pg8::RowOrder<DM / 256> S; S.init(G, bid);
            EpiRes E{ws, out, nullptr, nullptr, 0, -1};
            pg8::gemm_phase<FF, EpiRes, pg8::RowOrder<DM / 256>>(lds, ACT, (const bf16*)(wb + W_D), S, E, wave);
            pg8::RowOrder<DM / 256> S2; S2.init(G, G - 1 - bid);
            EpiPP E2{ws, out};
            pg8::gemm_phase<DPLE, EpiPP, pg8::RowOrder<DM / 256>>(lds, (const bf16*)(ws + WS_PB) + (size_t)l * MT * DPLE, (const bf16*)(wb + W_PP), S2, E2, wave);
            if (l == 0) {
                const int nbusy = (MT / 256 * 4) % G;
                if (S.v >= nbusy) { const int lane = lane_id(); const PIn I = *pin; __syncthreads();
                    conv_weights(lds, ws, I, 1, wave, lane, (S.v - nbusy) * NWAVES + wave, (G - nbusy) * NWAVES, 0, 1 << 30); }
            }
        }
        GRID_BAR(6 * l + 5);
        {
            pg8::RowOrder<DM / 256> S; S.init(G, bid);
            EpiPG E{ws, out, (2 + 2 * l) * MT};
            pg8::gemm_phase<DM, EpiPG, pg8::RowOrder<DM / 256>>(lds, HB, (const bf16*)(wb + W_PG), S, E, wave);
            if (l == 0) {
                const int nbusy = (MT / 256 * 4) % G;
                if (S.v >= nbusy) { const int lane = lane_id(); const PIn I = *pin;
                    conv_p_caches(ws, out, I, 1, (size_t)(S.v - nbusy) * (NWAVES * 64) + wave * 64 + lane, (size_t)(G - nbusy) * (NWAVES * 64), 2); }
            }
        }
        GRID_BAR(6 * l + 6);
    }
#undef GRID_BAR

__global__ void __launch_bounds__(NWAVES * 64, 2) mega_fwd(Args args) {
    extern __shared__ __attribute__((aligned(16))) unsigned char lds_raw[];
    LAS unsigned char* lds = (LAS unsigned char*)lds_raw;
    const int wave = __builtin_amdgcn_readfirstlane((int)threadIdx.x >> 6);
    const int G = gridDim.x, bid = blockIdx.x;
    unsigned char* const ws = args.ws;
    float* const out = args.out;
    float* const H = out + O_Y;

    if (args.ws == nullptr) cg::this_grid().sync();
    {
        const float *x_p = args.in[0], *x_s = args.in[1], *p_p = args.in[2], *p_s = args.in[3], *cak = args.in[4], *cav = args.in[5], *cbk = args.in[6], *cbv = args.in[7],
                    *g_mix = args.in[8], *w_in = args.in[9], *relb = args.in[10], *sinks = args.in[11], *goa = args.in[12], *gob = args.in[13], *w_out = args.in[14],
                    *g_ffn = args.in[15], *w_gu = args.in[16], *w_d = args.in[17], *w_pp = args.in[18], *w_pg = args.in[19], *g_fin = args.in[20];
        float* ssqb = (float*)(ws + WS_SSQ);
        float* rope = (float*)(ws + WS_ROPE);
        float* sm = (float*)(ws + WS_SMALL);
        bf16 *XB = (bf16*)(ws + WS_XB), *PB = (bf16*)(ws + WS_PB);
        const int lane = lane_id(), tid = wave * 64 + lane;
        const int gw = bid * NWAVES + wave, NGW = G * NWAVES;
        const size_t gtid = (size_t)bid * (NWAVES * 64) + tid, gth = (size_t)G * (NWAVES * 64);
        const PIn I{w_in, w_out, w_gu, w_d, w_pp, w_pg, g_mix, g_ffn, p_p, p_s, cak, cav, cbk, cbv};
        conv_weights(lds, ws, I, 0, wave, lane, gw, NGW, 0, W_ITEMS_EARLY);
        for (int m0 = gw; m0 < MT; m0 += 2 * NGW) {
            const int m1 = m0 + NGW; const bool has1 = m1 < MT;
            const float* xr0 = (m0 < MP) ? x_p + (size_t)m0 * DM : x_s + (size_t)(m0 - MP) * DM;
            const float* xr1 = has1 ? ((m1 < MP) ? x_p + (size_t)m1 * DM : x_s + (size_t)(m1 - MP) * DM) : xr0;
            f32x4 a[2][4];
#pragma unroll
            for (int j = 0; j < 2; ++j) { a[0][2 * j] = *(const f32x4*)(xr0 + j * 512 + lane * 8); a[0][2 * j + 1] = *(const f32x4*)(xr0 + j * 512 + lane * 8 + 4);
                                          a[1][2 * j] = *(const f32x4*)(xr1 + j * 512 + lane * 8); a[1][2 * j + 1] = *(const f32x4*)(xr1 + j * 512 + lane * 8 + 4); }
#pragma unroll
            for (int r = 0; r < 2; ++r) {
                const int m = r ? m1 : m0; float ss = 0.f;
#pragma unroll
                for (int j = 0; j < 2; ++j) { const f32x4 p = a[r][2 * j], q = a[r][2 * j + 1];
                    ss += (p[0] * p[0] + p[1] * p[1]) + (p[2] * p[2] + p[3] * p[3]) + (q[0] * q[0] + q[1] * q[1]) + (q[2] * q[2] + q[3] * q[3]);
                    v4u w; w.x = cvt_pk(p[0], p[1]); w.y = cvt_pk(p[2], p[3]); w.z = cvt_pk(q[0], q[1]); w.w = cvt_pk(q[2], q[3]);
                    if (r == 0 || has1) *(v4u*)(XB + (size_t)m * DM + j * 512 + lane * 8) = w; }
#pragma unroll
                for (int o = 1; o < 64; o <<= 1) ss += __shfl_xor(ss, o);
                if (lane == 0 && (r == 0 || has1)) ssqb[m] = ss;
            }
        }
        for (size_t i = gtid; i < (size_t)16384 * 8; i += gth) {
            const int pos = (int)(i >> 3), j = (int)(i & 7);
            const double rv = (j == 0) ? 0.15915494309189535 : (j == 1) ? 0.03086376340470123 : (j == 2) ? 0.005985185712713705 : (j == 3) ? 0.001160663641240061 :
                              (j == 4) ? 0.00022507907903927653 : (j == 5) ? 4.364795279280289e-05 : (j == 6) ? 8.464330808241401e-06 : 1.6414262627950345e-06;
            const double t = (double)pos * rv; const float fr_ = (float)(t - __builtin_floor(t));
            rope[2 * i] = __builtin_amdgcn_cosf(fr_); rope[2 * i + 1] = __builtin_amdgcn_sinf(fr_);
        }
        for (size_t i = gtid; i < (size_t)SM_END; i += gth) {
            float v = 0.f; const int k = (int)i;
            if (k < 2 * 8 * 513) v = relb[k];
            else if (k >= SM_SINK && k < SM_SINK + 16) v = sinks[k - SM_SINK];
            else if (k >= SM_GOA && k < SM_GOB) v = goa[k - SM_GOA];
            else if (k >= SM_GOB && k < SM_GFIN) v = gob[k - SM_GOB];
            else if (k >= SM_GFIN) v = g_fin[k - SM_GFIN];
            sm[k] = v;
        }
        for (size_t i = gtid; i < (size_t)4 * MT; i += gth) ssqb[MT + i] = 0.f;
        if (gtid < 256) ((unsigned*)(ws + WS_CTL))[gtid] = 0u;
    }
    grid_bar((unsigned*)(ws + WS_BAR), 1u, (unsigned)G, (unsigned)bid, wave == 0 && lane_id() == 0);

    const float* const x_p = args.in[0]; const float* const x_s = args.in[1];
    const PIn pin{args.in[9], args.in[14], args.in[16], args.in[17], args.in[18], args.in[19], args.in[8], args.in[15], args.in[2], args.in[3], args.in[4], args.in[5], args.in[6], args.in[7]};
    run_layer<0>(lds, ws, out, x_p, x_s, &pin, G, bid, wave);
    run_layer<1>(lds, ws, out, x_p, x_s, &pin, G, bid, wave);
    {
        const int lane = lane_id();
        const int gw = bid * NWAVES + wave, NGW = G * NWAVES;
        const float* ssq = (const float*)(ws + WS_SSQ) + 4 * (size_t)MT;
        const float* g_fin = (const float*)(ws + WS_SMALL) + SM_GFIN;
        const bf16* XB = (const bf16*)(ws + WS_XB);
        f32x4 gf[2][2];
#pragma unroll
        for (int j = 0; j < 2; ++j) { gf[j][0] = *(const f32x4*)(g_fin + j * 512 + lane * 8); gf[j][1] = *(const f32x4*)(g_fin + j * 512 + lane * 8 + 4); }
        for (int m = gw; m < MT; m += NGW) {
            const float rstd = __builtin_amdgcn_rsqf(ssq[m] * (1.0f / DM) + EPS);
            float* yr = H + (size_t)m * DM;
#pragma unroll
            for (int j = 0; j < 2; ++j) {
                const v4u w = *(const v4u*)(XB + (size_t)m * DM + j * 512 + lane * 8);
                const f32x4 a = (f32x4){bf_lo(w.x), bf_hi(w.x), bf_lo(w.y), bf_hi(w.y)}, b2 = (f32x4){bf_lo(w.z), bf_hi(w.z), bf_lo(w.w), bf_hi(w.w)};
                *(f32x4*)(yr + j * 512 + lane * 8) = a * rstd * gf[j][0]; *(f32x4*)(yr + j * 512 + lane * 8 + 4) = b2 * rstd * gf[j][1];
            }
        }
    }
}

extern "C" void kernel_launch(void* const* d_in, const int* in_sizes, int n_in, void* d_out, int out_size, void* d_ws, size_t ws_size, hipStream_t stream) {
    static int grid = 0;
    if (grid == 0) {
        if (n_in != 21 || (size_t)out_size != O_END || ws_size < WS_END) { fprintf(stderr, "kernel_launch: unexpected problem: n_in %d out %d ws %zu (need out %zu ws %zu)\n", n_in, out_size, ws_size, (size_t)O_END, (size_t)WS_END); grid = -1; return; }
        int dev = 0, cus = 0, per_cu = 0;
        (void)hipGetDevice(&dev);
        (void)hipDeviceGetAttribute(&cus, hipDeviceAttributeMultiprocessorCount, dev);
        if (hipFuncSetAttribute((const void*)mega_fwd, hipFuncAttributeMaxDynamicSharedMemorySize, LDS_BYTES) != hipSuccess) { fprintf(stderr, "kernel_launch: hipFuncSetAttribute failed\n"); grid = -1; return; }
        if (hipOccupancyMaxActiveBlocksPerMultiprocessor(&per_cu, (const void*)mega_fwd, NWAVES * 64, LDS_BYTES) != hipSuccess || per_cu < 1) { fprintf(stderr, "kernel_launch: occupancy query says %d blocks per CU\n", per_cu); (void)hipGetLastError(); per_cu = 1; }
        grid = cus * 1;
        if (grid <= 0) { grid = -1; return; }
    }
    if (grid < 0) return;
    (void)hipMemsetAsync((unsigned char*)d_ws + WS_BAR, 0, 2048, stream);
    Args a{};
    for (int i = 0; i < 21; ++i) a.in[i] = (const float*)d_in[i];
    a.out = (float*)d_out; a.ws = (unsigned char*)d_ws;
    void* kargs[] = {&a};
    hipError_t e = hipLaunchCooperativeKernel((const void*)mega_fwd, dim3(grid), dim3(NWAVES * 64), kargs, LDS_BYTES, stream);
    if (e != hipSuccess) fprintf(stderr, "kernel_launch: cooperative launch failed: %s (grid %d)\n", hipGetErrorString(e), grid);
}
```

```cpp
#include <hip/hip_runtime.h>
#include <hip/hip_cooperative_groups.h>
#include <cstdio>
#include <cstdint>
namespace cg = cooperative_groups;

#define GAS __attribute__((address_space(1)))
#define LAS __attribute__((address_space(3)))
typedef unsigned short bf16;
typedef unsigned v4u __attribute__((ext_vector_type(4)));
typedef unsigned v2u __attribute__((ext_vector_type(2)));
typedef float f32x4 __attribute__((ext_vector_type(4)));
typedef short bf16x8 __attribute__((ext_vector_type(8)));
typedef short s16x4 __attribute__((ext_vector_type(4)));

constexpr int MP = 32768, MS = 1024, MT = MP + MS;
constexpr int DM = 1024, NIN = 2304, FF = 2816, DPLE = 256;
constexpr float EPS = 1e-6f;
constexpr float LOG2E = 1.4426950408889634f;
constexpr float QSCALE = 0.125f * LOG2E;

__device__ __forceinline__ unsigned cvt_pk(float lo, float hi) { unsigned r; asm("v_cvt_pk_bf16_f32 %0, %1, %2" : "=v"(r) : "v"(lo), "v"(hi)); return r; }
__device__ __forceinline__ float bf_lo(unsigned w) { return __builtin_bit_cast(float, w << 16); }
__device__ __forceinline__ float bf_hi(unsigned w) { return __builtin_bit_cast(float, w & 0xffff0000u); }
__device__ __forceinline__ float fexp2(float x) { return __builtin_amdgcn_exp2f(x); }
__device__ __forceinline__ float frcp(float x) { return __builtin_amdgcn_rcpf(x); }

__device__ __forceinline__ int lane_id() { int l = __builtin_amdgcn_mbcnt_hi(~0u, __builtin_amdgcn_mbcnt_lo(~0u, 0u)); asm volatile("" : "+v"(l)); return l; }

namespace pg8 {
constexpr int BM = 256, BK = 64, HALF = 128, HTB = HALF * BK * 2, STAGE_BYTES = 8 * HTB, NXCD = 8, WGM = 8;
__host__ __device__ __forceinline__ int lds_byte(int r, int c) { const int st = (r >> 4) * 2 + (c >> 5), rr = r & 15, cc = c & 31, ob = rr * 64 + cc * 2; return st * 1024 + (ob ^ (((ob >> 9) & 1) << 5)); }
__host__ __device__ __forceinline__ void stage_rc(int b, int& R, int& C) { const int st = b / 1024, sb = b % 1024, swz = sb ^ (((sb >> 9) & 1) << 5); R = (st >> 1) * 16 + swz / 64; C = (st & 1) * 32 + (swz % 64) / 2; }
__host__ __device__ __forceinline__ int perm32(int rho) { const int n = rho >> 4, i = rho & 15; return 8 * (i >> 2) + 4 * n + (i & 3); }

struct Unit { int pm, pn; };
struct Gemm { const bf16* A; const bf16* Bt; int M, N, K; };

template <int NN>
struct RowOrder {
    int G, v;
    __device__ __forceinline__ void init(int G_, int c) { G = G_; v = (G_ % 8 == 0) ? (c % 8) * (G_ / 8) + c / 8 : c; }
    __device__ __forceinline__ bool next(int i, Unit& u) const {
        const int L = i * G + v; if (L >= (33792 / BM) * NN) return false;
        constexpr int NM = 33792 / BM, NFULL = (NM / 8) * 8 * NN;
        if (L < NFULL) { const int g = L / (8 * NN), idx = L % (8 * NN); u.pm = g * 8 + (idx & 7); u.pn = idx >> 3; }
        else { constexpr int GS = NM % 8 ? NM % 8 : 8; const int idx = L - NFULL; u.pm = (NM / 8) * 8 + idx % GS; u.pn = idx / GS; }
        return true;
    }
};

template <int NN>
struct RowOrderSkip {
    int G, v, nskip;
    __device__ __forceinline__ void init(int G_, int c, int nskip_) { G = G_; nskip = nskip_; v = (G_ % 8 == 0) ? (c % 8) * (G_ / 8) + c / 8 : c; }
    __device__ __forceinline__ bool next(int i, Unit& u) const {
        if (v < nskip) return false;
        const int L = i * (G - nskip) + (v - nskip); if (L >= (33792 / BM) * NN) return false;
        constexpr int NM = 33792 / BM, NFULL = (NM / 8) * 8 * NN;
        if (L < NFULL) { const int g = L / (8 * NN), idx = L % (8 * NN); u.pm = g * 8 + (idx & 7); u.pn = idx >> 3; }
        else { constexpr int GS = NM % 8 ? NM % 8 : 8; const int idx = L - NFULL; u.pm = (NM / 8) * 8 + idx % GS; u.pn = idx / GS; }
        return true;
    }
};

template <int KK, class Epi, class Sched, bool ALIGN_EPI = true>
__device__ __forceinline__ void gemm_phase(LAS unsigned char* lds, const bf16* gA, const bf16* gBt, const Sched& S, const Epi& E, const int wid) {
    const int lane = lane_id();
    const int tid = wid * 64 + lane, wr = wid >> 2, wc = wid & 3, fr = lane & 15, fq = lane >> 4;
    constexpr int K = KK, nt = K / BK;
    unsigned voffA[2], voffB[2];
#pragma unroll
    for (int i = 0; i < 2; ++i) { int R, C; stage_rc(tid * 16 + i * 8192, R, C); const int Rb = Epi::PERM ? ((R & ~31) + perm32(R & 31)) : R;
        voffA[i] = (unsigned)(R * K + C) * 2u; voffB[i] = (unsigned)(Rb * K + C) * 2u; }
    const size_t kstep = (size_t)(BK * 2);
    const size_t hstep = (size_t)HALF * K * 2;
    const size_t tstep = 2 * hstep;
    const unsigned ldsw = (unsigned)wid * 1024u;
    const int aoff = lds_byte(wr * 64 + fr, fq * 8), boff = lds_byte(wc * 32 + fr, fq * 8);
#define PG8_SA(b, h) (((b) * 2 + (h)) * HTB)
#define PG8_SB(b, h) ((4 + (b) * 2 + (h)) * HTB)
#define PG8_STAGE(bufoff, gbase, voff) do { _Pragma("unroll") for (int _i = 0; _i < 2; ++_i) \
        __builtin_amdgcn_global_load_lds((const unsigned*)((const char*)(gbase) + (voff)[_i]), (LAS unsigned*)(lds + (bufoff) + ldsw + _i * 8192), 16, 0, 0); } while (0)
#define PG8_LDA(dst, b, h) do { _Pragma("unroll") for (int m = 0; m < 4; ++m) _Pragma("unroll") for (int k = 0; k < 2; ++k) dst[m][k] = *(const LAS bf16x8*)(lds + PG8_SA(b, h) + aoff + m * 2048 + k * 1024); } while (0)
#define PG8_LDB(dst, b, h) do { _Pragma("unroll") for (int n = 0; n < 2; ++n) _Pragma("unroll") for (int k = 0; k < 2; ++k) dst[n][k] = *(const LAS bf16x8*)(lds + PG8_SB(b, h) + boff + n * 2048 + k * 1024); } while (0)
#define PG8_MMA(ai, bj, At, Bt) do { __builtin_amdgcn_s_setprio(1); _Pragma("unroll") for (int m = 0; m < 4; ++m) _Pragma("unroll") for (int n = 0; n < 2; ++n) _Pragma("unroll") for (int k = 0; k < 2; ++k) \
        acc[ai][bj][m][n] = __builtin_amdgcn_mfma_f32_16x16x32_bf16(Bt[n][k], At[m][k], acc[ai][bj][m][n], 0, 0, 0); __builtin_amdgcn_s_setprio(0); } while (0)
#define PG8_WAIT_V(n) asm volatile("s_waitcnt vmcnt(" #n ")" ::: "memory")
#define PG8_WAIT_L(n) asm volatile("s_waitcnt lgkmcnt(" #n ")" ::: "memory")
#define PG8_BAR __builtin_amdgcn_s_barrier()
#define PG8_SCHED __builtin_amdgcn_sched_barrier(0)
    Unit cur, nxt; int ui = 0;
    if (!S.next(0, cur)) return;
    f32x4 acc[2][2][4][2];
#pragma unroll
    for (int a = 0; a < 2; ++a)
#pragma unroll
        for (int b = 0; b < 2; ++b)
#pragma unroll
            for (int m = 0; m < 4; ++m)
#pragma unroll
                for (int n = 0; n < 2; ++n) acc[a][b][m][n] = (f32x4){0.f, 0.f, 0.f, 0.f};
    bf16x8 At[4][2], B0[2][2], B1[2][2];
    const char* cA = (const char*)gA + (size_t)cur.pm * tstep; const char* cB = (const char*)gBt + (size_t)cur.pn * tstep;
    PG8_STAGE(PG8_SB(0, 0), cB, voffB); PG8_STAGE(PG8_SB(0, 1), cB + hstep, voffB); PG8_STAGE(PG8_SA(0, 0), cA, voffA); PG8_STAGE(PG8_SA(0, 1), cA + hstep, voffA);
    PG8_STAGE(PG8_SB(1, 0), cB + kstep, voffB); PG8_STAGE(PG8_SA(1, 0), cA + kstep, voffA); PG8_STAGE(PG8_SB(1, 1), cB + hstep + kstep, voffB);
    if (wr == 1) PG8_BAR;
    PG8_WAIT_V(8); PG8_BAR;
    PG8_WAIT_V(6); PG8_BAR;
    for (;;) {
        const bool has_next = S.next(ui + 1, nxt);
        const char* nA = has_next ? (const char*)gA + (size_t)nxt.pm * tstep : cA; const char* nB = has_next ? (const char*)gBt + (size_t)nxt.pn * tstep : cB;
#pragma unroll 1
        for (int t = 0; t < nt; t += 2) {
            const bool last = (t == nt - 2);
            const char* a1 = cA + (size_t)(t + 1) * kstep;
            const char* a2 = last ? nA : cA + (size_t)(t + 2) * kstep; const char* b2 = last ? nB : cB + (size_t)(t + 2) * kstep;
            const char* a3 = a2 + kstep; const char* b3 = b2 + kstep;
            PG8_LDB(B0, 0, 0); PG8_LDB(B1, 0, 1); PG8_SCHED; PG8_LDA(At, 0, 0); PG8_STAGE(PG8_SA(1, 1), a1 + hstep, voffA);
            PG8_WAIT_V(8); PG8_WAIT_L(0); PG8_BAR; PG8_MMA(0, 0, At, B0); PG8_MMA(0, 1, At, B1); PG8_BAR; PG8_SCHED;
            PG8_LDA(At, 0, 1); PG8_STAGE(PG8_SB(0, 0), b2, voffB); PG8_STAGE(PG8_SB(0, 1), b2 + hstep, voffB); PG8_STAGE(PG8_SA(0, 0), a2, voffA);
            PG8_WAIT_V(8); PG8_WAIT_L(0); PG8_BAR; PG8_MMA(1, 0, At, B0); PG8_MMA(1, 1, At, B1); PG8_BAR; PG8_SCHED;
            PG8_LDB(B0, 1, 0); PG8_LDB(B1, 1, 1); PG8_SCHED; PG8_LDA(At, 1, 0); PG8_STAGE(PG8_SA(0, 1), a2 + hstep, voffA);
            PG8_WAIT_V(8); PG8_WAIT_L(0); PG8_BAR; PG8_MMA(0, 0, At, B0); PG8_MMA(0, 1, At, B1); PG8_BAR; PG8_SCHED;
            PG8_LDA(At, 1, 1); PG8_STAGE(PG8_SB(1, 0), b3, voffB); PG8_STAGE(PG8_SB(1, 1), b3 + hstep, voffB); PG8_STAGE(PG8_SA(1, 0), a3, voffA);
            PG8_WAIT_V(8); PG8_WAIT_L(0); PG8_BAR; PG8_MMA(1, 0, At, B0); PG8_MMA(1, 1, At, B1); PG8_BAR; PG8_SCHED;
        }
        if constexpr (ALIGN_EPI) { if (wr == 0) PG8_BAR; }
        E(acc, cur, wr, wc, fr, fq);
        if (!has_next) break;
#pragma unroll
        for (int a = 0; a < 2; ++a)
#pragma unroll
            for (int b = 0; b < 2; ++b)
#pragma unroll
                for (int m = 0; m < 4; ++m)
#pragma unroll
                    for (int n = 0; n < 2; ++n) acc[a][b][m][n] = (f32x4){0.f, 0.f, 0.f, 0.f};
        cur = nxt; cA = nA; cB = nB; ++ui;
        if constexpr (ALIGN_EPI) { if (wr == 1) PG8_BAR; }
    }
    PG8_WAIT_V(0);
    if constexpr (!ALIGN_EPI) { if (wr == 0) PG8_BAR; }
    PG8_BAR;
#undef PG8_SA
#undef PG8_SB
#undef PG8_STAGE
#undef PG8_LDA
#undef PG8_LDB
#undef PG8_MMA
#undef PG8_WAIT_V
#undef PG8_WAIT_L
#undef PG8_BAR
#undef PG8_SCHED
}
}

constexpr size_t MiB = 1u << 20;
constexpr size_t WS_CTL = 0;
constexpr size_t WS_SSQ = 4096;
constexpr size_t WS_ROPE = 1 * MiB;
constexpr size_t WS_W = 2 * MiB;
constexpr size_t W_IN = 0, W_OUT = W_IN + (size_t)NIN * DM * 2, W_GU = W_OUT + (size_t)DM * DM * 2, W_D = W_GU + (size_t)2 * FF * DM * 2,
                 W_PP = W_D + (size_t)DM * FF * 2, W_PG = W_PP + (size_t)DM * DPLE * 2, W_LAYER = W_PG + (size_t)DM * DM * 2;
constexpr size_t WS_XB = WS_W + 2 * W_LAYER + MiB;
constexpr size_t ACT_DM = (size_t)MT * DM * 2;
constexpr size_t WS_HB = WS_XB + ACT_DM;
constexpr size_t WS_Z = WS_HB + ACT_DM;
constexpr size_t WS_O = WS_Z + (size_t)MT * NIN * 2;
constexpr size_t WS_ACT = WS_Z;
constexpr size_t WS_PB = WS_O + ACT_DM;
constexpr size_t WS_CKA = WS_PB + (size_t)2 * MT * DPLE * 2;
constexpr size_t CA_BYTES = (size_t)2 * 16 * 512 * 512 * 2, CB_BYTES = (size_t)2 * 16 * 128 * 128 * 2;
constexpr size_t WS_CVA = WS_CKA + CA_BYTES, WS_CKB = WS_CVA + CA_BYTES, WS_CVB = WS_CKB + CB_BYTES, WS_END = WS_CVB + CB_BYTES;
static_assert((size_t)MT * FF * 2 <= (size_t)MT * NIN * 2 + ACT_DM, "ACT overlay fits Z|O");
static_assert(WS_END <= 512 * MiB, "workspace map");

constexpr size_t O_Y = 0, O_AKP = (size_t)MT * DM, O_AVP = O_AKP + 2 * 2 * 512 * 512, O_BKP = O_AVP + 2 * 2 * 512 * 512, O_BVP = O_BKP + 2 * 2 * 128 * 128,
                 O_AKS = O_BVP + 2 * 2 * 128 * 128, O_AVS = O_AKS + (size_t)2 * 16 * 512 * 512, O_BKS = O_AVS + (size_t)2 * 16 * 512 * 512, O_BVS = O_BKS + 2 * 16 * 128 * 128,
                 O_END = O_BVS + 2 * 16 * 128 * 128;

constexpr int LDS_BYTES = 131072 + 4096;
constexpr int W_ITEMS_EARLY = (DM / 64) * (NIN / 32) + (DM / 64) * (DM / 32);
constexpr int NWAVES = 8;

typedef const f32x4 (&AccRef)[2][2][4][2];

struct EpiIn {
    static constexpr bool PERM = true;
    unsigned char* ws_; float* out_; int ssq_off; int l;
    __device__ __forceinline__ void operator()(AccRef acc, const pg8::Unit& u, int wr, int wc, int, int) const {
        GAS unsigned char* wsg_ = (GAS unsigned char*)ws_; GAS float* outg_ = (GAS float*)out_; asm volatile("" : "+s"(wsg_), "+s"(outg_)); unsigned char* ws = (unsigned char*)wsg_; float* out = (float*)outg_;
        const int lane_ = lane_id(); const int fr = lane_ & 15, fq = lane_ >> 4;
        const float* ssq = (const float*)(ws + WS_SSQ) + ssq_off;
        const int pn = u.pn, pm = u.pm;
        const bool samp = pm >= (MP / 256);
        const bool isq = (pn < 2) || (pn == 6) || (pn == 7);
        bf16* Z = (bf16*)(ws + WS_Z); const float* rope = (const float*)(ws + WS_ROPE);
        const bool wrA = (pn >= 2 && pn <= 5) && (samp || (pm & 63) >= 62);
        const bool wrB = (pn == 8) && (samp || (pm & 63) == 63);
        float sq[2][4];
#pragma unroll
        for (int ai = 0; ai < 2; ++ai)
#pragma unroll
            for (int m = 0; m < 4; ++m) sq[ai][m] = ssq[pm * 256 + ai * 128 + wr * 64 + m * 16 + fr];
        asm volatile("" ::: "memory");
#pragma unroll
        for (int ai = 0; ai < 2; ++ai)
#pragma unroll
            for (int m = 0; m < 4; ++m) {
                const int row = pm * 256 + ai * 128 + wr * 64 + m * 16 + fr;
                const float rstd = __builtin_amdgcn_rsqf(sq[ai][m] * (1.0f / DM) + EPS) * (isq ? QSCALE : 1.0f);
                const int pos = samp ? 2048 + ((row - MP) & 63) : (row & 16383);
#pragma unroll
                for (int bj = 0; bj < 2; ++bj) {
                    const int c0 = pn * 256 + bj * 128 + wc * 32 + 8 * fq;
                    float v[8];
#pragma unroll
                    for (int j = 0; j < 4; ++j) { v[j] = acc[ai][bj][m][0][j] * rstd; v[4 + j] = acc[ai][bj][m][1][j] * rstd; }
                    const bool ropet = (pn == 6 || pn == 7 || (pn == 8 && bj == 0)) && ((wc & 1) == 0);
                    if (ropet) {
                        float pv[8];
#pragma unroll
                        for (int j = 0; j < 8; ++j) pv[j] = __shfl_xor(v[j], 16);
                        if (fq < 2) {
                            const f32x4* cs = (const f32x4*)(rope + (size_t)pos * 16);
                            const float sg = (fq == 0) ? -1.f : 1.f;
#pragma unroll
                            for (int jj = 0; jj < 4; ++jj) { const f32x4 t = cs[jj];
                                v[2 * jj] = v[2 * jj] * t[0] + sg * pv[2 * jj] * t[1];
                                v[2 * jj + 1] = v[2 * jj + 1] * t[2] + sg * pv[2 * jj + 1] * t[3]; }
                        }
                    }
                    v4u w; w.x = cvt_pk(v[0], v[1]); w.y = cvt_pk(v[2], v[3]); w.z = cvt_pk(v[4], v[5]); w.w = cvt_pk(v[6], v[7]);
                    *(v4u*)(Z + (size_t)row * NIN + c0) = w;
                    if (wrA) {
                        const int colA = c0 - (pn < 4 ? 512 : 1024);
                        float* dst;
                        if (samp) { const int rs = row - MP; dst = out + (pn < 4 ? O_AKS : O_AVS) + (size_t)l * 16 * 512 * 512 + ((size_t)((rs >> 6) * 512 + 448 + (rs & 63))) * 512 + colA; }
                        else { const int sq = (row & 16383) - 15872; dst = out + (pn < 4 ? O_AKP : O_AVP) + (size_t)l * 2 * 512 * 512 + ((size_t)((row >> 14) * 512 + sq)) * 512 + colA; }
                        *(f32x4*)dst = (f32x4){v[0], v[1], v[2], v[3]}; *(f32x4*)(dst + 4) = (f32x4){v[4], v[5], v[6], v[7]};
                    }
                    if (wrB && (samp || ai == 1)) {
                        const int colB = c0 - (bj == 0 ? 2048 : 2176);
                        float* dst;
                        if (samp) { const int rs = row - MP; dst = out + (bj == 0 ? O_BKS : O_BVS) + (size_t)l * 16 * 128 * 128 + ((size_t)((rs >> 6) * 128 + 64 + (rs & 63))) * 128 + colB; }
                        else { const int sq = (row & 16383) - 16256; dst = out + (bj == 0 ? O_BKP : O_BVP) + (size_t)l * 2 * 128 * 128 + ((size_t)((row >> 14) * 128 + sq)) * 128 + colB; }
                        *(f32x4*)dst = (f32x4){v[0], v[1], v[2], v[3]}; *(f32x4*)(dst + 4) = (f32x4){v[4], v[5], v[6], v[7]};
                    }
                }
            }
    }
};

#define EPI_ENTRY() GAS unsigned char* wsg_ = (GAS unsigned char*)ws_; GAS float* outg_ = (GAS float*)out_; asm volatile("" : "+s"(wsg_), "+s"(outg_)); unsigned char* ws = (unsigned char*)wsg_; float* out = (float*)outg_; const int lane_ = lane_id(); const int fr = lane_ & 15, fq = lane_ >> 4; (void)ws; (void)out

struct EpiRes {
    static constexpr bool PERM = true;
    unsigned char* ws_; float* out_; const float *xp, *xs; int from_xb; int ssq_off;
    __device__ __forceinline__ void operator()(AccRef acc, const pg8::Unit& u, int wr, int wc, int, int) const {
        EPI_ENTRY();
        bf16* HB = (bf16*)(ws + WS_HB); const bf16* RB = (const bf16*)(ws + (from_xb ? WS_XB : WS_HB)); float* ssq = (float*)(ws + WS_SSQ) + ssq_off;
#pragma unroll
        for (int ai = 0; ai < 2; ++ai) {
            f32x4 r0[4][2], r1[4][2];
            if (xp) {
#pragma unroll
                for (int m = 0; m < 4; ++m) { const int row = u.pm * 256 + ai * 128 + wr * 64 + m * 16 + fr;
                    const float* rsrc = (row < MP) ? xp + (size_t)row * DM : xs + (size_t)(row - MP) * DM;
#pragma unroll
                    for (int bj = 0; bj < 2; ++bj) { const int c0 = u.pn * 256 + bj * 128 + wc * 32 + 8 * fq; r0[m][bj] = *(const f32x4*)(rsrc + c0); r1[m][bj] = *(const f32x4*)(rsrc + c0 + 4); } }
            } else {
                v4u pw[4][2];
#pragma unroll
                for (int m = 0; m < 4; ++m) { const int row = u.pm * 256 + ai * 128 + wr * 64 + m * 16 + fr;
#pragma unroll
                    for (int bj = 0; bj < 2; ++bj) pw[m][bj] = *(const v4u*)(RB + (size_t)row * DM + u.pn * 256 + bj * 128 + wc * 32 + 8 * fq); }
#pragma unroll
                for (int m = 0; m < 4; ++m)
#pragma unroll
                    for (int bj = 0; bj < 2; ++bj) { const v4u w = pw[m][bj]; r0[m][bj] = (f32x4){bf_lo(w.x), bf_hi(w.x), bf_lo(w.y), bf_hi(w.y)}; r1[m][bj] = (f32x4){bf_lo(w.z), bf_hi(w.z), bf_lo(w.w), bf_hi(w.w)}; }
            }
            asm volatile("" ::: "memory");
#pragma unroll
            for (int m = 0; m < 4; ++m) {
                const int row = u.pm * 256 + ai * 128 + wr * 64 + m * 16 + fr;
                float ss = 0.f;
#pragma unroll
                for (int bj = 0; bj < 2; ++bj) {
                    const int c0 = u.pn * 256 + bj * 128 + wc * 32 + 8 * fq;
                    const f32x4 o0 = r0[m][bj] + acc[ai][bj][m][0], o1 = r1[m][bj] + acc[ai][bj][m][1];
                    v4u w; w.x = cvt_pk(o0[0], o0[1]); w.y = cvt_pk(o0[2], o0[3]); w.z = cvt_pk(o1[0], o1[1]); w.w = cvt_pk(o1[2], o1[3]);
                    *(v4u*)(HB + (size_t)row * DM + c0) = w;
                    ss += (o0[0] * o0[0] + o0[1] * o0[1]) + (o0[2] * o0[2] + o0[3] * o0[3]) + (o1[0] * o1[0] + o1[1] * o1[1]) + (o1[2] * o1[2] + o1[3] * o1[3]);
                }
                if (ssq_off >= 0) { ss += __shfl_xor(ss, 16); ss += __shfl_xor(ss, 32); if (fq == 0) __hip_atomic_fetch_add(ssq + row, ss, __ATOMIC_RELAXED, __HIP_MEMORY_SCOPE_AGENT); }
            }
        }
    }
};

typedef float f32x2 __attribute__((ext_vector_type(2)));
struct EpiGU {
    static constexpr bool PERM = true;
    unsigned char* ws_; float* out_; int ssq_off;
    __device__ __forceinline__ void operator()(AccRef acc, const pg8::Unit& u, int wr, int wc, int, int) const {
        EPI_ENTRY();
        bf16* ACT = (bf16*)(ws + WS_ACT); const float* ssq = (const float*)(ws + WS_SSQ) + ssq_off;
        float sq[2][4];
#pragma unroll
        for (int ai = 0; ai < 2; ++ai)
#pragma unroll
            for (int m = 0; m < 4; ++m) sq[ai][m] = ssq[u.pm * 256 + ai * 128 + wr * 64 + m * 16 + fr];
        asm volatile("" ::: "memory");
#pragma unroll
        for (int ai = 0; ai < 2; ++ai)
#pragma unroll
            for (int m = 0; m < 4; ++m) {
                const int row = u.pm * 256 + ai * 128 + wr * 64 + m * 16 + fr;
                const float rstd = __builtin_amdgcn_rsqf(sq[ai][m] * (1.0f / DM) + EPS);
                const float rc = -rstd * LOG2E, r2 = rstd * rstd;
                unsigned pk[4];
#pragma unroll
                for (int n = 0; n < 2; ++n)
#pragma unroll
                    for (int h = 0; h < 2; ++h) {
                        const f32x2 g2 = {acc[ai][0][m][n][2 * h], acc[ai][0][m][n][2 * h + 1]}, u2 = {acc[ai][1][m][n][2 * h], acc[ai][1][m][n][2 * h + 1]};
                        const f32x2 x2 = g2 * rc; f32x2 d2; d2.x = fexp2(x2.x); d2.y = fexp2(x2.y); d2 = d2 + 1.0f;
                        f32x2 q2; q2.x = frcp(d2.x); q2.y = frcp(d2.y);
                        const f32x2 t2 = (g2 * u2) * r2 * q2;
                        pk[2 * n + h] = cvt_pk(t2.x, t2.y);
                    }
                v4u w; w.x = pk[0]; w.y = pk[1]; w.z = pk[2]; w.w = pk[3];
                *(v4u*)(ACT + (size_t)row * FF + u.pn * 128 + wc * 32 + 8 * fq) = w;
            }
    }
};

struct EpiPP {
    static constexpr bool PERM = true;
    unsigned char* ws_; float* out_;
    __device__ __forceinline__ void operator()(AccRef acc, const pg8::Unit& u, int wr, int wc, int, int) const {
        EPI_ENTRY();
        bf16* PP = (bf16*)(ws + WS_XB);
#pragma unroll
        for (int ai = 0; ai < 2; ++ai)
#pragma unroll
            for (int m = 0; m < 4; ++m) {
                const int row = u.pm * 256 + ai * 128 + wr * 64 + m * 16 + fr;
#pragma unroll
                for (int bj = 0; bj < 2; ++bj) {
                    const int c0 = u.pn * 256 + bj * 128 + wc * 32 + 8 * fq;
                    const f32x4 o0 = acc[ai][bj][m][0], o1 = acc[ai][bj][m][1];
                    v4u w; w.x = cvt_pk(o0[0], o0[1]); w.y = cvt_pk(o0[2], o0[3]); w.z = cvt_pk(o1[0], o1[1]); w.w = cvt_pk(o1[2], o1[3]);
                    *(v4u*)(PP + (size_t)row * DM + c0) = w;
                }
            }
    }
};

struct EpiPG {
    static constexpr bool PERM = true;
    unsigned char* ws_; float* out_; int ssq_off;
    __device__ __forceinline__ void operator()(AccRef acc, const pg8::Unit& u, int wr, int wc, int, int) const {
        EPI_ENTRY();
        const bf16* HB = (const bf16*)(ws + WS_HB); bf16* XB = (bf16*)(ws + WS_XB); float* ssq = (float*)(ws + WS_SSQ) + ssq_off;
#pragma unroll
        for (int ai = 0; ai < 2; ++ai) {
            v4u hwv[4][2], pwv[4][2];
#pragma unroll
            for (int m = 0; m < 4; ++m) { const int row = u.pm * 256 + ai * 128 + wr * 64 + m * 16 + fr;
#pragma unroll
                for (int bj = 0; bj < 2; ++bj) { const size_t off = (size_t)row * DM + u.pn * 256 + bj * 128 + wc * 32 + 8 * fq; hwv[m][bj] = *(const v4u*)(HB + off); pwv[m][bj] = *(const v4u*)(XB + off); } }
            asm volatile("" ::: "memory");
#pragma unroll
            for (int m = 0; m < 4; ++m) {
                const int row = u.pm * 256 + ai * 128 + wr * 64 + m * 16 + fr;
                float ss = 0.f;
#pragma unroll
                for (int bj = 0; bj < 2; ++bj) {
                    const int c0 = u.pn * 256 + bj * 128 + wc * 32 + 8 * fq;
                    const v4u hw = hwv[m][bj], pw = pwv[m][bj];
                    const float hh[8] = {bf_lo(hw.x), bf_hi(hw.x), bf_lo(hw.y), bf_hi(hw.y), bf_lo(hw.z), bf_hi(hw.z), bf_lo(hw.w), bf_hi(hw.w)};
                    const float pp[8] = {bf_lo(pw.x), bf_hi(pw.x), bf_lo(pw.y), bf_hi(pw.y), bf_lo(pw.z), bf_hi(pw.z), bf_lo(pw.w), bf_hi(pw.w)};
                    float o[8];
#pragma unroll
                    for (int j = 0; j < 4; ++j) {
                        o[j] = hh[j] + pp[j] * frcp(1.0f + fexp2(-acc[ai][bj][m][0][j] * LOG2E));
                        o[4 + j] = hh[4 + j] + pp[4 + j] * frcp(1.0f + fexp2(-acc[ai][bj][m][1][j] * LOG2E));
                    }
                    v4u w; w.x = cvt_pk(o[0], o[1]); w.y = cvt_pk(o[2], o[3]); w.z = cvt_pk(o[4], o[5]); w.w = cvt_pk(o[6], o[7]);
                    *(v4u*)(XB + (size_t)row * DM + c0) = w;
#pragma unroll
                    for (int j = 0; j < 8; ++j) ss += o[j] * o[j];
                }
                ss += __shfl_xor(ss, 16); ss += __shfl_xor(ss, 32);
                if (fq == 0) __hip_atomic_fetch_add(ssq + row, ss, __ATOMIC_RELAXED, __HIP_MEMORY_SCOPE_AGENT);
            }
        }
    }
};

template <bool GU>
__device__ __forceinline__ void transpose_item(const float* W, int K, int N, bf16* WT, const float* gs, LAS float* scr, int item, int lane) {
    const int nblk = N / 32, kb = item / nblk, nb = item % nblk, k0 = 64 * kb, n0 = 32 * nb;
#pragma unroll 16
    for (int i = 0; i < 32; ++i) { const int kk = 2 * i + (lane >> 5); float w = W[(size_t)(k0 + kk) * N + n0 + (lane & 31)]; if (gs) w *= gs[k0 + kk]; scr[kk * 33 + (lane & 31)] = w; }
    asm volatile("s_waitcnt lgkmcnt(0)" ::: "memory");
    int d0 = n0;
    if (GU) { const int f = (n0 < FF) ? n0 : n0 - FF; d0 = 256 * (f >> 7) + (f & 127) + ((n0 < FF) ? 0 : 128); }
    const int c = lane & 7;
#pragma unroll
    for (int j = 0; j < 4; ++j) { const int n = (lane >> 3) + 8 * j; const LAS float* s = scr + (8 * c) * 33 + n;
        v4u o; o.x = cvt_pk(s[0 * 33], s[1 * 33]); o.y = cvt_pk(s[2 * 33], s[3 * 33]); o.z = cvt_pk(s[4 * 33], s[5 * 33]); o.w = cvt_pk(s[6 * 33], s[7 * 33]);
        *(v4u*)(WT + (size_t)(d0 + n) * K + k0 + 8 * c) = o; }
    asm volatile("s_waitcnt lgkmcnt(0)" ::: "memory");
}

__device__ __forceinline__ void convert_flat(const float* src, bf16* dst, size_t n, size_t gtid, size_t gthreads) {
    for (size_t i = gtid * 8; i < n; i += gthreads * 8) {
        const f32x4 a = *(const f32x4*)(src + i), b = *(const f32x4*)(src + i + 4);
        v4u w; w.x = cvt_pk(a[0], a[1]); w.y = cvt_pk(a[2], a[3]); w.z = cvt_pk(b[0], b[1]); w.w = cvt_pk(b[2], b[3]);
        *(v4u*)(dst + i) = w;
    }
}

constexpr float ATT_THR = 6.0f;
constexpr int AL_V = 0, AL_EXT = 65536, AL_RED = AL_EXT + 26624, AL_UNIT = AL_RED + 2048;
struct AttnArgs { const bf16 *Z, *CKA, *CVA, *CKB, *CVB; const float *sinks, *goa, *gob; bf16* O; unsigned* ctr; };

template <bool ISA>
__device__ __forceinline__ void attn_unit(LAS unsigned char* lds, const AttnArgs& T, int sc, int wave, int) {
    const int lane = lane_id();
    const int fr = lane & 15, fq = lane >> 4;
    const bool samp = sc >= 512;
    const int b = samp ? sc - 512 : sc >> 8, c = samp ? 255 : (sc & 255);
    const int row0 = samp ? MP + b * 64 : b * 16384 + c * 64;
    constexpr int NPREV = ISA ? 8 : 2;
    const int kc0 = (NPREV - c) > 0 ? (NPREV - c) : 0;
    const int hd = wave, kv = wave >> 2;
    const int qcol = ISA ? hd * 64 : 1536 + hd * 64;
    LAS unsigned char* vst = lds + AL_V + wave * 8192;
    const LAS float* ext = (const LAS float*)(lds + AL_EXT) + hd * 832;
    LAS float* red = (LAS float*)(lds + AL_RED);

    bf16x8 qf[4][2];
#pragma unroll
    for (int qb = 0; qb < 4; ++qb)
#pragma unroll
        for (int ks = 0; ks < 2; ++ks) qf[qb][ks] = *(const bf16x8*)((const char*)(T.Z + (size_t)(row0 + 16 * qb) * NIN + qcol + 32 * ks) + (unsigned)((fr * NIN + 8 * fq) * 2));
    f32x4 o[4][4];
#pragma unroll
    for (int db = 0; db < 4; ++db)
#pragma unroll
        for (int qb = 0; qb < 4; ++qb) o[db][qb] = (f32x4){0.f, 0.f, 0.f, 0.f};
    const float sink2 = ISA ? 0.f : T.sinks[hd] * LOG2E;
    float mrow[4], lrow[4];
#pragma unroll
    for (int qb = 0; qb < 4; ++qb) { mrow[qb] = ISA ? -1e30f : sink2; lrow[qb] = 0.f; }

#define ATT_TILE_PTRS(KC, KP, VP, PITCH) do { \
        if (samp && (KC) < NPREV) { \
            if (ISA) { const size_t off_ = ((size_t)(b * 512 + (KC) * 64)) * 512 + hd * 64; KP = T.CKA + off_; VP = T.CVA + off_; PITCH = 512; } \
            else { const size_t off_ = ((size_t)(b * 128 + (KC) * 64)) * 128 + kv * 64; KP = T.CKB + off_; VP = T.CVB + off_; PITCH = 128; } \
        } else { \
            const size_t r_ = (size_t)(row0 - (NPREV - (KC)) * 64) * NIN; \
            KP = T.Z + r_ + (ISA ? 512 + hd * 64 : 2048 + kv * 64); VP = T.Z + r_ + (ISA ? 1024 + hd * 64 : 2176 + kv * 64); PITCH = NIN; \
        } } while (0)
#define ATT_LOAD_K(KP, PITCH) do { _Pragma("unroll") for (int kb = 0; kb < 4; ++kb) { \
        const char* kr_ = (const char*)((KP) + (size_t)(16 * kb) * (PITCH)) + (unsigned)((fr * (PITCH) + 8 * fq) * 2); kf[kb][0] = *(const bf16x8*)kr_; kf[kb][1] = *(const bf16x8*)(kr_ + 64); } } while (0)
    bf16x8 kf[4][2];
    { const bf16 *kp0, *vp0; int pitch0; ATT_TILE_PTRS(kc0, kp0, vp0, pitch0); (void)vp0; ATT_LOAD_K(kp0, pitch0); }
    for (int kc = kc0; kc <= NPREV; ++kc) {
        const bf16 *kp, *vp; int pitch;
        ATT_TILE_PTRS(kc, kp, vp, pitch); (void)kp;
        {
            const unsigned voff = (unsigned)(((lane >> 3) * pitch + (((lane & 7) ^ ((lane >> 3) & 6)) * 8)) * 2);
#pragma unroll
            for (int i = 0; i < 8; ++i)
                __builtin_amdgcn_global_load_lds((const unsigned*)((const char*)(vp + (size_t)(8 * i) * pitch) + voff), (LAS unsigned*)(vst + i * 1024), 16, 0, 0);
        }
        bf16x8 pf[4][2];
#pragma unroll
        for (int qh = 0; qh < 2; ++qh) {
            f32x4 s[4][2];
            const LAS float* eb = ext + (768 + 32 * qh + fr - 64 * kc - 4 * fq);
#pragma unroll
            for (int kb = 0; kb < 4; ++kb)
#pragma unroll
                for (int q2 = 0; q2 < 2; ++q2) {
                    f32x4 c0 = (f32x4){0.f, 0.f, 0.f, 0.f};
                    if (ISA) { const LAS float* e = eb + (16 * q2 - 16 * kb); c0 = (f32x4){e[0], e[-1], e[-2], e[-3]}; }
                    f32x4 t = __builtin_amdgcn_mfma_f32_16x16x32_bf16(kf[kb][0], qf[2 * qh + q2][0], c0, 0, 0, 0);
                    s[kb][q2] = __builtin_amdgcn_mfma_f32_16x16x32_bf16(kf[kb][1], qf[2 * qh + q2][1], t, 0, 0, 0);
                }
            if (qh == 1) { const int kn = kc < NPREV ? kc + 1 : kc; const bf16 *kpn, *vpn; int pitchn; ATT_TILE_PTRS(kn, kpn, vpn, pitchn); (void)vpn; ATT_LOAD_K(kpn, pitchn); }
#pragma unroll
            for (int q2 = 0; q2 < 2; ++q2) {
                const int qb = 2 * qh + q2;
                float mx = fmaxf(fmaxf(s[0][q2][0], s[0][q2][1]), s[0][q2][2]);
                mx = fmaxf(fmaxf(mx, s[0][q2][3]), s[1][q2][0]); mx = fmaxf(fmaxf(mx, s[1][q2][1]), s[1][q2][2]); mx = fmaxf(fmaxf(mx, s[1][q2][3]), s[2][q2][0]);
                mx = fmaxf(fmaxf(mx, s[2][q2][1]), s[2][q2][2]); mx = fmaxf(fmaxf(mx, s[2][q2][3]), s[3][q2][0]); mx = fmaxf(fmaxf(mx, s[3][q2][1]), s[3][q2][2]); mx = fmaxf(mx, s[3][q2][3]);
                if (!__all(mx <= mrow[qb] + ATT_THR)) {
                    mx = fmaxf(mx, __shfl_xor(mx, 16)); mx = fmaxf(mx, __shfl_xor(mx, 32));
                    const float mnew = fmaxf(mrow[qb], mx), alpha = fexp2(mrow[qb] - mnew);
                    mrow[qb] = mnew; lrow[qb] = lrow[qb] * alpha;
#pragma unroll
                    for (int db = 0; db < 4; ++db) o[db][qb] = o[db][qb] * alpha;
                }
                const float mcur = mrow[qb];
                float ps = 0.f; float p[4][4];
#pragma unroll
                for (int kb = 0; kb < 4; ++kb)
#pragma unroll
                    for (int j = 0; j < 4; ++j) { p[kb][j] = fexp2(s[kb][q2][j] - mcur); ps += p[kb][j]; }
                lrow[qb] += ps;
#pragma unroll
                for (int kp2 = 0; kp2 < 2; ++kp2) {
                    v4u w; w.x = cvt_pk(p[2 * kp2][0], p[2 * kp2][1]); w.y = cvt_pk(p[2 * kp2][2], p[2 * kp2][3]);
                    w.z = cvt_pk(p[2 * kp2 + 1][0], p[2 * kp2 + 1][1]); w.w = cvt_pk(p[2 * kp2 + 1][2], p[2 * kp2 + 1][3]);
                    pf[qb][kp2] = __builtin_bit_cast(bf16x8, w);
                }
            }
        }
        asm volatile("s_waitcnt vmcnt(8)" ::: "memory");
        __builtin_amdgcn_wave_barrier();
        const int tq = (lane & 15) >> 2, tp = lane & 3;
#pragma unroll
        for (int kp2 = 0; kp2 < 2; ++kp2) {
            bf16x8 vf[4];
#pragma unroll
            for (int db = 0; db < 4; ++db) {
                const int r8 = 4 * (fq & 1) + tq;
                LAS unsigned char* a0 = vst + (4 * kp2 + (fq >> 1)) * 1024 + r8 * 128 + (((2 * db + (tp >> 1)) ^ (r8 & 6)) * 16) + (tp & 1) * 8;
                const s16x4 lo = __builtin_bit_cast(s16x4, __builtin_amdgcn_ds_read_tr16_b64_v4i16((LAS s16x4*)a0));
                const s16x4 hi = __builtin_bit_cast(s16x4, __builtin_amdgcn_ds_read_tr16_b64_v4i16((LAS s16x4*)(a0 + 2048)));
                vf[db] = (bf16x8){lo[0], lo[1], lo[2], lo[3], hi[0], hi[1], hi[2], hi[3]};
            }
#pragma unroll
            for (int qb = 0; qb < 4; ++qb)
#pragma unroll
                for (int db = 0; db < 4; ++db) o[db][qb] = __builtin_amdgcn_mfma_f32_16x16x32_bf16(vf[db], pf[qb][kp2], o[db][qb], 0, 0, 0);
        }
        asm volatile("" ::: "memory");
    }
#pragma unroll
    for (int qb = 0; qb < 4; ++qb) {
        float lt = lrow[qb]; lt += __shfl_xor(lt, 16); lt += __shfl_xor(lt, 32);
        if (!ISA) lt += fexp2(sink2 - mrow[qb]);
        const float inv = 1.0f / lt; float ss = 0.f;
#pragma unroll
        for (int db = 0; db < 4; ++db) { o[db][qb] = o[db][qb] * inv;
#pragma unroll
            for (int j = 0; j < 4; ++j) ss += o[db][qb][j] * o[db][qb][j]; }
        ss += __shfl_xor(ss, 16); ss += __shfl_xor(ss, 32);
        if (fq == 0) red[wave * 64 + 16 * qb + fr] = ss;
    }
    __syncthreads();
    const float* gout = (ISA ? T.goa : T.gob) + hd * 64 + 4 * (lane_id() >> 4);
    f32x4 gv[4];
#pragma unroll
    for (int db = 0; db < 4; ++db) gv[db] = *(const f32x4*)(gout + 16 * db);
#pragma unroll
    for (int qb = 0; qb < 4; ++qb) {
        float tot = 0.f;
#pragma unroll
        for (int w = 0; w < 8; ++w) tot += red[w * 64 + 16 * qb + fr];
        const float rstd = __builtin_amdgcn_rsqf(tot * (1.0f / 512.0f) + EPS);
        char* orow = (char*)(T.O + (size_t)(row0 + 16 * qb) * DM + (ISA ? 0 : 512) + hd * 64) + (unsigned)((fr * DM + 4 * fq) * 2);
#pragma unroll
        for (int db = 0; db < 4; ++db) { const f32x4 v = o[db][qb] * rstd * gv[db];
            v2u w; w.x = cvt_pk(v[0], v[1]); w.y = cvt_pk(v[2], v[3]); *(v2u*)(orow + 32 * db) = w; }
    }
}

__device__ __forceinline__ void attn_phase(LAS unsigned char* lds, const AttnArgs& T, const float* relb, const int wave) {
    const int lane = lane_id(), tid = wave * 64 + lane;
    LAS float* ext = (LAS float*)(lds + AL_EXT);
    for (int i = tid; i < 8 * 832; i += NWAVES * 64) { const int h = i / 832, k = i % 832; ext[i] = relb[h * 513 + (k < 512 ? k : 512)] * LOG2E; }
    volatile LAS unsigned* uw = (volatile LAS unsigned*)(lds + AL_UNIT);
    int qcur = (int)(blockIdx.x & 7u), qleft = 8;
    for (;;) {
        __syncthreads();
        if (tid == 0) {
            unsigned code = 0xffffffffu;
            while (qleft > 0) {
                const unsigned j = __hip_atomic_fetch_add(T.ctr + 16 * qcur, 1u, __ATOMIC_RELAXED, __HIP_MEMORY_SCOPE_AGENT);
                if (j < 132u) { code = (unsigned)qcur * 132u + j; break; }
                qcur = (qcur + 1) & 7; --qleft;
            }
            uw[0] = code;
        }
        __syncthreads();
        const unsigned u = (unsigned)__builtin_amdgcn_readfirstlane((int)uw[0]);
        if (u == 0xffffffffu) break;
        const int qq = (int)(u / 132u), j = (int)(u % 132u);
        if (j < 66) attn_unit<true>(lds, T, qq * 66 + j, wave, lane); else attn_unit<false>(lds, T, qq * 66 + j - 66, wave, lane);
    }
    __syncthreads();
}

struct Args { const float* in[21]; float* out; unsigned char* ws; };

constexpr size_t WS_SMALL = 768 * 1024, WS_BAR = 2048;
constexpr int SM_RELB = 0, SM_SINK = 8448, SM_GOA = 8512, SM_GOB = 9536, SM_GFIN = 10560, SM_END = 11584;
static_assert(WS_SSQ + (size_t)5 * MT * 4 <= WS_SMALL && WS_SMALL + SM_END * 4 <= WS_ROPE, "control region map");

__device__ __forceinline__ void grid_bar(unsigned* bar, unsigned k, unsigned G, unsigned bid, bool leader) {
    asm volatile("s_waitcnt vmcnt(0) lgkmcnt(0)" ::: "memory");
    __syncthreads();
    if (leader) {
        const unsigned g = bid & 7u, gsz = (G - g + 7u) >> 3, ng = G < 8u ? G : 8u;
        unsigned* gcnt = bar + 16 * (1 + g); unsigned* ggen = bar + 16 * (9 + g); unsigned* top = bar + 16 * 17;
        __builtin_amdgcn_fence(__ATOMIC_RELEASE, "agent");
        asm volatile("s_waitcnt vmcnt(0)" ::: "memory");
        const unsigned old = __hip_atomic_fetch_add(gcnt, 1u, __ATOMIC_RELAXED, __HIP_MEMORY_SCOPE_AGENT);
        if (old + 1u == k * gsz) {
            __hip_atomic_fetch_add(top, 1u, __ATOMIC_RELAXED, __HIP_MEMORY_SCOPE_AGENT);
            while (__hip_atomic_load(top, __ATOMIC_RELAXED, __HIP_MEMORY_SCOPE_AGENT) < k * ng) __builtin_amdgcn_s_sleep(1);
            __hip_atomic_fetch_add(ggen, 1u, __ATOMIC_RELAXED, __HIP_MEMORY_SCOPE_AGENT);
        } else {
            while (__hip_atomic_load(ggen, __ATOMIC_RELAXED, __HIP_MEMORY_SCOPE_AGENT) < k) __builtin_amdgcn_s_sleep(1);
        }
        __builtin_amdgcn_fence(__ATOMIC_ACQUIRE, "agent");
        asm volatile("s_waitcnt vmcnt(0)" ::: "memory");
    }
    __syncthreads();
}

struct PIn { const float *w_in, *w_out, *w_gu, *w_d, *w_pp, *w_pg, *g_mix, *g_ffn, *p_p, *p_s, *cak, *cav, *cbk, *cbv; };

__device__ __forceinline__ void conv_weights(LAS unsigned char* lds, unsigned char* ws, const PIn& I, const int l, const int wave, const int lane, const int gw, const int NGW, const int r_lo, const int r_hi) {
    LAS float* scr = (LAS float*)(lds + wave * 8448);
    constexpr int I_IN = (DM / 64) * (NIN / 32), I_OUT = (DM / 64) * (DM / 32), I_GU = (DM / 64) * (2 * FF / 32), I_D = (FF / 64) * (DM / 32), I_PP = (DPLE / 64) * (DM / 32), I_PG = I_OUT;
    constexpr int I_LAYER = I_IN + I_OUT + I_GU + I_D + I_PP + I_PG;
    unsigned char* wb = ws + WS_W + (size_t)l * W_LAYER;
    for (int it = r_lo + gw; it < (r_hi < I_LAYER ? r_hi : I_LAYER); it += NGW) {
        int r = it;
        if (r < I_IN) { transpose_item<false>(I.w_in + (size_t)l * DM * NIN, DM, NIN, (bf16*)(wb + W_IN), I.g_mix + l * DM, scr, r, lane); continue; } r -= I_IN;
        if (r < I_OUT) { transpose_item<false>(I.w_out + (size_t)l * DM * DM, DM, DM, (bf16*)(wb + W_OUT), nullptr, scr, r, lane); continue; } r -= I_OUT;
        if (r < I_GU) { transpose_item<true>(I.w_gu + (size_t)l * DM * 2 * FF, DM, 2 * FF, (bf16*)(wb + W_GU), I.g_ffn + l * DM, scr, r, lane); continue; } r -= I_GU;
        if (r < I_D) { transpose_item<false>(I.w_d + (size_t)l * FF * DM, FF, DM, (bf16*)(wb + W_D), nullptr, scr, r, lane); continue; } r -= I_D;
        if (r < I_PP) { transpose_item<false>(I.w_pp + (size_t)l * DPLE * DM, DPLE, DM, (bf16*)(wb + W_PP), nullptr, scr, r, lane); continue; } r -= I_PP;
        transpose_item<false>(I.w_pg + (size_t)l * DM * DM, DM, DM, (bf16*)(wb + W_PG), nullptr, scr, r, lane);
    }
}
__device__ __forceinline__ void conv_p_caches(unsigned char* ws, float* out, const PIn& I, const int l, const size_t gtid, const size_t gth, const int part = 3) {
    bf16* PB = (bf16*)(ws + WS_PB);
    if (part & 1) {
    convert_flat(I.p_p + (size_t)l * MP * DPLE, PB + (size_t)l * MT * DPLE, (size_t)MP * DPLE, gtid, gth);
    convert_flat(I.p_s + (size_t)l * MS * DPLE, PB + (size_t)l * MT * DPLE + (size_t)MP * DPLE, (size_t)MS * DPLE, gtid, gth);
    }
    if (!(part & 2)) return;
    constexpr size_t NA = (size_t)16 * 512 * 512, NB = (size_t)16 * 128 * 128;
    for (size_t i = gtid * 8; i < NA; i += gth * 8) {
        const size_t gi = (size_t)l * NA + i;
        const f32x4 a = *(const f32x4*)(I.cak + gi), b = *(const f32x4*)(I.cak + gi + 4), c = *(const f32x4*)(I.cav + gi), d = *(const f32x4*)(I.cav + gi + 4);
        v4u w; w.x = cvt_pk(a[0], a[1]); w.y = cvt_pk(a[2], a[3]); w.z = cvt_pk(b[0], b[1]); w.w = cvt_pk(b[2], b[3]);
        *(v4u*)((bf16*)(ws + WS_CKA) + gi) = w;
        w.x = cvt_pk(c[0], c[1]); w.y = cvt_pk(c[2], c[3]); w.z = cvt_pk(d[0], d[1]); w.w = cvt_pk(d[2], d[3]);
        *(v4u*)((bf16*)(ws + WS_CVA) + gi) = w;
        if (((i >> 9) & 511) >= 64) { float* dk = out + O_AKS + gi - 32768; float* dv = out + O_AVS + gi - 32768;
            *(f32x4*)dk = a; *(f32x4*)(dk + 4) = b; *(f32x4*)dv = c; *(f32x4*)(dv + 4) = d; }
    }
    for (size_t i = gtid * 8; i < NB; i += gth * 8) {
        const size_t gi = (size_t)l * NB + i;
        const f32x4 a = *(const f32x4*)(I.cbk + gi), b = *(const f32x4*)(I.cbk + gi + 4), c = *(const f32x4*)(I.cbv + gi), d = *(const f32x4*)(I.cbv + gi + 4);
        v4u w; w.x = cvt_pk(a[0], a[1]); w.y = cvt_pk(a[2], a[3]); w.z = cvt_pk(b[0], b[1]); w.w = cvt_pk(b[2], b[3]);
        *(v4u*)((bf16*)(ws + WS_CKB) + gi) = w;
        w.x = cvt_pk(c[0], c[1]); w.y = cvt_pk(c[2], c[3]); w.z = cvt_pk(d[0], d[1]); w.w = cvt_pk(d[2], d[3]);
        *(v4u*)((bf16*)(ws + WS_CVB) + gi) = w;
        if (((i >> 7) & 127) >= 64) { float* dk = out + O_BKS + gi - 8192; float* dv = out + O_BVS + gi - 8192;
            *(f32x4*)dk = a; *(f32x4*)(dk + 4) = b; *(f32x4*)dv = c; *(f32x4*)(dv + 4) = d; }
    }
}

template <int l>
__device__ __forceinline__ void run_layer(LAS unsigned char* lds, unsigned char* ws_in, float* out_in, const float* x_p, const float* x_s, const PIn* pin, const int G, const int bid, const int wave) {
    GAS unsigned char* wsg_ = (GAS unsigned char*)ws_in; GAS float* outg_ = (GAS float*)out_in; asm volatile("" : "+s"(wsg_), "+s"(outg_));
    unsigned char* ws = (unsigned char*)wsg_; float* out = (float*)outg_;
    unsigned* const bar = (unsigned*)(ws + WS_BAR);
#define GRID_BAR(k) grid_bar(bar, (unsigned)((k) + 1), (unsigned)G, (unsigned)bid, wave == 0 && lane_id() == 0)
        unsigned char* wb = ws + WS_W + (size_t)l * W_LAYER;
        bf16 *XB = (bf16*)(ws + WS_XB), *HB = (bf16*)(ws + WS_HB), *O = (bf16*)(ws + WS_O), *ACT = (bf16*)(ws + WS_ACT);
        {
            pg8::RowOrder<NIN / 256> S; S.init(G, bid);
            EpiIn E{ws, out, (l == 0) ? 0 : 2 * MT, l};
            pg8::gemm_phase<DM, EpiIn, pg8::RowOrder<NIN / 256>>(lds, XB, (const bf16*)(wb + W_IN), S, E, wave);
            if (l == 0) {
                const int nbusy = (MT / 256 * (NIN / 256)) % G;
                if (S.v >= nbusy) { const int lane = lane_id(); const PIn I = *pin;
                    conv_p_caches(ws, out, I, 0, (size_t)(S.v - nbusy) * (NWAVES * 64) + wave * 64 + lane, (size_t)(G - nbusy) * (NWAVES * 64)); }
            }
        }
        GRID_BAR(6 * l + 1);
        {
            const float* sm = (const float*)(ws + WS_SMALL);
            AttnArgs T{(const bf16*)(ws + WS_Z), (const bf16*)(ws + WS_CKA) + (size_t)l * 16 * 512 * 512, (const bf16*)(ws + WS_CVA) + (size_t)l * 16 * 512 * 512,
                       (const bf16*)(ws + WS_CKB) + (size_t)l * 16 * 128 * 128, (const bf16*)(ws + WS_CVB) + (size_t)l * 16 * 128 * 128,
                       sm + SM_SINK + l * 8, sm + SM_GOA + l * 512, sm + SM_GOB + l * 512, O, (unsigned*)(ws + WS_CTL) + 128 * l};
            attn_phase(lds, T, sm + SM_RELB + (size_t)l * 8 * 513, wave);
        }
        GRID_BAR(6 * l + 2);
        {
            pg8::RowOrder<DM / 256> S; S.init(G, bid);
            EpiRes E{ws, out, nullptr, nullptr, 1, (1 + 2 * l) * MT};
            pg8::gemm_phase<DM, EpiRes, pg8::RowOrder<DM / 256>>(lds, O, (const bf16*)(wb + W_OUT), S, E, wave);
            if (l == 0) {
                const int nbusy = (MT / 256 * 4) % G;
                if (S.v >= nbusy) { const int lane = lane_id(); const PIn I = *pin; __syncthreads();
                    conv_weights(lds, ws, I, 0, wave, lane, (S.v - nbusy) * NWAVES + wave, (G - nbusy) * NWAVES, W_ITEMS_EARLY, 1 << 30); }
            }
        }
        GRID_BAR(6 * l + 3);
        {
            pg8::RowOrder<2 * FF / 256> S; S.init(G, bid);
            EpiGU E{ws, out, (1 + 2 * l) * MT};
            pg8::gemm_phase<DM, EpiGU, pg8::RowOrder<2 * FF / 256>>(lds, HB, (const bf16*)(wb + W_GU), S, E, wave);
            if (l == 0) {
                const int nbusy = (MT / 256 * (2 * FF / 256)) % G;
                if (S.v >= nbusy) { const int lane = lane_id(); const PIn I = *pin;
                    conv_p_caches(ws, out, I, 1, (size_t)(S.v - nbusy) * (NWAVES * 64) + wave * 64 + lane, (size_t)(G - nbusy) * (NWAVES * 64), 1); }
            }
        }
        GRID_BAR(6 * l + 4);
        {
            pg8::RowOrder<DM / 256> S; S.init(G, bid);
            EpiRes E{ws, out, nullptr, nullptr, 0, -1};
            pg8::gemm_phase<FF, EpiRes, pg8::RowOrder<DM / 256>>(lds, ACT, (const bf16*)(wb + W_D), S, E, wave);
            pg8::RowOrderSkip<DM / 256> S2; S2.init(G, bid, (G > 16) ? (MT / 256 * 4) % G : 0);
            EpiPP E2{ws, out};
            pg8::gemm_phase<DPLE, EpiPP, pg8::RowOrderSkip<DM / 256>>(lds, (const bf16*)(ws + WS_PB) + (size_t)l * MT * DPLE, (const bf16*)(wb + W_PP), S2, E2, wave);
            if (l == 0) {
                const int nbusy = (MT / 256 * 4) % G;
                if (S.v >= nbusy) { const int lane = lane_id(); const PIn I = *pin; __syncthreads();
                    conv_weights(lds, ws, I, 1, wave, lane, (S.v - nbusy) * NWAVES + wave, (G - nbusy) * NWAVES, 0, 1 << 30); }
            }
        }
        GRID_BAR(6 * l + 5);
        {
            pg8::RowOrder<DM / 256> S; S.init(G, bid);
            EpiPG E{ws, out, (2 + 2 * l) * MT};
            pg8::gemm_phase<DM, EpiPG, pg8::RowOrder<DM / 256>>(lds, HB, (const bf16*)(wb + W_PG), S, E, wave);
            if (l == 0) {
                const int nbusy = (MT / 256 * 4) % G;
                if (S.v >= nbusy) { const int lane = lane_id(); const PIn I = *pin;
                    conv_p_caches(ws, out, I, 1, (size_t)(S.v - nbusy) * (NWAVES * 64) + wave * 64 + lane, (size_t)(G - nbusy) * (NWAVES * 64), 2); }
            }
        }
        GRID_BAR(6 * l + 6);
    }
#undef GRID_BAR

__global__ void __launch_bounds__(NWAVES * 64, 2) mega_fwd(Args args) {
    extern __shared__ __attribute__((aligned(16))) unsigned char lds_raw[];
    LAS unsigned char* lds = (LAS unsigned char*)lds_raw;
    const int wave = __builtin_amdgcn_readfirstlane((int)threadIdx.x >> 6);
    const int G = gridDim.x, bid = blockIdx.x;
    unsigned char* const ws = args.ws;
    float* const out = args.out;
    float* const H = out + O_Y;

    if (args.ws == nullptr) cg::this_grid().sync();
    {
        const float *x_p = args.in[0], *x_s = args.in[1], *p_p = args.in[2], *p_s = args.in[3], *cak = args.in[4], *cav = args.in[5], *cbk = args.in[6], *cbv = args.in[7],
                    *g_mix = args.in[8], *w_in = args.in[9], *relb = args.in[10], *sinks = args.in[11], *goa = args.in[12], *gob = args.in[13], *w_out = args.in[14],
                    *g_ffn = args.in[15], *w_gu = args.in[16], *w_d = args.in[17], *w_pp = args.in[18], *w_pg = args.in[19], *g_fin = args.in[20];
        float* ssqb = (float*)(ws + WS_SSQ);
        float* rope = (float*)(ws + WS_ROPE);
        float* sm = (float*)(ws + WS_SMALL);
        bf16 *XB = (bf16*)(ws + WS_XB), *PB = (bf16*)(ws + WS_PB);
        const int lane = lane_id(), tid = wave * 64 + lane;
        const int gw = bid * NWAVES + wave, NGW = G * NWAVES;
        const size_t gtid = (size_t)bid * (NWAVES * 64) + tid, gth = (size_t)G * (NWAVES * 64);
        const PIn I{w_in, w_out, w_gu, w_d, w_pp, w_pg, g_mix, g_ffn, p_p, p_s, cak, cav, cbk, cbv};
        conv_weights(lds, ws, I, 0, wave, lane, gw, NGW, 0, W_ITEMS_EARLY);
        for (int m0 = gw; m0 < MT; m0 += 2 * NGW) {
            const int m1 = m0 + NGW; const bool has1 = m1 < MT;
            const float* xr0 = (m0 < MP) ? x_p + (size_t)m0 * DM : x_s + (size_t)(m0 - MP) * DM;
            const float* xr1 = has1 ? ((m1 < MP) ? x_p + (size_t)m1 * DM : x_s + (size_t)(m1 - MP) * DM) : xr0;
            f32x4 a[2][4];
#pragma unroll
            for (int j = 0; j < 2; ++j) { a[0][2 * j] = *(const f32x4*)(xr0 + j * 512 + lane * 8); a[0][2 * j + 1] = *(const f32x4*)(xr0 + j * 512 + lane * 8 + 4);
                                          a[1][2 * j] = *(const f32x4*)(xr1 + j * 512 + lane * 8); a[1][2 * j + 1] = *(const f32x4*)(xr1 + j * 512 + lane * 8 + 4); }
#pragma unroll
            for (int r = 0; r < 2; ++r) {
                const int m = r ? m1 : m0; float ss = 0.f;
#pragma unroll
                for (int j = 0; j < 2; ++j) { const f32x4 p = a[r][2 * j], q = a[r][2 * j + 1];
                    ss += (p[0] * p[0] + p[1] * p[1]) + (p[2] * p[2] + p[3] * p[3]) + (q[0] * q[0] + q[1] * q[1]) + (q[2] * q[2] + q[3] * q[3]);
                    v4u w; w.x = cvt_pk(p[0], p[1]); w.y = cvt_pk(p[2], p[3]); w.z = cvt_pk(q[0], q[1]); w.w = cvt_pk(q[2], q[3]);
                    if (r == 0 || has1) *(v4u*)(XB + (size_t)m * DM + j * 512 + lane * 8) = w; }
#pragma unroll
                for (int o = 1; o < 64; o <<= 1) ss += __shfl_xor(ss, o);
                if (lane == 0 && (r == 0 || has1)) ssqb[m] = ss;
            }
        }
        for (size_t i = gtid; i < (size_t)16384 * 8; i += gth) {
            const int pos = (int)(i >> 3), j = (int)(i & 7);
            const double rv = (j == 0) ? 0.15915494309189535 : (j == 1) ? 0.03086376340470123 : (j == 2) ? 0.005985185712713705 : (j == 3) ? 0.001160663641240061 :
                              (j == 4) ? 0.00022507907903927653 : (j == 5) ? 4.364795279280289e-05 : (j == 6) ? 8.464330808241401e-06 : 1.6414262627950345e-06;
            const double t = (double)pos * rv; const float fr_ = (float)(t - __builtin_floor(t));
            rope[2 * i] = __builtin_amdgcn_cosf(fr_); rope[2 * i + 1] = __builtin_amdgcn_sinf(fr_);
        }
        for (size_t i = gtid; i < (size_t)SM_END; i += gth) {
            float v = 0.f; const int k = (int)i;
            if (k < 2 * 8 * 513) v = relb[k];
            else if (k >= SM_SINK && k < SM_SINK + 16) v = sinks[k - SM_SINK];
            else if (k >= SM_GOA && k < SM_GOB) v = goa[k - SM_GOA];
            else if (k >= SM_GOB && k < SM_GFIN) v = gob[k - SM_GOB];
            else if (k >= SM_GFIN) v = g_fin[k - SM_GFIN];
            sm[k] = v;
        }
        for (size_t i = gtid; i < (size_t)4 * MT; i += gth) ssqb[MT + i] = 0.f;
        if (gtid < 256) ((unsigned*)(ws + WS_CTL))[gtid] = 0u;
    }
    grid_bar((unsigned*)(ws + WS_BAR), 1u, (unsigned)G, (unsigned)bid, wave == 0 && lane_id() == 0);

    const float* const x_p = args.in[0]; const float* const x_s = args.in[1];
    const PIn pin{args.in[9], args.in[14], args.in[16], args.in[17], args.in[18], args.in[19], args.in[8], args.in[15], args.in[2], args.in[3], args.in[4], args.in[5], args.in[6], args.in[7]};
    run_layer<0>(lds, ws, out, x_p, x_s, &pin, G, bid, wave);
    run_layer<1>(lds, ws, out, x_p, x_s, &pin, G, bid, wave);
    {
        const int lane = lane_id();
        const int gw = bid * NWAVES + wave, NGW = G * NWAVES;
        const float* ssq = (const float*)(ws + WS_SSQ) + 4 * (size_t)MT;
        const float* g_fin = (const float*)(ws + WS_SMALL) + SM_GFIN;
        const bf16* XB = (const bf16*)(ws + WS_XB);
        f32x4 gf[2][2];
#pragma unroll
        for (int j = 0; j < 2; ++j) { gf[j][0] = *(const f32x4*)(g_fin + j * 512 + lane * 8); gf[j][1] = *(const f32x4*)(g_fin + j * 512 + lane * 8 + 4); }
        for (int m = gw; m < MT; m += NGW) {
            const float rstd = __builtin_amdgcn_rsqf(ssq[m] * (1.0f / DM) + EPS);
            float* yr = H + (size_t)m * DM;
#pragma unroll
            for (int j = 0; j < 2; ++j) {
                const v4u w = *(const v4u*)(XB + (size_t)m * DM + j * 512 + lane * 8);
                const f32x4 a = (f32x4){bf_lo(w.x), bf_hi(w.x), bf_lo(w.y), bf_hi(w.y)}, b2 = (f32x4){bf_lo(w.z), bf_hi(w.z), bf_lo(w.w), bf_hi(w.w)};
                *(f32x4*)(yr + j * 512 + lane * 8) = a * rstd * gf[j][0]; *(f32x4*)(yr + j * 512 + lane * 8 + 4) = b2 * rstd * gf[j][1];
            }
        }
    }
}

extern "C" void kernel_launch(void* const* d_in, const int* in_sizes, int n_in, void* d_out, int out_size, void* d_ws, size_t ws_size, hipStream_t stream) {
    static int grid = 0;
    if (grid == 0) {
        if (n_in != 21 || (size_t)out_size != O_END || ws_size < WS_END) { fprintf(stderr, "kernel_launch: unexpected problem: n_in %d out %d ws %zu (need out %zu ws %zu)\n", n_in, out_size, ws_size, (size_t)O_END, (size_t)WS_END); grid = -1; return; }
        int dev = 0, cus = 0, per_cu = 0;
        (void)hipGetDevice(&dev);
        (void)hipDeviceGetAttribute(&cus, hipDeviceAttributeMultiprocessorCount, dev);
        if (hipFuncSetAttribute((const void*)mega_fwd, hipFuncAttributeMaxDynamicSharedMemorySize, LDS_BYTES) != hipSuccess) { fprintf(stderr, "kernel_launch: hipFuncSetAttribute failed\n"); grid = -1; return; }
        if (hipOccupancyMaxActiveBlocksPerMultiprocessor(&per_cu, (const void*)mega_fwd, NWAVES * 64, LDS_BYTES) != hipSuccess || per_cu < 1) { fprintf(stderr, "kernel_launch: occupancy query says %d blocks per CU\n", per_cu); (void)hipGetLastError(); per_cu = 1; }
        grid = cus * 1;
        if (grid <= 0) { grid = -1; return; }
    }
    if (grid < 0) return;
    (void)hipMemsetAsync((unsigned char*)d_ws + WS_BAR, 0, 2048, stream);
    Args a{};
    for (int i = 0; i < 21; ++i) a.in[i] = (const float*)d_in[i];
    a.out = (float*)d_out; a.ws = (unsigned char*)d_ws;
    void* kargs[] = {&a};
    hipError_t e = hipLaunchCooperativeKernel((const void*)mega_fwd, dim3(grid), dim3(NWAVES * 64), kargs, LDS_BYTES, stream);
    if (e != hipSuccess) fprintf(stderr, "kernel_launch: cooperative launch failed: %s (grid %d)\n", hipGetErrorString(e), grid);
}
```

```cpp
#include <hip/hip_runtime.h>
#include <hip/hip_cooperative_groups.h>
#include <cstdio>
#include <cstdint>
namespace cg = cooperative_groups;

#define GAS __attribute__((address_space(1)))
#define LAS __attribute__((address_space(3)))
typedef unsigned short bf16;
typedef unsigned v4u __attribute__((ext_vector_type(4)));
typedef unsigned v2u __attribute__((ext_vector_type(2)));
typedef float f32x4 __attribute__((ext_vector_type(4)));
typedef short bf16x8 __attribute__((ext_vector_type(8)));
typedef short s16x4 __attribute__((ext_vector_type(4)));

constexpr int MP = 32768, MS = 1024, MT = MP + MS;
constexpr int DM = 1024, NIN = 2304, FF = 2816, DPLE = 256;
constexpr float EPS = 1e-6f;
constexpr float LOG2E = 1.4426950408889634f;
constexpr float QSCALE = 0.125f * LOG2E;

__device__ __forceinline__ unsigned cvt_pk(float lo, float hi) { unsigned r; asm("v_cvt_pk_bf16_f32 %0, %1, %2" : "=v"(r) : "v"(lo), "v"(hi)); return r; }
__device__ __forceinline__ float bf_lo(unsigned w) { return __builtin_bit_cast(float, w << 16); }
__device__ __forceinline__ float bf_hi(unsigned w) { return __builtin_bit_cast(float, w & 0xffff0000u); }
__device__ __forceinline__ float fexp2(float x) { return __builtin_amdgcn_exp2f(x); }
__device__ __forceinline__ float frcp(float x) { return __builtin_amdgcn_rcpf(x); }

__device__ __forceinline__ int lane_id() { int l = __builtin_amdgcn_mbcnt_hi(~0u, __builtin_amdgcn_mbcnt_lo(~0u, 0u)); asm volatile("" : "+v"(l)); return l; }

namespace pg8 {
constexpr int BM = 256, BK = 64, HALF = 128, HTB = HALF * BK * 2, STAGE_BYTES = 8 * HTB, NXCD = 8, WGM = 8;
__host__ __device__ __forceinline__ int lds_byte(int r, int c) { const int st = (r >> 4) * 2 + (c >> 5), rr = r & 15, cc = c & 31, ob = rr * 64 + cc * 2; return st * 1024 + (ob ^ (((ob >> 9) & 1) << 5)); }
__host__ __device__ __forceinline__ void stage_rc(int b, int& R, int& C) { const int st = b / 1024, sb = b % 1024, swz = sb ^ (((sb >> 9) & 1) << 5); R = (st >> 1) * 16 + swz / 64; C = (st & 1) * 32 + (swz % 64) / 2; }
__host__ __device__ __forceinline__ int perm32(int rho) { const int n = rho >> 4, i = rho & 15; return 8 * (i >> 2) + 4 * n + (i & 3); }

struct Unit { int pm, pn; };
struct Gemm { const bf16* A; const bf16* Bt; int M, N, K; };

template <int NN>
struct RowOrder {
    int G, v;
    __device__ __forceinline__ void init(int G_, int c) { G = G_; v = (G_ % 8 == 0) ? (c % 8) * (G_ / 8) + c / 8 : c; }
    __device__ __forceinline__ bool next(int i, Unit& u) const {
        const int L = i * G + v; if (L >= (33792 / BM) * NN) return false;
        constexpr int NM = 33792 / BM, NFULL = (NM / 8) * 8 * NN;
        if (L < NFULL) { const int g = L / (8 * NN), idx = L % (8 * NN); u.pm = g * 8 + (idx & 7); u.pn = idx >> 3; }
        else { constexpr int GS = NM % 8 ? NM % 8 : 8; const int idx = L - NFULL; u.pm = (NM / 8) * 8 + idx % GS; u.pn = idx / GS; }
        return true;
    }
};

template <int NN>
struct RowOrderSkip {
    int G, v, nskip;
    __device__ __forceinline__ void init(int G_, int c, int nskip_) { G = G_; nskip = nskip_; v = (G_ % 8 == 0) ? (c % 8) * (G_ / 8) + c / 8 : c; }
    __device__ __forceinline__ bool next(int i, Unit& u) const {
        if (v < nskip) return false;
        const int L = i * (G - nskip) + (v - nskip); if (L >= (33792 / BM) * NN) return false;
        constexpr int NM = 33792 / BM, NFULL = (NM / 8) * 8 * NN;
        if (L < NFULL) { const int g = L / (8 * NN), idx = L % (8 * NN); u.pm = g * 8 + (idx & 7); u.pn = idx >> 3; }
        else { constexpr int GS = NM % 8 ? NM % 8 : 8; const int idx = L - NFULL; u.pm = (NM / 8) * 8 + idx % GS; u.pn = idx / GS; }
        return true;
    }
};

template <int KK, class Epi, class Sched, bool ALIGN_EPI = true>
__device__ __forceinline__ void gemm_phase(LAS unsigned char* lds, const bf16* gA, const bf16* gBt, const Sched& S, const Epi& E, const int wid) {
    const int lane = lane_id();
    const int tid = wid * 64 + lane, wr = wid >> 2, wc = wid & 3, fr = lane & 15, fq = lane >> 4;
    constexpr int K = KK, nt = K / BK;
    unsigned voffA[2], voffB[2];
#pragma unroll
    for (int i = 0; i < 2; ++i) { int R, C; stage_rc(tid * 16 + i * 8192, R, C); const int Rb = Epi::PERM ? ((R & ~31) + perm32(R & 31)) : R;
        voffA[i] = (unsigned)(R * K + C) * 2u; voffB[i] = (unsigned)(Rb * K + C) * 2u; }
    const size_t kstep = (size_t)(BK * 2);
    const size_t hstep = (size_t)HALF * K * 2;
    const size_t tstep = 2 * hstep;
    const unsigned ldsw = (unsigned)wid * 1024u;
    const int aoff = lds_byte(wr * 64 + fr, fq * 8), boff = lds_byte(wc * 32 + fr, fq * 8);
#define PG8_SA(b, h) (((b) * 2 + (h)) * HTB)
#define PG8_SB(b, h) ((4 + (b) * 2 + (h)) * HTB)
#define PG8_STAGE(bufoff, gbase, voff) do { _Pragma("unroll") for (int _i = 0; _i < 2; ++_i) \
        __builtin_amdgcn_global_load_lds((const unsigned*)((const char*)(gbase) + (voff)[_i]), (LAS unsigned*)(lds + (bufoff) + ldsw + _i * 8192), 16, 0, 0); } while (0)
#define PG8_LDA(dst, b, h) do { _Pragma("unroll") for (int m = 0; m < 4; ++m) _Pragma("unroll") for (int k = 0; k < 2; ++k) dst[m][k] = *(const LAS bf16x8*)(lds + PG8_SA(b, h) + aoff + m * 2048 + k * 1024); } while (0)
#define PG8_LDB(dst, b, h) do { _Pragma("unroll") for (int n = 0; n < 2; ++n) _Pragma("unroll") for (int k = 0; k < 2; ++k) dst[n][k] = *(const LAS bf16x8*)(lds + PG8_SB(b, h) + boff + n * 2048 + k * 1024); } while (0)
#define PG8_MMA(ai, bj, At, Bt) do { __builtin_amdgcn_s_setprio(1); _Pragma("unroll") for (int m = 0; m < 4; ++m) _Pragma("unroll") for (int n = 0; n < 2; ++n) _Pragma("unroll") for (int k = 0; k < 2; ++k) \
        acc[ai][bj][m][n] = __builtin_amdgcn_mfma_f32_16x16x32_bf16(Bt[n][k], At[m][k], acc[ai][bj][m][n], 0, 0, 0); __builtin_amdgcn_s_setprio(0); } while (0)
#define PG8_WAIT_V(n) asm volatile("s_waitcnt vmcnt(" #n ")" ::: "memory")
#define PG8_WAIT_L(n) asm volatile("s_waitcnt lgkmcnt(" #n ")" ::: "memory")
#define PG8_BAR __builtin_amdgcn_s_barrier()
#define PG8_SCHED __builtin_amdgcn_sched_barrier(0)
    Unit cur, nxt; int ui = 0;
    if (!S.next(0, cur)) return;
    f32x4 acc[2][2][4][2];
#pragma unroll
    for (int a = 0; a < 2; ++a)
#pragma unroll
        for (int b = 0; b < 2; ++b)
#pragma unroll
            for (int m = 0; m < 4; ++m)
#pragma unroll
                for (int n = 0; n < 2; ++n) acc[a][b][m][n] = (f32x4){0.f, 0.f, 0.f, 0.f};
    bf16x8 At[4][2], B0[2][2], B1[2][2];
    const char* cA = (const char*)gA + (size_t)cur.pm * tstep; const char* cB = (const char*)gBt + (size_t)cur.pn * tstep;
    PG8_STAGE(PG8_SB(0, 0), cB, voffB); PG8_STAGE(PG8_SB(0, 1), cB + hstep, voffB); PG8_STAGE(PG8_SA(0, 0), cA, voffA); PG8_STAGE(PG8_SA(0, 1), cA + hstep, voffA);
    PG8_STAGE(PG8_SB(1, 0), cB + kstep, voffB); PG8_STAGE(PG8_SA(1, 0), cA + kstep, voffA); PG8_STAGE(PG8_SB(1, 1), cB + hstep + kstep, voffB);
    if (wr == 1) PG8_BAR;
    PG8_WAIT_V(8); PG8_BAR;
    PG8_WAIT_V(6); PG8_BAR;
    for (;;) {
        const bool has_next = S.next(ui + 1, nxt);
        const char* nA = has_next ? (const char*)gA + (size_t)nxt.pm * tstep : cA; const char* nB = has_next ? (const char*)gBt + (size_t)nxt.pn * tstep : cB;
#pragma unroll 1
        for (int t = 0; t < nt; t += 2) {
            const bool last = (t == nt - 2);
            const char* a1 = cA + (size_t)(t + 1) * kstep;
            const char* a2 = last ? nA : cA + (size_t)(t + 2) * kstep; const char* b2 = last ? nB : cB + (size_t)(t + 2) * kstep;
            const char* a3 = a2 + kstep; const char* b3 = b2 + kstep;
            PG8_LDB(B0, 0, 0); PG8_LDB(B1, 0, 1); PG8_SCHED; PG8_LDA(At, 0, 0); PG8_STAGE(PG8_SA(1, 1), a1 + hstep, voffA);
            PG8_WAIT_V(8); PG8_WAIT_L(0); PG8_BAR; PG8_MMA(0, 0, At, B0); PG8_MMA(0, 1, At, B1); PG8_BAR; PG8_SCHED;
            PG8_LDA(At, 0, 1); PG8_STAGE(PG8_SB(0, 0), b2, voffB); PG8_STAGE(PG8_SB(0, 1), b2 + hstep, voffB); PG8_STAGE(PG8_SA(0, 0), a2, voffA);
            PG8_WAIT_V(8); PG8_WAIT_L(0); PG8_BAR; PG8_MMA(1, 0, At, B0); PG8_MMA(1, 1, At, B1); PG8_BAR; PG8_SCHED;
            PG8_LDB(B0, 1, 0); PG8_LDB(B1, 1, 1); PG8_SCHED; PG8_LDA(At, 1, 0); PG8_STAGE(PG8_SA(0, 1), a2 + hstep, voffA);
            PG8_WAIT_V(8); PG8_WAIT_L(0); PG8_BAR; PG8_MMA(0, 0, At, B0); PG8_MMA(0, 1, At, B1); PG8_BAR; PG8_SCHED;
            PG8_LDA(At, 1, 1); PG8_STAGE(PG8_SB(1, 0), b3, voffB); PG8_STAGE(PG8_SB(1, 1), b3 + hstep, voffB); PG8_STAGE(PG8_SA(1, 0), a3, voffA);
            PG8_WAIT_V(8); PG8_WAIT_L(0); PG8_BAR; PG8_MMA(1, 0, At, B0); PG8_MMA(1, 1, At, B1); PG8_BAR; PG8_SCHED;
        }
        if constexpr (ALIGN_EPI) { if (wr == 0) PG8_BAR; }
        E(acc, cur, wr, wc, fr, fq);
        if (!has_next) break;
#pragma unroll
        for (int a = 0; a < 2; ++a)
#pragma unroll
            for (int b = 0; b < 2; ++b)
#pragma unroll
                for (int m = 0; m < 4; ++m)
#pragma unroll
                    for (int n = 0; n < 2; ++n) acc[a][b][m][n] = (f32x4){0.f, 0.f, 0.f, 0.f};
        cur = nxt; cA = nA; cB = nB; ++ui;
        if constexpr (ALIGN_EPI) { if (wr == 1) PG8_BAR; }
    }
    PG8_WAIT_V(0);
    if constexpr (!ALIGN_EPI) { if (wr == 0) PG8_BAR; }
    PG8_BAR;
#undef PG8_SA
#undef PG8_SB
#undef PG8_STAGE
#undef PG8_LDA
#undef PG8_LDB
#undef PG8_MMA
#undef PG8_WAIT_V
#undef PG8_WAIT_L
#undef PG8_BAR
#undef PG8_SCHED
}
}

constexpr size_t MiB = 1u << 20;
constexpr size_t WS_CTL = 0;
constexpr size_t WS_SSQ = 4096;
constexpr size_t WS_ROPE = 1 * MiB;
constexpr size_t WS_W = 2 * MiB;
constexpr size_t W_IN = 0, W_OUT = W_IN + (size_t)NIN * DM * 2, W_GU = W_OUT + (size_t)DM * DM * 2, W_D = W_GU + (size_t)2 * FF * DM * 2,
                 W_PP = W_D + (size_t)DM * FF * 2, W_PG = W_PP + (size_t)DM * DPLE * 2, W_LAYER = W_PG + (size_t)DM * DM * 2;
constexpr size_t WS_XB = WS_W + 2 * W_LAYER + MiB;
constexpr size_t ACT_DM = (size_t)MT * DM * 2;
constexpr size_t WS_HB = WS_XB + ACT_DM;
constexpr size_t WS_Z = WS_HB + ACT_DM;
constexpr size_t WS_O = WS_Z + (size_t)MT * NIN * 2;
constexpr size_t WS_ACT = WS_Z;
constexpr size_t WS_PB = WS_O + ACT_DM;
constexpr size_t WS_CKA = WS_PB + (size_t)2 * MT * DPLE * 2;
constexpr size_t CA_BYTES = (size_t)2 * 16 * 512 * 512 * 2, CB_BYTES = (size_t)2 * 16 * 128 * 128 * 2;
constexpr size_t WS_CVA = WS_CKA + CA_BYTES, WS_CKB = WS_CVA + CA_BYTES, WS_CVB = WS_CKB + CB_BYTES, WS_END = WS_CVB + CB_BYTES;
static_assert((size_t)MT * FF * 2 <= (size_t)MT * NIN * 2 + ACT_DM, "ACT overlay fits Z|O");
static_assert(WS_END <= 512 * MiB, "workspace map");

constexpr size_t O_Y = 0, O_AKP = (size_t)MT * DM, O_AVP = O_AKP + 2 * 2 * 512 * 512, O_BKP = O_AVP + 2 * 2 * 512 * 512, O_BVP = O_BKP + 2 * 2 * 128 * 128,
                 O_AKS = O_BVP + 2 * 2 * 128 * 128, O_AVS = O_AKS + (size_t)2 * 16 * 512 * 512, O_BKS = O_AVS + (size_t)2 * 16 * 512 * 512, O_BVS = O_BKS + 2 * 16 * 128 * 128,
                 O_END = O_BVS + 2 * 16 * 128 * 128;

constexpr int LDS_BYTES = 131072 + 4096;
constexpr int W_ITEMS_EARLY = (DM / 64) * (NIN / 32) + (DM / 64) * (DM / 32);
constexpr int NWAVES = 8;

typedef const f32x4 (&AccRef)[2][2][4][2];

struct EpiIn {
    static constexpr bool PERM = true;
    unsigned char* ws_; float* out_; int ssq_off; int l;
    __device__ __forceinline__ void operator()(AccRef acc, const pg8::Unit& u, int wr, int wc, int, int) const {
        GAS unsigned char* wsg_ = (GAS unsigned char*)ws_; GAS float* outg_ = (GAS float*)out_; asm volatile("" : "+s"(wsg_), "+s"(outg_)); unsigned char* ws = (unsigned char*)wsg_; float* out = (float*)outg_;
        const int lane_ = lane_id(); const int fr = lane_ & 15, fq = lane_ >> 4;
        const float* ssq = (const float*)(ws + WS_SSQ) + ssq_off;
        const int pn = u.pn, pm = u.pm;
        const bool samp = pm >= (MP / 256);
        const bool isq = (pn < 2) || (pn == 6) || (pn == 7);
        bf16* Z = (bf16*)(ws + WS_Z); const float* rope = (const float*)(ws + WS_ROPE);
        const bool wrA = (pn >= 2 && pn <= 5) && (samp || (pm & 63) >= 62);
        const bool wrB = (pn == 8) && (samp || (pm & 63) == 63);
        float sq[2][4];
#pragma unroll
        for (int ai = 0; ai < 2; ++ai)
#pragma unroll
            for (int m = 0; m < 4; ++m) sq[ai][m] = ssq[pm * 256 + ai * 128 + wr * 64 + m * 16 + fr];
        asm volatile("" ::: "memory");
#pragma unroll
        for (int ai = 0; ai < 2; ++ai)
#pragma unroll
            for (int m = 0; m < 4; ++m) {
                const int row = pm * 256 + ai * 128 + wr * 64 + m * 16 + fr;
                const float rstd = __builtin_amdgcn_rsqf(sq[ai][m] * (1.0f / DM) + EPS) * (isq ? QSCALE : 1.0f);
                const int pos = samp ? 2048 + ((row - MP) & 63) : (row & 16383);
#pragma unroll
                for (int bj = 0; bj < 2; ++bj) {
                    const int c0 = pn * 256 + bj * 128 + wc * 32 + 8 * fq;
                    float v[8];
#pragma unroll
                    for (int j = 0; j < 4; ++j) { v[j] = acc[ai][bj][m][0][j] * rstd; v[4 + j] = acc[ai][bj][m][1][j] * rstd; }
                    const bool ropet = (pn == 6 || pn == 7 || (pn == 8 && bj == 0)) && ((wc & 1) == 0);
                    if (ropet) {
                        float pv[8];
#pragma unroll
                        for (int j = 0; j < 8; ++j) pv[j] = __shfl_xor(v[j], 16);
                        if (fq < 2) {
                            const f32x4* cs = (const f32x4*)(rope + (size_t)pos * 16);
                            const float sg = (fq == 0) ? -1.f : 1.f;
#pragma unroll
                            for (int jj = 0; jj < 4; ++jj) { const f32x4 t = cs[jj];
                                v[2 * jj] = v[2 * jj] * t[0] + sg * pv[2 * jj] * t[1];
                                v[2 * jj + 1] = v[2 * jj + 1] * t[2] + sg * pv[2 * jj + 1] * t[3]; }
                        }
                    }
                    v4u w; w.x = cvt_pk(v[0], v[1]); w.y = cvt_pk(v[2], v[3]); w.z = cvt_pk(v[4], v[5]); w.w = cvt_pk(v[6], v[7]);
                    *(v4u*)(Z + (size_t)row * NIN + c0) = w;
                    if (wrA) {
                        const int colA = c0 - (pn < 4 ? 512 : 1024);
                        float* dst;
                        if (samp) { const int rs = row - MP; dst = out + (pn < 4 ? O_AKS : O_AVS) + (size_t)l * 16 * 512 * 512 + ((size_t)((rs >> 6) * 512 + 448 + (rs & 63))) * 512 + colA; }
                        else { const int sq = (row & 16383) - 15872; dst = out + (pn < 4 ? O_AKP : O_AVP) + (size_t)l * 2 * 512 * 512 + ((size_t)((row >> 14) * 512 + sq)) * 512 + colA; }
                        *(f32x4*)dst = (f32x4){v[0], v[1], v[2], v[3]}; *(f32x4*)(dst + 4) = (f32x4){v[4], v[5], v[6], v[7]};
                    }
                    if (wrB && (samp || ai == 1)) {
                        const int colB = c0 - (bj == 0 ? 2048 : 2176);
                        float* dst;
                        if (samp) { const int rs = row - MP; dst = out + (bj == 0 ? O_BKS : O_BVS) + (size_t)l * 16 * 128 * 128 + ((size_t)((rs >> 6) * 128 + 64 + (rs & 63))) * 128 + colB; }
                        else { const int sq = (row & 16383) - 16256; dst = out + (bj == 0 ? O_BKP : O_BVP) + (size_t)l * 2 * 128 * 128 + ((size_t)((row >> 14) * 128 + sq)) * 128 + colB; }
                        *(f32x4*)dst = (f32x4){v[0], v[1], v[2], v[3]}; *(f32x4*)(dst + 4) = (f32x4){v[4], v[5], v[6], v[7]};
                    }
                }
            }
    }
};

#define EPI_ENTRY() GAS unsigned char* wsg_ = (GAS unsigned char*)ws_; GAS float* outg_ = (GAS float*)out_; asm volatile("" : "+s"(wsg_), "+s"(outg_)); unsigned char* ws = (unsigned char*)wsg_; float* out = (float*)outg_; const int lane_ = lane_id(); const int fr = lane_ & 15, fq = lane_ >> 4; (void)ws; (void)out

struct EpiRes {
    static constexpr bool PERM = true;
    unsigned char* ws_; float* out_; const float *xp, *xs; int from_xb; int ssq_off;
    __device__ __forceinline__ void operator()(AccRef acc, const pg8::Unit& u, int wr, int wc, int, int) const {
        EPI_ENTRY();
        bf16* HB = (bf16*)(ws + WS_HB); const bf16* RB = (const bf16*)(ws + (from_xb ? WS_XB : WS_HB)); float* ssq = (float*)(ws + WS_SSQ) + ssq_off;
#pragma unroll
        for (int ai = 0; ai < 2; ++ai) {
            f32x4 r0[4][2], r1[4][2];
            if (xp) {
#pragma unroll
                for (int m = 0; m < 4; ++m) { const int row = u.pm * 256 + ai * 128 + wr * 64 + m * 16 + fr;
                    const float* rsrc = (row < MP) ? xp + (size_t)row * DM : xs + (size_t)(row - MP) * DM;
#pragma unroll
                    for (int bj = 0; bj < 2; ++bj) { const int c0 = u.pn * 256 + bj * 128 + wc * 32 + 8 * fq; r0[m][bj] = *(const f32x4*)(rsrc + c0); r1[m][bj] = *(const f32x4*)(rsrc + c0 + 4); } }
            } else {
                v4u pw[4][2];
#pragma unroll
                for (int m = 0; m < 4; ++m) { const int row = u.pm * 256 + ai * 128 + wr * 64 + m * 16 + fr;
#pragma unroll
                    for (int bj = 0; bj < 2; ++bj) pw[m][bj] = *(const v4u*)(RB + (size_t)row * DM + u.pn * 256 + bj * 128 + wc * 32 + 8 * fq); }
#pragma unroll
                for (int m = 0; m < 4; ++m)
#pragma unroll
                    for (int bj = 0; bj < 2; ++bj) { const v4u w = pw[m][bj]; r0[m][bj] = (f32x4){bf_lo(w.x), bf_hi(w.x), bf_lo(w.y), bf_hi(w.y)}; r1[m][bj] = (f32x4){bf_lo(w.z), bf_hi(w.z), bf_lo(w.w), bf_hi(w.w)}; }
            }
            asm volatile("" ::: "memory");
#pragma unroll
            for (int m = 0; m < 4; ++m) {
                const int row = u.pm * 256 + ai * 128 + wr * 64 + m * 16 + fr;
                float ss = 0.f;
#pragma unroll
                for (int bj = 0; bj < 2; ++bj) {
                    const int c0 = u.pn * 256 + bj * 128 + wc * 32 + 8 * fq;
                    const f32x4 o0 = r0[m][bj] + acc[ai][bj][m][0], o1 = r1[m][bj] + acc[ai][bj][m][1];
                    v4u w; w.x = cvt_pk(o0[0], o0[1]); w.y = cvt_pk(o0[2], o0[3]); w.z = cvt_pk(o1[0], o1[1]); w.w = cvt_pk(o1[2], o1[3]);
                    *(v4u*)(HB + (size_t)row * DM + c0) = w;
                    ss += (o0[0] * o0[0] + o0[1] * o0[1]) + (o0[2] * o0[2] + o0[3] * o0[3]) + (o1[0] * o1[0] + o1[1] * o1[1]) + (o1[2] * o1[2] + o1[3] * o1[3]);
                }
                if (ssq_off >= 0) { ss += __shfl_xor(ss, 16); ss += __shfl_xor(ss, 32); if (fq == 0) __hip_atomic_fetch_add(ssq + row, ss, __ATOMIC_RELAXED, __HIP_MEMORY_SCOPE_AGENT); }
            }
        }
    }
};

typedef float f32x2 __attribute__((ext_vector_type(2)));
struct EpiGU {
    static constexpr bool PERM = true;
    unsigned char* ws_; float* out_; int ssq_off;
    __device__ __forceinline__ void operator()(AccRef acc, const pg8::Unit& u, int wr, int wc, int, int) const {
        EPI_ENTRY();
        bf16* ACT = (bf16*)(ws + WS_ACT); const float* ssq = (const float*)(ws + WS_SSQ) + ssq_off;
        float sq[2][4];
#pragma unroll
        for (int ai = 0; ai < 2; ++ai)
#pragma unroll
            for (int m = 0; m < 4; ++m) sq[ai][m] = ssq[u.pm * 256 + ai * 128 + wr * 64 + m * 16 + fr];
        asm volatile("" ::: "memory");
#pragma unroll
        for (int ai = 0; ai < 2; ++ai)
#pragma unroll
            for (int m = 0; m < 4; ++m) {
                const int row = u.pm * 256 + ai * 128 + wr * 64 + m * 16 + fr;
                const float rstd = __builtin_amdgcn_rsqf(sq[ai][m] * (1.0f / DM) + EPS);
                const float rc = -rstd * LOG2E, r2 = rstd * rstd;
                unsigned pk[4];
#pragma unroll
                for (int n = 0; n < 2; ++n)
#pragma unroll
                    for (int h = 0; h < 2; ++h) {
                        const f32x2 g2 = {acc[ai][0][m][n][2 * h], acc[ai][0][m][n][2 * h + 1]}, u2 = {acc[ai][1][m][n][2 * h], acc[ai][1][m][n][2 * h + 1]};
                        const f32x2 x2 = g2 * rc; f32x2 d2; d2.x = fexp2(x2.x); d2.y = fexp2(x2.y); d2 = d2 + 1.0f;
                        f32x2 q2; q2.x = frcp(d2.x); q2.y = frcp(d2.y);
                        const f32x2 t2 = (g2 * u2) * r2 * q2;
                        pk[2 * n + h] = cvt_pk(t2.x, t2.y);
                    }
                v4u w; w.x = pk[0]; w.y = pk[1]; w.z = pk[2]; w.w = pk[3];
                *(v4u*)(ACT + (size_t)row * FF + u.pn * 128 + wc * 32 + 8 * fq) = w;
            }
    }
};

struct EpiPP {
    static constexpr bool PERM = true;
    unsigned char* ws_; float* out_;
    __device__ __forceinline__ void operator()(AccRef acc, const pg8::Unit& u, int wr, int wc, int, int) const {
        EPI_ENTRY();
        bf16* PP = (bf16*)(ws + WS_XB);
#pragma unroll
        for (int ai = 0; ai < 2; ++ai)
#pragma unroll
            for (int m = 0; m < 4; ++m) {
                const int row = u.pm * 256 + ai * 128 + wr * 64 + m * 16 + fr;
#pragma unroll
                for (int bj = 0; bj < 2; ++bj) {
                    const int c0 = u.pn * 256 + bj * 128 + wc * 32 + 8 * fq;
                    const f32x4 o0 = acc[ai][bj][m][0], o1 = acc[ai][bj][m][1];
                    v4u w; w.x = cvt_pk(o0[0], o0[1]); w.y = cvt_pk(o0[2], o0[3]); w.z = cvt_pk(o1[0], o1[1]); w.w = cvt_pk(o1[2], o1[3]);
                    *(v4u*)(PP + (size_t)row * DM + c0) = w;
                }
            }
    }
};

struct EpiPG {
    static constexpr bool PERM = true;
    unsigned char* ws_; float* out_; int ssq_off;
    __device__ __forceinline__ void operator()(AccRef acc, const pg8::Unit& u, int wr, int wc, int, int) const {
        EPI_ENTRY();
        const bf16* HB = (const bf16*)(ws + WS_HB); bf16* XB = (bf16*)(ws + WS_XB); float* ssq = (float*)(ws + WS_SSQ) + ssq_off;
#pragma unroll
        for (int ai = 0; ai < 2; ++ai) {
            v4u hwv[4][2], pwv[4][2];
#pragma unroll
            for (int m = 0; m < 4; ++m) { const int row = u.pm * 256 + ai * 128 + wr * 64 + m * 16 + fr;
#pragma unroll
                for (int bj = 0; bj < 2; ++bj) { const size_t off = (size_t)row * DM + u.pn * 256 + bj * 128 + wc * 32 + 8 * fq; hwv[m][bj] = *(const v4u*)(HB + off); pwv[m][bj] = *(const v4u*)(XB + off); } }
            asm volatile("" ::: "memory");
#pragma unroll
            for (int m = 0; m < 4; ++m) {
                const int row = u.pm * 256 + ai * 128 + wr * 64 + m * 16 + fr;
                float ss = 0.f;
#pragma unroll
                for (int bj = 0; bj < 2; ++bj) {
                    const int c0 = u.pn * 256 + bj * 128 + wc * 32 + 8 * fq;
                    const v4u hw = hwv[m][bj], pw = pwv[m][bj];
                    const float hh[8] = {bf_lo(hw.x), bf_hi(hw.x), bf_lo(hw.y), bf_hi(hw.y), bf_lo(hw.z), bf_hi(hw.z), bf_lo(hw.w), bf_hi(hw.w)};
                    const float pp[8] = {bf_lo(pw.x), bf_hi(pw.x), bf_lo(pw.y), bf_hi(pw.y), bf_lo(pw.z), bf_hi(pw.z), bf_lo(pw.w), bf_hi(pw.w)};
                    float o[8];
#pragma unroll
                    for (int j = 0; j < 4; ++j) {
                        o[j] = hh[j] + pp[j] * frcp(1.0f + fexp2(-acc[ai][bj][m][0][j] * LOG2E));
                        o[4 + j] = hh[4 + j] + pp[4 + j] * frcp(1.0f + fexp2(-acc[ai][bj][m][1][j] * LOG2E));
                    }
                    v4u w; w.x = cvt_pk(o[0], o[1]); w.y = cvt_pk(o[2], o[3]); w.z = cvt_pk(o[4], o[5]); w.w = cvt_pk(o[6], o[7]);
                    *(v4u*)(XB + (size_t)row * DM + c0) = w;
#pragma unroll
                    for (int j = 0; j < 8; ++j) ss += o[j] * o[j];
                }
                ss += __shfl_xor(ss, 16); ss += __shfl_xor(ss, 32);
                if (fq == 0) __hip_atomic_fetch_add(ssq + row, ss, __ATOMIC_RELAXED, __HIP_MEMORY_SCOPE_AGENT);
            }
        }
    }
};

template <bool GU>
__device__ __forceinline__ void transpose_item(const float* W, int K, int N, bf16* WT, const float* gs, LAS float* scr, int item, int lane) {
    const int nblk = N / 32, kb = item / nblk, nb = item % nblk, k0 = 64 * kb, n0 = 32 * nb;
#pragma unroll 16
    for (int i = 0; i < 32; ++i) { const int kk = 2 * i + (lane >> 5); float w = W[(size_t)(k0 + kk) * N + n0 + (lane & 31)]; if (gs) w *= gs[k0 + kk]; scr[kk * 33 + (lane & 31)] = w; }
    asm volatile("s_waitcnt lgkmcnt(0)" ::: "memory");
    int d0 = n0;
    if (GU) { const int f = (n0 < FF) ? n0 : n0 - FF; d0 = 256 * (f >> 7) + (f & 127) + ((n0 < FF) ? 0 : 128); }
    const int c = lane & 7;
#pragma unroll
    for (int j = 0; j < 4; ++j) { const int n = (lane >> 3) + 8 * j; const LAS float* s = scr + (8 * c) * 33 + n;
        v4u o; o.x = cvt_pk(s[0 * 33], s[1 * 33]); o.y = cvt_pk(s[2 * 33], s[3 * 33]); o.z = cvt_pk(s[4 * 33], s[5 * 33]); o.w = cvt_pk(s[6 * 33], s[7 * 33]);
        *(v4u*)(WT + (size_t)(d0 + n) * K + k0 + 8 * c) = o; }
    asm volatile("s_waitcnt lgkmcnt(0)" ::: "memory");
}

__device__ __forceinline__ void convert_flat(const float* src, bf16* dst, size_t n, size_t gtid, size_t gthreads) {
    for (size_t i = gtid * 8; i < n; i += gthreads * 8) {
        const f32x4 a = *(const f32x4*)(src + i), b = *(const f32x4*)(src + i + 4);
        v4u w; w.x = cvt_pk(a[0], a[1]); w.y = cvt_pk(a[2], a[3]); w.z = cvt_pk(b[0], b[1]); w.w = cvt_pk(b[2], b[3]);
        *(v4u*)(dst + i) = w;
    }
}

constexpr float ATT_THR = 6.0f;
constexpr int AL_V = 0, AL_EXT = 65536, AL_RED = AL_EXT + 26624, AL_UNIT = AL_RED + 2048;
struct AttnArgs { const bf16 *Z, *CKA, *CVA, *CKB, *CVB; const float *sinks, *goa, *gob; bf16* O; unsigned* ctr; };

template <bool ISA>
__device__ __forceinline__ void attn_unit(LAS unsigned char* lds, const AttnArgs& T, int sc, int wave, int) {
    const int lane = lane_id();
    const int fr = lane & 15, fq = lane >> 4;
    const bool samp = sc >= 512;
    const int b = samp ? sc - 512 : sc >> 8, c = samp ? 255 : (sc & 255);
    const int row0 = samp ? MP + b * 64 : b * 16384 + c * 64;
    constexpr int NPREV = ISA ? 8 : 2;
    const int kc0 = (NPREV - c) > 0 ? (NPREV - c) : 0;
    const int hd = wave, kv = wave >> 2;
    const int qcol = ISA ? hd * 64 : 1536 + hd * 64;
    LAS unsigned char* vst = lds + AL_V + wave * 8192;
    const LAS float* ext = (const LAS float*)(lds + AL_EXT) + hd * 832;
    LAS float* red = (LAS float*)(lds + AL_RED);

    bf16x8 qf[4][2];
#pragma unroll
    for (int qb = 0; qb < 4; ++qb)
#pragma unroll
        for (int ks = 0; ks < 2; ++ks) qf[qb][ks] = *(const bf16x8*)((const char*)(T.Z + (size_t)(row0 + 16 * qb) * NIN + qcol + 32 * ks) + (unsigned)((fr * NIN + 8 * fq) * 2));
    f32x4 o[4][4];
#pragma unroll
    for (int db = 0; db < 4; ++db)
#pragma unroll
        for (int qb = 0; qb < 4; ++qb) o[db][qb] = (f32x4){0.f, 0.f, 0.f, 0.f};
    const float sink2 = ISA ? 0.f : T.sinks[hd] * LOG2E;
    float mrow[4], lrow[4];
#pragma unroll
    for (int qb = 0; qb < 4; ++qb) { mrow[qb] = ISA ? -1e30f : sink2; lrow[qb] = 0.f; }

#define ATT_TILE_PTRS(KC, KP, VP, PITCH) do { \
        if (samp && (KC) < NPREV) { \
            if (ISA) { const size_t off_ = ((size_t)(b * 512 + (KC) * 64)) * 512 + hd * 64; KP = T.CKA + off_; VP = T.CVA + off_; PITCH = 512; } \
            else { const size_t off_ = ((size_t)(b * 128 + (KC) * 64)) * 128 + kv * 64; KP = T.CKB + off_; VP = T.CVB + off_; PITCH = 128; } \
        } else { \
            const size_t r_ = (size_t)(row0 - (NPREV - (KC)) * 64) * NIN; \
            KP = T.Z + r_ + (ISA ? 512 + hd * 64 : 2048 + kv * 64); VP = T.Z + r_ + (ISA ? 1024 + hd * 64 : 2176 + kv * 64); PITCH = NIN; \
        } } while (0)
#define ATT_LOAD_K(KP, PITCH) do { _Pragma("unroll") for (int kb = 0; kb < 4; ++kb) { \
        const char* kr_ = (const char*)((KP) + (size_t)(16 * kb) * (PITCH)) + (unsigned)((fr * (PITCH) + 8 * fq) * 2); kf[kb][0] = *(const bf16x8*)kr_; kf[kb][1] = *(const bf16x8*)(kr_ + 64); } } while (0)
    bf16x8 kf[4][2];
    { const bf16 *kp0, *vp0; int pitch0; ATT_TILE_PTRS(kc0, kp0, vp0, pitch0); (void)vp0; ATT_LOAD_K(kp0, pitch0); }
    for (int kc = kc0; kc <= NPREV; ++kc) {
        const bf16 *kp, *vp; int pitch;
        ATT_TILE_PTRS(kc, kp, vp, pitch); (void)kp;
        {
            const unsigned voff = (unsigned)(((lane >> 3) * pitch + (((lane & 7) ^ ((lane >> 3) & 6)) * 8)) * 2);
#pragma unroll
            for (int i = 0; i < 8; ++i)
                __builtin_amdgcn_global_load_lds((const unsigned*)((const char*)(vp + (size_t)(8 * i) * pitch) + voff), (LAS unsigned*)(vst + i * 1024), 16, 0, 0);
        }
        bf16x8 pf[4][2];
#pragma unroll
        for (int qh = 0; qh < 2; ++qh) {
            f32x4 s[4][2];
            const LAS float* eb = ext + (768 + 32 * qh + fr - 64 * kc - 4 * fq);
#pragma unroll
            for (int kb = 0; kb < 4; ++kb)
#pragma unroll
                for (int q2 = 0; q2 < 2; ++q2) {
                    f32x4 c0 = (f32x4){0.f, 0.f, 0.f, 0.f};
                    if (ISA) { const LAS float* e = eb + (16 * q2 - 16 * kb); c0 = (f32x4){e[0], e[-1], e[-2], e[-3]}; }
                    f32x4 t = __builtin_amdgcn_mfma_f32_16x16x32_bf16(kf[kb][0], qf[2 * qh + q2][0], c0, 0, 0, 0);
                    s[kb][q2] = __builtin_amdgcn_mfma_f32_16x16x32_bf16(kf[kb][1], qf[2 * qh + q2][1], t, 0, 0, 0);
                }
            if (qh == 1) { const int kn = kc < NPREV ? kc + 1 : kc; const bf16 *kpn, *vpn; int pitchn; ATT_TILE_PTRS(kn, kpn, vpn, pitchn); (void)vpn; ATT_LOAD_K(kpn, pitchn); }
#pragma unroll
            for (int q2 = 0; q2 < 2; ++q2) {
                const int qb = 2 * qh + q2;
                float mx = fmaxf(fmaxf(s[0][q2][0], s[0][q2][1]), s[0][q2][2]);
                mx = fmaxf(fmaxf(mx, s[0][q2][3]), s[1][q2][0]); mx = fmaxf(fmaxf(mx, s[1][q2][1]), s[1][q2][2]); mx = fmaxf(fmaxf(mx, s[1][q2][3]), s[2][q2][0]);
                mx = fmaxf(fmaxf(mx, s[2][q2][1]), s[2][q2][2]); mx = fmaxf(fmaxf(mx, s[2][q2][3]), s[3][q2][0]); mx = fmaxf(fmaxf(mx, s[3][q2][1]), s[3][q2][2]); mx = fmaxf(mx, s[3][q2][3]);
                if (!__all(mx <= mrow[qb] + ATT_THR)) {
                    mx = fmaxf(mx, __shfl_xor(mx, 16)); mx = fmaxf(mx, __shfl_xor(mx, 32));
                    const float mnew = fmaxf(mrow[qb], mx), alpha = fexp2(mrow[qb] - mnew);
                    mrow[qb] = mnew; lrow[qb] = lrow[qb] * alpha;
#pragma unroll
                    for (int db = 0; db < 4; ++db) o[db][qb] = o[db][qb] * alpha;
                }
                const float mcur = mrow[qb];
                float ps = 0.f; float p[4][4];
#pragma unroll
                for (int kb = 0; kb < 4; ++kb)
#pragma unroll
                    for (int j = 0; j < 4; ++j) { p[kb][j] = fexp2(s[kb][q2][j] - mcur); ps += p[kb][j]; }
                lrow[qb] += ps;
#pragma unroll
                for (int kp2 = 0; kp2 < 2; ++kp2) {
                    v4u w; w.x = cvt_pk(p[2 * kp2][0], p[2 * kp2][1]); w.y = cvt_pk(p[2 * kp2][2], p[2 * kp2][3]);
                    w.z = cvt_pk(p[2 * kp2 + 1][0], p[2 * kp2 + 1][1]); w.w = cvt_pk(p[2 * kp2 + 1][2], p[2 * kp2 + 1][3]);
                    pf[qb][kp2] = __builtin_bit_cast(bf16x8, w);
                }
            }
        }
        asm volatile("s_waitcnt vmcnt(8)" ::: "memory");
        __builtin_amdgcn_wave_barrier();
        const int tq = (lane & 15) >> 2, tp = lane & 3;
#pragma unroll
        for (int kp2 = 0; kp2 < 2; ++kp2) {
            bf16x8 vf[4];
#pragma unroll
            for (int db = 0; db < 4; ++db) {
                const int r8 = 4 * (fq & 1) + tq;
                LAS unsigned char* a0 = vst + (4 * kp2 + (fq >> 1)) * 1024 + r8 * 128 + (((2 * db + (tp >> 1)) ^ (r8 & 6)) * 16) + (tp & 1) * 8;
                const s16x4 lo = __builtin_bit_cast(s16x4, __builtin_amdgcn_ds_read_tr16_b64_v4i16((LAS s16x4*)a0));
                const s16x4 hi = __builtin_bit_cast(s16x4, __builtin_amdgcn_ds_read_tr16_b64_v4i16((LAS s16x4*)(a0 + 2048)));
                vf[db] = (bf16x8){lo[0], lo[1], lo[2], lo[3], hi[0], hi[1], hi[2], hi[3]};
            }
#pragma unroll
            for (int qb = 0; qb < 4; ++qb)
#pragma unroll
                for (int db = 0; db < 4; ++db) o[db][qb] = __builtin_amdgcn_mfma_f32_16x16x32_bf16(vf[db], pf[qb][kp2], o[db][qb], 0, 0, 0);
        }
        asm volatile("" ::: "memory");
    }
#pragma unroll
    for (int qb = 0; qb < 4; ++qb) {
        float lt = lrow[qb]; lt += __shfl_xor(lt, 16); lt += __shfl_xor(lt, 32);
        if (!ISA) lt += fexp2(sink2 - mrow[qb]);
        const float inv = 1.0f / lt; float ss = 0.f;
#pragma unroll
        for (int db = 0; db < 4; ++db) { o[db][qb] = o[db][qb] * inv;
#pragma unroll
            for (int j = 0; j < 4; ++j) ss += o[db][qb][j] * o[db][qb][j]; }
        ss += __shfl_xor(ss, 16); ss += __shfl_xor(ss, 32);
        if (fq == 0) red[wave * 64 + 16 * qb + fr] = ss;
    }
    __syncthreads();
    const float* gout = (ISA ? T.goa : T.gob) + hd * 64 + 4 * (lane_id() >> 4);
    f32x4 gv[4];
#pragma unroll
    for (int db = 0; db < 4; ++db) gv[db] = *(const f32x4*)(gout + 16 * db);
#pragma unroll
    for (int qb = 0; qb < 4; ++qb) {
        float tot = 0.f;
#pragma unroll
        for (int w = 0; w < 8; ++w) tot += red[w * 64 + 16 * qb + fr];
        const float rstd = __builtin_amdgcn_rsqf(tot * (1.0f / 512.0f) + EPS);
        char* orow = (char*)(T.O + (size_t)(row0 + 16 * qb) * DM + (ISA ? 0 : 512) + hd * 64) + (unsigned)((fr * DM + 4 * fq) * 2);
#pragma unroll
        for (int db = 0; db < 4; ++db) { const f32x4 v = o[db][qb] * rstd * gv[db];
            v2u w; w.x = cvt_pk(v[0], v[1]); w.y = cvt_pk(v[2], v[3]); *(v2u*)(orow + 32 * db) = w; }
    }
}

__device__ __forceinline__ void attn_phase(LAS unsigned char* lds, const AttnArgs& T, const float* relb, const int wave) {
    const int lane = lane_id(), tid = wave * 64 + lane;
    LAS float* ext = (LAS float*)(lds + AL_EXT);
    for (int i = tid; i < 8 * 832; i += NWAVES * 64) { const int h = i / 832, k = i % 832; ext[i] = relb[h * 513 + (k < 512 ? k : 512)] * LOG2E; }
    volatile LAS unsigned* uw = (volatile LAS unsigned*)(lds + AL_UNIT);
    int qcur = (int)(blockIdx.x & 7u), qleft = 8;
    for (;;) {
        __syncthreads();
        if (tid == 0) {
            unsigned code = 0xffffffffu;
            while (qleft > 0) {
                const unsigned j = __hip_atomic_fetch_add(T.ctr + 16 * qcur, 1u, __ATOMIC_RELAXED, __HIP_MEMORY_SCOPE_AGENT);
                if (j < 132u) { code = (unsigned)qcur * 132u + j; break; }
                qcur = (qcur + 1) & 7; --qleft;
            }
            uw[0] = code;
        }
        __syncthreads();
        const unsigned u = (unsigned)__builtin_amdgcn_readfirstlane((int)uw[0]);
        if (u == 0xffffffffu) break;
        const int qq = (int)(u / 132u), j = (int)(u % 132u);
        if (j < 66) attn_unit<true>(lds, T, qq * 66 + j, wave, lane); else attn_unit<false>(lds, T, qq * 66 + j - 66, wave, lane);
    }
    __syncthreads();
}

struct Args { const float* in[21]; float* out; unsigned char* ws; };

constexpr size_t WS_SMALL = 768 * 1024, WS_BAR = 2048;
constexpr int SM_RELB = 0, SM_SINK = 8448, SM_GOA = 8512, SM_GOB = 9536, SM_GFIN = 10560, SM_END = 11584;
static_assert(WS_SSQ + (size_t)5 * MT * 4 <= WS_SMALL && WS_SMALL + SM_END * 4 <= WS_ROPE, "control region map");

__device__ __forceinline__ void grid_bar(unsigned* bar, unsigned k, unsigned G, unsigned bid, bool leader) {
    asm volatile("s_waitcnt vmcnt(0) lgkmcnt(0)" ::: "memory");
    __syncthreads();
    if (leader) {
        const unsigned g = bid & 7u, gsz = (G - g + 7u) >> 3, ng = G < 8u ? G : 8u;
        unsigned* gcnt = bar + 16 * (1 + g); unsigned* ggen = bar + 16 * (9 + g); unsigned* top = bar + 16 * 17;
        __builtin_amdgcn_fence(__ATOMIC_RELEASE, "agent");
        asm volatile("s_waitcnt vmcnt(0)" ::: "memory");
        const unsigned old = __hip_atomic_fetch_add(gcnt, 1u, __ATOMIC_RELAXED, __HIP_MEMORY_SCOPE_AGENT);
        if (old + 1u == k * gsz) {
            __hip_atomic_fetch_add(top, 1u, __ATOMIC_RELAXED, __HIP_MEMORY_SCOPE_AGENT);
            while (__hip_atomic_load(top, __ATOMIC_RELAXED, __HIP_MEMORY_SCOPE_AGENT) < k * ng) __builtin_amdgcn_s_sleep(1);
            __hip_atomic_fetch_add(ggen, 1u, __ATOMIC_RELAXED, __HIP_MEMORY_SCOPE_AGENT);
        } else {
            while (__hip_atomic_load(ggen, __ATOMIC_RELAXED, __HIP_MEMORY_SCOPE_AGENT) < k) __builtin_amdgcn_s_sleep(1);
        }
        __builtin_amdgcn_fence(__ATOMIC_ACQUIRE, "agent");
        asm volatile("s_waitcnt vmcnt(0)" ::: "memory");
    }
    __syncthreads();
}

struct PIn { const float *w_in, *w_out, *w_gu, *w_d, *w_pp, *w_pg, *g_mix, *g_ffn, *p_p, *p_s, *cak, *cav, *cbk, *cbv; };

__device__ __forceinline__ void conv_weights(LAS unsigned char* lds, unsigned char* ws, const PIn& I, const int l, const int wave, const int lane, const int gw, const int NGW, const int r_lo, const int r_hi) {
    LAS float* scr = (LAS float*)(lds + wave * 8448);
    constexpr int I_IN = (DM / 64) * (NIN / 32), I_OUT = (DM / 64) * (DM / 32), I_GU = (DM / 64) * (2 * FF / 32), I_D = (FF / 64) * (DM / 32), I_PP = (DPLE / 64) * (DM / 32), I_PG = I_OUT;
    constexpr int I_LAYER = I_IN + I_OUT + I_GU + I_D + I_PP + I_PG;
    unsigned char* wb = ws + WS_W + (size_t)l * W_LAYER;
    for (int it = r_lo + gw; it < (r_hi < I_LAYER ? r_hi : I_LAYER); it += NGW) {
        int r = it;
        if (r < I_IN) { transpose_item<false>(I.w_in + (size_t)l * DM * NIN, DM, NIN, (bf16*)(wb + W_IN), I.g_mix + l * DM, scr, r, lane); continue; } r -= I_IN;
        if (r < I_OUT) { transpose_item<false>(I.w_out + (size_t)l * DM * DM, DM, DM, (bf16*)(wb + W_OUT), nullptr, scr, r, lane); continue; } r -= I_OUT;
        if (r < I_GU) { transpose_item<true>(I.w_gu + (size_t)l * DM * 2 * FF, DM, 2 * FF, (bf16*)(wb + W_GU), I.g_ffn + l * DM, scr, r, lane); continue; } r -= I_GU;
        if (r < I_D) { transpose_item<false>(I.w_d + (size_t)l * FF * DM, FF, DM, (bf16*)(wb + W_D), nullptr, scr, r, lane); continue; } r -= I_D;
        if (r < I_PP) { transpose_item<false>(I.w_pp + (size_t)l * DPLE * DM, DPLE, DM, (bf16*)(wb + W_PP), nullptr, scr, r, lane); continue; } r -= I_PP;
        transpose_item<false>(I.w_pg + (size_t)l * DM * DM, DM, DM, (bf16*)(wb + W_PG), nullptr, scr, r, lane);
    }
}
__device__ __forceinline__ void conv_p_caches(unsigned char* ws, float* out, const PIn& I, const int l, const size_t gtid, const size_t gth, const int part = 3) {
    bf16* PB = (bf16*)(ws + WS_PB);
    if (part & 1) {
    convert_flat(I.p_p + (size_t)l * MP * DPLE, PB + (size_t)l * MT * DPLE, (size_t)MP * DPLE, gtid, gth);
    convert_flat(I.p_s + (size_t)l * MS * DPLE, PB + (size_t)l * MT * DPLE + (size_t)MP * DPLE, (size_t)MS * DPLE, gtid, gth);
    }
    if (!(part & 2)) return;
    constexpr size_t NA = (size_t)16 * 512 * 512, NB = (size_t)16 * 128 * 128;
    for (size_t i = gtid * 8; i < NA; i += gth * 8) {
        const size_t gi = (size_t)l * NA + i;
        const f32x4 a = *(const f32x4*)(I.cak + gi), b = *(const f32x4*)(I.cak + gi + 4), c = *(const f32x4*)(I.cav + gi), d = *(const f32x4*)(I.cav + gi + 4);
        v4u w; w.x = cvt_pk(a[0], a[1]); w.y = cvt_pk(a[2], a[3]); w.z = cvt_pk(b[0], b[1]); w.w = cvt_pk(b[2], b[3]);
        *(v4u*)((bf16*)(ws + WS_CKA) + gi) = w;
        w.x = cvt_pk(c[0], c[1]); w.y = cvt_pk(c[2], c[3]); w.z = cvt_pk(d[0], d[1]); w.w = cvt_pk(d[2], d[3]);
        *(v4u*)((bf16*)(ws + WS_CVA) + gi) = w;
        if (((i >> 9) & 511) >= 64) { float* dk = out + O_AKS + gi - 32768; float* dv = out + O_AVS + gi - 32768;
            *(f32x4*)dk = a; *(f32x4*)(dk + 4) = b; *(f32x4*)dv = c; *(f32x4*)(dv + 4) = d; }
    }
    for (size_t i = gtid * 8; i < NB; i += gth * 8) {
        const size_t gi = (size_t)l * NB + i;
        const f32x4 a = *(const f32x4*)(I.cbk + gi), b = *(const f32x4*)(I.cbk + gi + 4), c = *(const f32x4*)(I.cbv + gi), d = *(const f32x4*)(I.cbv + gi + 4);
        v4u w; w.x = cvt_pk(a[0], a[1]); w.y = cvt_pk(a[2], a[3]); w.z = cvt_pk(b[0], b[1]); w.w = cvt_pk(b[2], b[3]);
        *(v4u*)((bf16*)(ws + WS_CKB) + gi) = w;
        w.x = cvt_pk(c[0], c[1]); w.y = cvt_pk(c[2], c[3]); w.z = cvt_pk(d[0], d[1]); w.w = cvt_pk(d[2], d[3]);
        *(v4u*)((bf16*)(ws + WS_CVB) + gi) = w;
        if (((i >> 7) & 127) >= 64) { float* dk = out + O_BKS + gi - 8192; float* dv = out + O_BVS + gi - 8192;
            *(f32x4*)dk = a; *(f32x4*)(dk + 4) = b; *(f32x4*)dv = c; *(f32x4*)(dv + 4) = d; }
    }
}

template <int l>
__device__ __forceinline__ void run_layer(LAS unsigned char* lds, unsigned char* ws_in, float* out_in, const float* x_p, const float* x_s, const PIn* pin, const int G, const int bid, const int wave) {
    GAS unsigned char* wsg_ = (GAS unsigned char*)ws_in; GAS float* outg_ = (GAS float*)out_in; asm volatile("" : "+s"(wsg_), "+s"(outg_));
    unsigned char* ws = (unsigned char*)wsg_; float* out = (float*)outg_;
    unsigned* const bar = (unsigned*)(ws + WS_BAR);
#define GRID_BAR(k) grid_bar(bar, (unsigned)((k) + 1), (unsigned)G, (unsigned)bid, wave == 0 && lane_id() == 0)
        unsigned char* wb = ws + WS_W + (size_t)l * W_LAYER;
        bf16 *XB = (bf16*)(ws + WS_XB), *HB = (bf16*)(ws + WS_HB), *O = (bf16*)(ws + WS_O), *ACT = (bf16*)(ws + WS_ACT);
        {
            pg8::RowOrder<NIN / 256> S; S.init(G, bid);
            EpiIn E{ws, out, (l == 0) ? 0 : 2 * MT, l};
            pg8::gemm_phase<DM, EpiIn, pg8::RowOrder<NIN / 256>>(lds, XB, (const bf16*)(wb + W_IN), S, E, wave);
            if (l == 0) {
                const int nbusy = (MT / 256 * (NIN / 256)) % G;
                if (S.v >= nbusy) { const int lane = lane_id(); const PIn I = *pin;
                    conv_p_caches(ws, out, I, 0, (size_t)(S.v - nbusy) * (NWAVES * 64) + wave * 64 + lane, (size_t)(G - nbusy) * (NWAVES * 64), 2); }
            }
        }
        GRID_BAR(6 * l + 1);
        {
            const float* sm = (const float*)(ws + WS_SMALL);
            AttnArgs T{(const bf16*)(ws + WS_Z), (const bf16*)(ws + WS_CKA) + (size_t)l * 16 * 512 * 512, (const bf16*)(ws + WS_CVA) + (size_t)l * 16 * 512 * 512,
                       (const bf16*)(ws + WS_CKB) + (size_t)l * 16 * 128 * 128, (const bf16*)(ws + WS_CVB) + (size_t)l * 16 * 128 * 128,
                       sm + SM_SINK + l * 8, sm + SM_GOA + l * 512, sm + SM_GOB + l * 512, O, (unsigned*)(ws + WS_CTL) + 128 * l};
            attn_phase(lds, T, sm + SM_RELB + (size_t)l * 8 * 513, wave);
            if (l == 0) {
                const int lane = lane_id(); const PIn I = *pin;
                conv_p_caches(ws, out, I, 0, (size_t)bid * (NWAVES * 64) + wave * 64 + lane, (size_t)G * (NWAVES * 64), 1); }
        }
        GRID_BAR(6 * l + 2);
        {
            pg8::RowOrder<DM / 256> S; S.init(G, bid);
            EpiRes E{ws, out, nullptr, nullptr, 1, (1 + 2 * l) * MT};
            pg8::gemm_phase<DM, EpiRes, pg8::RowOrder<DM / 256>>(lds, O, (const bf16*)(wb + W_OUT), S, E, wave);
            if (l == 0) {
                const int nbusy = (MT / 256 * 4) % G;
                if (S.v >= nbusy) { const int lane = lane_id(); const PIn I = *pin; __syncthreads();
                    conv_weights(lds, ws, I, 0, wave, lane, (S.v - nbusy) * NWAVES + wave, (G - nbusy) * NWAVES, W_ITEMS_EARLY, 1 << 30); }
            }
        }
        GRID_BAR(6 * l + 3);
        {
            pg8::RowOrder<2 * FF / 256> S; S.init(G, bid);
            EpiGU E{ws, out, (1 + 2 * l) * MT};
            pg8::gemm_phase<DM, EpiGU, pg8::RowOrder<2 * FF / 256>>(lds, HB, (const bf16*)(wb + W_GU), S, E, wave);
            if (l == 0) {
                const int nbusy = (MT / 256 * (2 * FF / 256)) % G;
                if (S.v >= nbusy) { const int lane = lane_id(); const PIn I = *pin;
                    conv_p_caches(ws, out, I, 1, (size_t)(S.v - nbusy) * (NWAVES * 64) + wave * 64 + lane, (size_t)(G - nbusy) * (NWAVES * 64), 1); }
            }
        }
        GRID_BAR(6 * l + 4);
        {
            pg8::RowOrder<DM / 256> S; S.init(G, bid);
            EpiRes E{ws, out, nullptr, nullptr, 0, -1};
            pg8::gemm_phase<FF, EpiRes, pg8::RowOrder<DM / 256>>(lds, ACT, (const bf16*)(wb + W_D), S, E, wave);
            pg8::RowOrderSkip<DM / 256> S2; S2.init(G, bid, (G > 16) ? (MT / 256 * 4) % G : 0);
            EpiPP E2{ws, out};
            pg8::gemm_phase<DPLE, EpiPP, pg8::RowOrderSkip<DM / 256>>(lds, (const bf16*)(ws + WS_PB) + (size_t)l * MT * DPLE, (const bf16*)(wb + W_PP), S2, E2, wave);
            if (l == 0) {
                const int nbusy = (MT / 256 * 4) % G;
                if (S.v >= nbusy) { const int lane = lane_id(); const PIn I = *pin; __syncthreads();
                    conv_weights(lds, ws, I, 1, wave, lane, (S.v - nbusy) * NWAVES + wave, (G - nbusy) * NWAVES, 0, 1 << 30); }
            }
        }
        GRID_BAR(6 * l + 5);
        {
            pg8::RowOrder<DM / 256> S; S.init(G, bid);
            EpiPG E{ws, out, (2 + 2 * l) * MT};
            pg8::gemm_phase<DM, EpiPG, pg8::RowOrder<DM / 256>>(lds, HB, (const bf16*)(wb + W_PG), S, E, wave);
            if (l == 0) {
                const int nbusy = (MT / 256 * 4) % G;
                if (S.v >= nbusy) { const int lane = lane_id(); const PIn I = *pin;
                    conv_p_caches(ws, out, I, 1, (size_t)(S.v - nbusy) * (NWAVES * 64) + wave * 64 + lane, (size_t)(G - nbusy) * (NWAVES * 64), 2); }
            }
        }
        GRID_BAR(6 * l + 6);
    }
#undef GRID_BAR

__global__ void __launch_bounds__(NWAVES * 64, 2) mega_fwd(Args args) {
    extern __shared__ __attribute__((aligned(16))) unsigned char lds_raw[];
    LAS unsigned char* lds = (LAS unsigned char*)lds_raw;
    const int wave = __builtin_amdgcn_readfirstlane((int)threadIdx.x >> 6);
    const int G = gridDim.x, bid = blockIdx.x;
    unsigned char* const ws = args.ws;
    float* const out = args.out;
    float* const H = out + O_Y;

    if (args.ws == nullptr) cg::this_grid().sync();
    {
        const float *x_p = args.in[0], *x_s = args.in[1], *p_p = args.in[2], *p_s = args.in[3], *cak = args.in[4], *cav = args.in[5], *cbk = args.in[6], *cbv = args.in[7],
                    *g_mix = args.in[8], *w_in = args.in[9], *relb = args.in[10], *sinks = args.in[11], *goa = args.in[12], *gob = args.in[13], *w_out = args.in[14],
                    *g_ffn = args.in[15], *w_gu = args.in[16], *w_d = args.in[17], *w_pp = args.in[18], *w_pg = args.in[19], *g_fin = args.in[20];
        float* ssqb = (float*)(ws + WS_SSQ);
        float* rope = (float*)(ws + WS_ROPE);
        float* sm = (float*)(ws + WS_SMALL);
        bf16 *XB = (bf16*)(ws + WS_XB), *PB = (bf16*)(ws + WS_PB);
        const int lane = lane_id(), tid = wave * 64 + lane;
        const int gw = bid * NWAVES + wave, NGW = G * NWAVES;
        const size_t gtid = (size_t)bid * (NWAVES * 64) + tid, gth = (size_t)G * (NWAVES * 64);
        const PIn I{w_in, w_out, w_gu, w_d, w_pp, w_pg, g_mix, g_ffn, p_p, p_s, cak, cav, cbk, cbv};
        conv_weights(lds, ws, I, 0, wave, lane, gw, NGW, 0, W_ITEMS_EARLY);
        for (int m0 = gw; m0 < MT; m0 += 2 * NGW) {
            const int m1 = m0 + NGW; const bool has1 = m1 < MT;
            const float* xr0 = (m0 < MP) ? x_p + (size_t)m0 * DM : x_s + (size_t)(m0 - MP) * DM;
            const float* xr1 = has1 ? ((m1 < MP) ? x_p + (size_t)m1 * DM : x_s + (size_t)(m1 - MP) * DM) : xr0;
            f32x4 a[2][4];
#pragma unroll
            for (int j = 0; j < 2; ++j) { a[0][2 * j] = *(const f32x4*)(xr0 + j * 512 + lane * 8); a[0][2 * j + 1] = *(const f32x4*)(xr0 + j * 512 + lane * 8 + 4);
                                          a[1][2 * j] = *(const f32x4*)(xr1 + j * 512 + lane * 8); a[1][2 * j + 1] = *(const f32x4*)(xr1 + j * 512 + lane * 8 + 4); }
#pragma unroll
            for (int r = 0; r < 2; ++r) {
                const int m = r ? m1 : m0; float ss = 0.f;
#pragma unroll
                for (int j = 0; j < 2; ++j) { const f32x4 p = a[r][2 * j], q = a[r][2 * j + 1];
                    ss += (p[0] * p[0] + p[1] * p[1]) + (p[2] * p[2] + p[3] * p[3]) + (q[0] * q[0] + q[1] * q[1]) + (q[2] * q[2] + q[3] * q[3]);
                    v4u w; w.x = cvt_pk(p[0], p[1]); w.y = cvt_pk(p[2], p[3]); w.z = cvt_pk(q[0], q[1]); w.w = cvt_pk(q[2], q[3]);
                    if (r == 0 || has1) *(v4u*)(XB + (size_t)m * DM + j * 512 + lane * 8) = w; }
#pragma unroll
                for (int o = 1; o < 64; o <<= 1) ss += __shfl_xor(ss, o);
                if (lane == 0 && (r == 0 || has1)) ssqb[m] = ss;
            }
        }
        for (size_t i = gtid; i < (size_t)16384 * 8; i += gth) {
            const int pos = (int)(i >> 3), j = (int)(i & 7);
            const double rv = (j == 0) ? 0.15915494309189535 : (j == 1) ? 0.03086376340470123 : (j == 2) ? 0.005985185712713705 : (j == 3) ? 0.001160663641240061 :
                              (j == 4) ? 0.00022507907903927653 : (j == 5) ? 4.364795279280289e-05 : (j == 6) ? 8.464330808241401e-06 : 1.6414262627950345e-06;
            const double t = (double)pos * rv; const float fr_ = (float)(t - __builtin_floor(t));
            rope[2 * i] = __builtin_amdgcn_cosf(fr_); rope[2 * i + 1] = __builtin_amdgcn_sinf(fr_);
        }
        for (size_t i = gtid; i < (size_t)SM_END; i += gth) {
            float v = 0.f; const int k = (int)i;
            if (k < 2 * 8 * 513) v = relb[k];
            else if (k >= SM_SINK && k < SM_SINK + 16) v = sinks[k - SM_SINK];
            else if (k >= SM_GOA && k < SM_GOB) v = goa[k - SM_GOA];
            else if (k >= SM_GOB && k < SM_GFIN) v = gob[k - SM_GOB];
            else if (k >= SM_GFIN) v = g_fin[k - SM_GFIN];
            sm[k] = v;
        }
        for (size_t i = gtid; i < (size_t)4 * MT; i += gth) ssqb[MT + i] = 0.f;
        if (gtid < 256) ((unsigned*)(ws + WS_CTL))[gtid] = 0u;
    }
    grid_bar((unsigned*)(ws + WS_BAR), 1u, (unsigned)G, (unsigned)bid, wave == 0 && lane_id() == 0);

    const float* const x_p = args.in[0]; const float* const x_s = args.in[1];
    const PIn pin{args.in[9], args.in[14], args.in[16], args.in[17], args.in[18], args.in[19], args.in[8], args.in[15], args.in[2], args.in[3], args.in[4], args.in[5], args.in[6], args.in[7]};
    run_layer<0>(lds, ws, out, x_p, x_s, &pin, G, bid, wave);
    run_layer<1>(lds, ws, out, x_p, x_s, &pin, G, bid, wave);
    {
        const int lane = lane_id();
        const int gw = bid * NWAVES + wave, NGW = G * NWAVES;
        const float* ssq = (const float*)(ws + WS_SSQ) + 4 * (size_t)MT;
        const float* g_fin = (const float*)(ws + WS_SMALL) + SM_GFIN;
        const bf16* XB = (const bf16*)(ws + WS_XB);
        f32x4 gf[2][2];
#pragma unroll
        for (int j = 0; j < 2; ++j) { gf[j][0] = *(const f32x4*)(g_fin + j * 512 + lane * 8); gf[j][1] = *(const f32x4*)(g_fin + j * 512 + lane * 8 + 4); }
        for (int m = gw; m < MT; m += NGW) {
            const float rstd = __builtin_amdgcn_rsqf(ssq[m] * (1.0f / DM) + EPS);
            float* yr = H + (size_t)m * DM;
#pragma unroll
            for (int j = 0; j < 2; ++j) {
                const v4u w = *(const v4u*)(XB + (size_t)m * DM + j * 512 + lane * 8);
                const f32x4 a = (f32x4){bf_lo(w.x), bf_hi(w.x), bf_lo(w.y), bf_hi(w.y)}, b2 = (f32x4){bf_lo(w.z), bf_hi(w.z), bf_lo(w.w), bf_hi(w.w)};
                *(f32x4*)(yr + j * 512 + lane * 8) = a * rstd * gf[j][0]; *(f32x4*)(yr + j * 512 + lane * 8 + 4) = b2 * rstd * gf[j][1];
            }
        }
    }
}

extern "C" void kernel_launch(void* const* d_in, const int* in_sizes, int n_in, void* d_out, int out_size, void* d_ws, size_t ws_size, hipStream_t stream) {
    static int grid = 0;
    if (grid == 0) {
        if (n_in != 21 || (size_t)out_size != O_END || ws_size < WS_END) { fprintf(stderr, "kernel_launch: unexpected problem: n_in %d out %d ws %zu (need out %zu ws %zu)\n", n_in, out_size, ws_size, (size_t)O_END, (size_t)WS_END); grid = -1; return; }
        int dev = 0, cus = 0, per_cu = 0;
        (void)hipGetDevice(&dev);
        (void)hipDeviceGetAttribute(&cus, hipDeviceAttributeMultiprocessorCount, dev);
        if (hipFuncSetAttribute((const void*)mega_fwd, hipFuncAttributeMaxDynamicSharedMemorySize, LDS_BYTES) != hipSuccess) { fprintf(stderr, "kernel_launch: hipFuncSetAttribute failed\n"); grid = -1; return; }
        if (hipOccupancyMaxActiveBlocksPerMultiprocessor(&per_cu, (const void*)mega_fwd, NWAVES * 64, LDS_BYTES) != hipSuccess || per_cu < 1) { fprintf(stderr, "kernel_launch: occupancy query says %d blocks per CU\n", per_cu); (void)hipGetLastError(); per_cu = 1; }
        grid = cus * 1;
        if (grid <= 0) { grid = -1; return; }
    }
    if (grid < 0) return;
    (void)hipMemsetAsync((unsigned char*)d_ws + WS_BAR, 0, 2048, stream);
    Args a{};
    for (int i = 0; i < 21; ++i) a.in[i] = (const float*)d_in[i];
    a.out = (float*)d_out; a.ws = (unsigned char*)d_ws;
    void* kargs[] = {&a};
    hipError_t e = hipLaunchCooperativeKernel((const void*)mega_fwd, dim3(grid), dim3(NWAVES * 64), kargs, LDS_BYTES, stream);
    if (e != hipSuccess) fprintf(stderr, "kernel_launch: cooperative launch failed: %s (grid %d)\n", hipGetErrorString(e), grid);
}
```
